# Optimizing an MI355X kernel written in HIP

```python
import math
import jax, jax.numpy as jnp
from jax import lax
import numpy as np

D_MODEL = 1024
BATCH = 8
SEQ = 4096
DEPTH = 4

EPS = 1e-6
D_MIX = D_MODEL

SSD_HEADS = 8
SSD_HEAD_DIM = 64
SSD_INNER = SSD_HEADS * SSD_HEAD_DIM
SSD_GROUPS = 2
SSD_HPG = SSD_HEADS // SSD_GROUPS
SSD_STATE = 128
SSD_CONV = 4
SSD_CHUNK = 128
SSD_XBC = SSD_INNER + 2 * SSD_GROUPS * SSD_STATE
DT_MIN = 0.001
DT_MAX = 0.1

MLA_HEADS = 4
MLA_NOPE = 64
MLA_ROPE = 32
MLA_V = 64
MLA_Q_RANK = 256
MLA_KV_RANK = 128
ROPE_THETA = 10000.0
MAX_POS_OFFSET = 1024

SWA_HEADS = 4
SWA_KV_HEADS = 2
SWA_HEAD_DIM = 64
WINDOW = 128

ATTN_BLOCK = 128

SSD_IN = SSD_INNER + SSD_XBC + SSD_HEADS
MLA_IN = MLA_Q_RANK + MLA_KV_RANK + MLA_ROPE
SWA_IN = (SWA_HEADS + 2 * SWA_KV_HEADS) * SWA_HEAD_DIM
D_IN = SSD_IN + MLA_IN + SWA_IN

D_FF = 2816
FFN_CONV = 3

kernel_name = "hybrid_ssd_mla_swa_convffn_adaln"


def rmsnorm(x, g):
    xf = x.astype(jnp.float32)
    y = xf * lax.rsqrt(jnp.mean(xf * xf, axis=-1, keepdims=True) + EPS)
    return (y * g.astype(jnp.float32)).astype(x.dtype)


def causal_dwconv(x, w, b):
    k_width = w.shape[0]
    s = x.shape[1]
    xp = jnp.pad(x, ((0, 0), (k_width - 1, 0), (0, 0)))
    y = b
    for k in range(k_width):
        y = y + xp[:, k:k + s] * w[k]
    return y


def apply_rope(x, cos, sin):
    xf = x.astype(jnp.float32)
    x1, x2 = jnp.split(xf, 2, axis=-1)
    return jnp.concatenate([x1 * cos - x2 * sin, x1 * sin + x2 * cos], axis=-1).astype(x.dtype)


def ssd_mixer(p, conv_w, conv_b, dt_bias, a_log, d_skip, norm_g):
    f32 = jnp.float32
    bsz, s, _ = p.shape
    nc, q = s // SSD_CHUNK, SSD_CHUNK
    z, xbc, dt = jnp.split(p, [SSD_INNER, SSD_INNER + SSD_XBC], axis=-1)
    xbc = jax.nn.silu(causal_dwconv(xbc, conv_w, conv_b))
    xs, bm, cm = jnp.split(xbc, [SSD_INNER, SSD_INNER + SSD_GROUPS * SSD_STATE], axis=-1)
    xs = xs.astype(f32).reshape(bsz, nc, q, SSD_GROUPS, SSD_HPG, SSD_HEAD_DIM)
    bm = bm.astype(f32).reshape(bsz, nc, q, SSD_GROUPS, SSD_STATE)
    cm = cm.astype(f32).reshape(bsz, nc, q, SSD_GROUPS, SSD_STATE)
    dt = jax.nn.softplus(dt.astype(f32) + dt_bias.astype(f32))
    a = -jnp.exp(a_log.astype(f32))
    dt_c = dt.reshape(bsz, nc, q, SSD_GROUPS, SSD_HPG)
    xdt = xs * dt_c[..., None]
    da = (dt * a).reshape(bsz, nc, q, SSD_HEADS).transpose(0, 1, 3, 2)
    a_h = jnp.cumsum(da, axis=-1).reshape(bsz, nc, SSD_GROUPS, SSD_HPG, q)
    causal = jnp.tril(jnp.ones((q, q), dtype=bool))
    seg = a_h[..., :, None] - a_h[..., None, :]
    decay = jnp.exp(jnp.where(causal, seg, -jnp.inf))
    cb = jnp.einsum('bclgn,bcsgn->bcgls', cm, bm)
    y_diag = jnp.einsum('bcghls,bcsghp->bclghp', cb[:, :, :, None] * decay, xdt)
    decay_to_end = jnp.exp(a_h[..., -1:] - a_h)
    states = jnp.einsum('bcsgn,bcghs,bcsghp->bcghpn', bm, decay_to_end, xdt)
    chunk_decay = jnp.exp(a_h[..., -1])

    def step(h, inp):
        st, dec = inp
        return h * dec[..., None, None] + st, h

    h0 = jnp.zeros((bsz, SSD_GROUPS, SSD_HPG, SSD_HEAD_DIM, SSD_STATE), f32)
    _, h_in = lax.scan(step, h0, (states.swapaxes(0, 1), chunk_decay.swapaxes(0, 1)))
    h_in = h_in.swapaxes(0, 1)
    y_off = jnp.einsum('bclgn,bcghpn,bcghl->bclghp', cm, h_in, jnp.exp(a_h))
    y = y_diag + y_off + xs * d_skip.astype(f32).reshape(SSD_GROUPS, SSD_HPG, 1)
    y = y.reshape(bsz, s, SSD_INNER) * jax.nn.silu(z.astype(f32))
    yg = y.reshape(bsz, s, SSD_GROUPS, SSD_INNER // SSD_GROUPS)
    yg = yg * lax.rsqrt(jnp.mean(yg * yg, axis=-1, keepdims=True) + EPS)
    y = yg.reshape(bsz, s, SSD_INNER) * norm_g.astype(f32)
    return y.astype(p.dtype)


def causal_block_attention(q, k, v, scale):
    bsz, s, h, dk = q.shape
    nb = s // ATTN_BLOCK
    qb = q.reshape(bsz, nb, ATTN_BLOCK, h, dk).swapaxes(0, 1)
    kpos = jnp.arange(s)

    def one_block(args):
        qi, i = args
        sc = jnp.einsum('bqhd,bkhd->bhqk', qi, k, preferred_element_type=jnp.float32) * scale
        qpos = i * ATTN_BLOCK + jnp.arange(ATTN_BLOCK)
        sc = jnp.where(kpos[None, :] <= qpos[:, None], sc, -jnp.inf)
        pr = jax.nn.softmax(sc, axis=-1).astype(v.dtype)
        return jnp.einsum('bhqk,bkhd->bqhd', pr, v)

    out = lax.map(one_block, (qb, jnp.arange(nb)))
    return out.swapaxes(0, 1).reshape(bsz, s, h * v.shape[-1])


def mla_mixer(p, q_norm_g, w_uq, kv_norm_g, w_ukv, cos, sin):
    bsz, s, _ = p.shape
    cq, ckv, k_rope = jnp.split(p, [MLA_Q_RANK, MLA_Q_RANK + MLA_KV_RANK], axis=-1)
    qh = (rmsnorm(cq, q_norm_g) @ w_uq).reshape(bsz, s, MLA_HEADS, MLA_NOPE + MLA_ROPE)
    q_nope, q_rope = jnp.split(qh, [MLA_NOPE], axis=-1)
    q_rope = apply_rope(q_rope, cos, sin)
    kv = (rmsnorm(ckv, kv_norm_g) @ w_ukv).reshape(bsz, s, MLA_HEADS, MLA_NOPE + MLA_V)
    k_nope, v = jnp.split(kv, [MLA_NOPE], axis=-1)
    k_rope = apply_rope(k_rope[:, :, None, :], cos, sin)
    qf = jnp.concatenate([q_nope, q_rope], axis=-1)
    kf = jnp.concatenate([k_nope, jnp.broadcast_to(k_rope, (bsz, s, MLA_HEADS, MLA_ROPE))], axis=-1)
    return causal_block_attention(qf, kf, v, 1.0 / math.sqrt(MLA_NOPE + MLA_ROPE))


def swa_sink_mixer(p, sinks):
    bsz, s, _ = p.shape
    grp = SWA_HEADS // SWA_KV_HEADS
    nb = s // WINDOW
    qd = SWA_HEADS * SWA_HEAD_DIM
    kd = SWA_KV_HEADS * SWA_HEAD_DIM
    q, k, v = jnp.split(p, [qd, qd + kd], axis=-1)
    qb = q.reshape(bsz, nb, WINDOW, SWA_KV_HEADS, grp, SWA_HEAD_DIM)

    def band(t):
        tp = jnp.pad(t.reshape(bsz, s, SWA_KV_HEADS, SWA_HEAD_DIM), ((0, 0), (WINDOW, 0), (0, 0), (0, 0)))
        tp = tp.reshape(bsz, nb + 1, WINDOW, SWA_KV_HEADS, SWA_HEAD_DIM)
        return jnp.concatenate([tp[:, :-1], tp[:, 1:]], axis=2)

    kb, vb = band(k), band(v)
    sc = jnp.einsum('bnqhgd,bnkhd->bnhgqk', qb, kb, preferred_element_type=jnp.float32)
    sc = sc * (1.0 / math.sqrt(SWA_HEAD_DIM))
    i = jnp.arange(WINDOW)[:, None]
    j = jnp.arange(2 * WINDOW)[None, :]
    rel = WINDOW + i - j
    blk = jnp.arange(nb)[:, None, None]
    valid = (rel >= 0) & (rel < WINDOW) & ((blk - 1) * WINDOW + j >= 0)
    sc = jnp.where(valid[None, :, None, None], sc, -jnp.inf)
    sink = jnp.broadcast_to(sinks.astype(jnp.float32).reshape(1, 1, SWA_KV_HEADS, grp, 1, 1),
                            sc.shape[:-1] + (1,))
    pr = jax.nn.softmax(jnp.concatenate([sc, sink], axis=-1), axis=-1)[..., :-1]
    o = jnp.einsum('bnhgqk,bnkhd->bnqhgd', pr.astype(vb.dtype), vb)
    return o.reshape(bsz, s, qd)


def setup_inputs(seed: int = 0) -> dict:
    key = jax.random.key(seed)
    ks = iter(jax.random.split(key, 32))
    f32 = jnp.float32
    L = DEPTH

    def nrm(shape, scale):
        return jax.random.normal(next(ks), shape, f32) * scale

    def gain(shape):
        return 1.0 + nrm(shape, 0.02)

    x = nrm((BATCH, SEQ, D_MODEL), 1.0)
    c = nrm((BATCH, D_MODEL), 1.0)
    offs = jax.random.randint(next(ks), (BATCH, 1), 0, MAX_POS_OFFSET, dtype=jnp.int32)
    positions = offs + jnp.arange(SEQ, dtype=jnp.int32)[None, :]
    ada_w = nrm((L, D_MODEL, 6 * D_MODEL), 0.5 * D_MODEL ** -0.5)
    ada_b = nrm((L, 6 * D_MODEL), 0.02)
    norm1_g = gain((L, D_MODEL))
    norm2_g = gain((L, D_MODEL))
    w_in = nrm((L, D_MODEL, D_IN), D_MODEL ** -0.5)
    ssd_conv_w = nrm((L, SSD_CONV, SSD_XBC), SSD_CONV ** -0.5)
    ssd_conv_b = nrm((L, SSD_XBC), 0.02)
    dt0 = jnp.exp(jax.random.uniform(next(ks), (L, SSD_HEADS), f32)
                  * (math.log(DT_MAX) - math.log(DT_MIN)) + math.log(DT_MIN))
    ssd_dt_bias = dt0 + jnp.log(-jnp.expm1(-dt0))
    ssd_a_log = jnp.log(jax.random.uniform(next(ks), (L, SSD_HEADS), f32, 1.0, 16.0))
    ssd_d = 1.0 + nrm((L, SSD_HEADS), 0.1)
    ssd_norm_g = gain((L, SSD_INNER))
    mla_q_norm_g = gain((L, MLA_Q_RANK))
    mla_w_uq = nrm((L, MLA_Q_RANK, MLA_HEADS * (MLA_NOPE + MLA_ROPE)), MLA_Q_RANK ** -0.5)
    mla_kv_norm_g = gain((L, MLA_KV_RANK))
    mla_w_ukv = nrm((L, MLA_KV_RANK, MLA_HEADS * (MLA_NOPE + MLA_V)), MLA_KV_RANK ** -0.5)
    swa_sinks = nrm((L, SWA_HEADS), 1.0)
    w_out = nrm((L, D_MIX, D_MODEL), D_MIX ** -0.5)
    ffn_w_up = nrm((L, D_MODEL, 2 * D_FF), D_MODEL ** -0.5)
    ffn_conv_w = nrm((L, FFN_CONV, 2 * D_FF), FFN_CONV ** -0.5)
    ffn_conv_b = nrm((L, 2 * D_FF), 0.02)
    ffn_w_down = nrm((L, D_FF, D_MODEL), D_FF ** -0.5)
    final_norm_g = gain((D_MODEL,))
    return {"x": x, "c": c, "positions": positions,
            "ada_w": ada_w, "ada_b": ada_b, "norm1_g": norm1_g, "norm2_g": norm2_g,
            "w_in": w_in, "ssd_conv_w": ssd_conv_w, "ssd_conv_b": ssd_conv_b,
            "ssd_dt_bias": ssd_dt_bias, "ssd_a_log": ssd_a_log, "ssd_d": ssd_d,
            "ssd_norm_g": ssd_norm_g, "mla_q_norm_g": mla_q_norm_g, "mla_w_uq": mla_w_uq,
            "mla_kv_norm_g": mla_kv_norm_g, "mla_w_ukv": mla_w_ukv, "swa_sinks": swa_sinks,
            "w_out": w_out, "ffn_w_up": ffn_w_up, "ffn_conv_w": ffn_conv_w,
            "ffn_conv_b": ffn_conv_b, "ffn_w_down": ffn_w_down, "final_norm_g": final_norm_g}


def reference(x, c, positions, ada_w, ada_b, norm1_g, norm2_g, w_in, ssd_conv_w, ssd_conv_b,
              ssd_dt_bias, ssd_a_log, ssd_d, ssd_norm_g, mla_q_norm_g, mla_w_uq, mla_kv_norm_g,
              mla_w_ukv, swa_sinks, w_out, ffn_w_up, ffn_conv_w, ffn_conv_b, ffn_w_down,
              final_norm_g):
    inv_freq = ROPE_THETA ** (-jnp.arange(0, MLA_ROPE, 2, dtype=jnp.float32) / MLA_ROPE)
    ang = positions.astype(jnp.float32)[..., None] * inv_freq
    cos = jnp.cos(ang)[:, :, None, :]
    sin = jnp.sin(ang)[:, :, None, :]
    c_act = jax.nn.silu(c)
    for l in range(DEPTH):
        mod = c_act @ ada_w[l] + ada_b[l]
        sh1, sc1, g1, sh2, sc2, g2 = [m[:, None, :] for m in jnp.split(mod, 6, axis=-1)]
        h = rmsnorm(x, norm1_g[l]) * (1.0 + sc1) + sh1
        proj = h @ w_in[l]
        p_ssd, p_mla, p_swa = jnp.split(proj, [SSD_IN, SSD_IN + MLA_IN], axis=-1)
        y_ssd = ssd_mixer(p_ssd, ssd_conv_w[l], ssd_conv_b[l], ssd_dt_bias[l], ssd_a_log[l],
                          ssd_d[l], ssd_norm_g[l])
        y_mla = mla_mixer(p_mla, mla_q_norm_g[l], mla_w_uq[l], mla_kv_norm_g[l], mla_w_ukv[l],
                          cos, sin)
        y_swa = swa_sink_mixer(p_swa, swa_sinks[l])
        y = jnp.concatenate([y_ssd, y_mla, y_swa], axis=-1) @ w_out[l]
        x = x + g1 * y
        h = rmsnorm(x, norm2_g[l]) * (1.0 + sc2) + sh2
        u = causal_dwconv(h @ ffn_w_up[l], ffn_conv_w[l], ffn_conv_b[l])
        a, b = jnp.split(u, 2, axis=-1)
        x = x + g2 * ((jax.nn.silu(a) * b) @ ffn_w_down[l])
    return rmsnorm(x, final_norm_g)
```

```cpp
#include <hip/hip_runtime.h>
#include <hip/hip_cooperative_groups.h>
#include <cstdio>
#include <cstdint>
namespace cg = cooperative_groups;

#define LAS __attribute__((address_space(3)))
typedef unsigned short bf16_t;
typedef short bf16x8 __attribute__((ext_vector_type(8)));
typedef float f32x4 __attribute__((ext_vector_type(4)));
typedef float f32x2 __attribute__((ext_vector_type(2)));
typedef unsigned u32x4 __attribute__((ext_vector_type(4)));
typedef unsigned u32x2 __attribute__((ext_vector_type(2)));

#ifndef PROBE_MASK
#define PROBE_MASK 0
#endif
#define RUN(bit, call) do { call; if (PROBE_MASK & (bit)) { call; } } while (0)
#ifndef MK_PER_PHASE
#define MK_PER_PHASE 0
#endif

constexpr int D = 1024, NB = 8, SEQ = 4096, M = NB * SEQ, DEPTH = 4, DFF = 2816, DIN = 2472, NPROJ = 2560;
constexpr float EPS = 1e-6f;
constexpr int PC_Z = 0, PC_X = 512, PC_CQ = 1536, PC_CKV = 1792, PC_KR = 1920, PC_SQ = 1952, PC_SK = 2208, PC_SV = 2336, PC_DT = 2464;
constexpr float LOG2E = 1.4426950408889634f;
constexpr float RSQ_SCALE = 16777216.f;
constexpr float MLA_QSCALE = 0.10206207261596577f * LOG2E;
constexpr float SWA_QSCALE = 0.125f * LOG2E;

constexpr size_t MiB = 1u << 20;
constexpr size_t WS_MOD = 1 * MiB;
constexpr size_t WS_ROPE = 2 * MiB;
constexpr size_t WS_W = 6 * MiB;
constexpr size_t WO_IN = 0, WO_OUT = 5 * MiB, WO_UP = 7 * MiB, WO_DN = 18 * MiB, WO_UQ = 23 * MiB + 512 * 1024, WO_UKV = 23 * MiB + 768 * 1024;
constexpr size_t WS_H = 32 * MiB;
constexpr size_t WS_PROJ = 96 * MiB;
constexpr size_t WS_YCAT = 272 * MiB;
constexpr size_t WS_Q = 336 * MiB;
constexpr size_t WS_KV = 360 * MiB;
constexpr size_t WS_KR = 392 * MiB;
constexpr size_t WS_DTRAW = 394 * MiB;
constexpr size_t WS_DTSP = 395 * MiB;
constexpr size_t WS_RS = 396 * MiB;
constexpr size_t WS_YS = 400 * MiB;
constexpr size_t WS_RSQ = 396 * MiB + 256 * 1024;
constexpr size_t WS_BIAS = 397 * MiB;
constexpr size_t WS_W2 = 464 * MiB;
constexpr size_t WS_END = 490 * MiB;

constexpr int LDS_BYTES = 147456;
constexpr int LDS_EXTRA = 131072;

__device__ __forceinline__ unsigned f2bf(float f) { unsigned u = __builtin_bit_cast(unsigned, f); return (u + 0x7fffu + ((u >> 16) & 1u)) >> 16; }
__device__ __forceinline__ unsigned pk2(float lo, float hi) { return f2bf(lo) | (f2bf(hi) << 16); }
__device__ __forceinline__ float bflo(unsigned w) { return __builtin_bit_cast(float, w << 16); }
__device__ __forceinline__ float bfhi(unsigned w) { return __builtin_bit_cast(float, w & 0xffff0000u); }
__device__ __forceinline__ float bf2f(bf16_t h) { return __builtin_bit_cast(float, (unsigned)h << 16); }
__device__ __forceinline__ unsigned cvt_pk_bf16(float lo, float hi) { unsigned r; asm volatile("v_cvt_pk_bf16_f32 %0, %1, %2" : "=v"(r) : "v"(lo), "v"(hi)); return r; }
__device__ __forceinline__ float shx(float v, int o, int lane) { return __builtin_bit_cast(float, __builtin_amdgcn_ds_bpermute((lane ^ o) << 2, __builtin_bit_cast(int, v))); }
__device__ __forceinline__ float wave_sum(float v, int lane) {
#pragma unroll
    for (int o = 1; o < 64; o <<= 1) v += shx(v, o, lane);
    return v;
}
__device__ __forceinline__ int tid_opaque(int wv) { unsigned m = ~0u; asm volatile("" : "+s"(m), "+s"(wv)); int t = (wv << 6) | (int)__builtin_amdgcn_mbcnt_hi(m, __builtin_amdgcn_mbcnt_lo(m, 0u)); asm volatile("" : "+v"(t)); return t; }
__device__ __forceinline__ float silu_f(float v) { return v * __builtin_amdgcn_rcpf(1.f + __builtin_amdgcn_exp2f(v * -1.4426950408889634f)); }

namespace pg8 {
constexpr int BM = 256, BK = 64, HALF = 128, HTB = HALF * BK * 2, STAGE_BYTES = 8 * HTB, NXCD = 8, WGM = 8;
__host__ __device__ __forceinline__ int lds_byte(int r, int c) { const int st = (r >> 4) * 2 + (c >> 5), rr = r & 15, cc = c & 31, ob = rr * 64 + cc * 2; return st * 1024 + (ob ^ (((ob >> 9) & 1) << 5)); }
__host__ __device__ __forceinline__ void stage_rc(int b, int& R, int& C) { const int st = b / 1024, sb = b % 1024, swz = sb ^ (((sb >> 9) & 1) << 5); R = (st >> 1) * 16 + swz / 64; C = (st & 1) * 32 + (swz % 64) / 2; }
__host__ __device__ __forceinline__ int perm32(int rho) { const int n = rho >> 4, i = rho & 15; return 8 * (i >> 2) + 4 * n + (i & 3); }

struct Unit { int pm, pn; };
struct Gemm { const bf16_t* A; const bf16_t* Bt; int K; int lda; int wv; };

struct Order {
    int nM, nN, nwg, G, c, mode;
    __device__ __forceinline__ void init(int nM_, int nN_, int G_, int c_, int mode_) { nM = nM_; nN = nN_; nwg = nM * nN; G = G_; c = c_; mode = mode_; }
    __device__ __forceinline__ bool next(int i, Unit& u) const {
        const long L = (long)i * G + c; if (L >= nwg) return false;
        int wgid = (int)L; { const int q = nwg / NXCD, r = nwg % NXCD, xcd = wgid % NXCD, off = wgid / NXCD; wgid = (xcd < r ? xcd * (q + 1) : r * (q + 1) + (xcd - r) * q) + off; }
        const int nig = WGM * nN, gid = wgid / nig, fm = gid * WGM, gsz = (nM - fm) < WGM ? (nM - fm) : WGM;
        u.pm = fm + ((wgid % nig) % gsz); u.pn = (wgid % nig) / gsz; return true;
    }
    __device__ __forceinline__ long a_row(const Unit& u) const { return mode == 0 ? (long)u.pm * 256 : (long)(u.pm / 17) * 4096 + (long)(u.pm % 17) * 254 - 2; }
};

template <class Epi, class Sched>
__device__ __forceinline__ void gemm_phase(LAS unsigned char* lds, const Gemm g, const Sched& S, const Epi& E) {
    const int tid = tid_opaque(g.wv);
    const int wid = __builtin_amdgcn_readfirstlane(tid >> 6), lane = tid & 63, wr = wid >> 2, wc = wid & 3, fr = lane & 15, fq = lane >> 4;
    const int K = g.K, nt = K / BK, lda = g.lda;
    unsigned voffA[2], voffB[2];
#pragma unroll
    for (int i = 0; i < 2; ++i) { int R, C; stage_rc(tid * 16 + i * 8192, R, C); const int Rb = Epi::PERM ? ((R & ~31) + perm32(R & 31)) : R;
        voffA[i] = (unsigned)(R * lda + C) * 2u; voffB[i] = (unsigned)(Rb * K + C) * 2u; }
    const size_t kstep = (size_t)(BK * 2);
    const size_t hA = (size_t)HALF * lda * 2, hB = (size_t)HALF * K * 2;
    const size_t tB = 2 * hB;
    const unsigned ldsw = (unsigned)wid * 1024u;
    const int aoff = lds_byte(wr * 64 + fr, fq * 8), boff = lds_byte(wc * 32 + fr, fq * 8);
#define PG8_SA(b, h) (((b) * 2 + (h)) * HTB)
#define PG8_SB(b, h) ((4 + (b) * 2 + (h)) * HTB)
#define PG8_STAGE(bufoff, gbase, voff) do { _Pragma("unroll") for (int _i = 0; _i < 2; ++_i) \
        __builtin_amdgcn_global_load_lds((const unsigned*)((const char*)(gbase) + (voff)[_i]), (LAS unsigned*)(lds + (bufoff) + ldsw + _i * 8192), 16, 0, 0); } while (0)
#define PG8_LDA(dst, b, h) do { _Pragma("unroll") for (int m = 0; m < 4; ++m) _Pragma("unroll") for (int k = 0; k < 2; ++k) dst[m][k] = *(const LAS bf16x8*)(lds + PG8_SA(b, h) + aoff + m * 2048 + k * 1024); } while (0)
#define PG8_LDB(dst, b, h) do { _Pragma("unroll") for (int n = 0; n < 2; ++n) _Pragma("unroll") for (int k = 0; k < 2; ++k) dst[n][k] = *(const LAS bf16x8*)(lds + PG8_SB(b, h) + boff + n * 2048 + k * 1024); } while (0)
#define PG8_MMA(ai, bj, At, Bt) do { __builtin_amdgcn_s_setprio(1); _Pragma("unroll") for (int m = 0; m < 4; ++m) _Pragma("unroll") for (int n = 0; n < 2; ++n) _Pragma("unroll") for (int k = 0; k < 2; ++k) \
        acc[ai][bj][m][n] = __builtin_amdgcn_mfma_f32_16x16x32_bf16(Bt[n][k], At[m][k], acc[ai][bj][m][n], 0, 0, 0); __builtin_amdgcn_s_setprio(0); } while (0)
#define PG8_WAIT_V(n) asm volatile("s_waitcnt vmcnt(" #n ")" ::: "memory")
#define PG8_WAIT_L(n) asm volatile("s_waitcnt lgkmcnt(" #n ")" ::: "memory")
#define PG8_BAR __builtin_amdgcn_s_barrier()
#define PG8_SCHED __builtin_amdgcn_sched_barrier(0)
    Unit cur, nxt; int ui = 0;
    if (!S.next(0, cur)) return;
    f32x4 acc[2][2][4][2];
#pragma unroll
    for (int a = 0; a < 2; ++a)
#pragma unroll
        for (int b = 0; b < 2; ++b)
#pragma unroll
            for (int m = 0; m < 4; ++m)
#pragma unroll
                for (int n = 0; n < 2; ++n) acc[a][b][m][n] = (f32x4){0.f, 0.f, 0.f, 0.f};
    bf16x8 At[4][2], B0[2][2], B1[2][2];
    const char* cA = (const char*)g.A + S.a_row(cur) * (long)lda * 2; const char* cB = (const char*)g.Bt + (size_t)cur.pn * tB;
    PG8_STAGE(PG8_SB(0, 0), cB, voffB); PG8_STAGE(PG8_SB(0, 1), cB + hB, voffB); PG8_STAGE(PG8_SA(0, 0), cA, voffA); PG8_STAGE(PG8_SA(0, 1), cA + hA, voffA);
    if (wr == 1) PG8_BAR;
    PG8_WAIT_V(2); PG8_BAR;
    PG8_STAGE(PG8_SB(1, 0), cB + kstep, voffB); PG8_STAGE(PG8_SA(1, 0), cA + kstep, voffA); PG8_STAGE(PG8_SB(1, 1), cB + hB + kstep, voffB);
    PG8_WAIT_V(6); PG8_BAR;
    for (;;) {
        const bool has_next = S.next(ui + 1, nxt);
        const char* nA = has_next ? (const char*)g.A + S.a_row(nxt) * (long)lda * 2 : cA; const char* nB = has_next ? (const char*)g.Bt + (size_t)nxt.pn * tB : cB;
        for (int t = 0; t < nt; t += 2) {
            const bool last = (t == nt - 2);
            const char* a1 = cA + (size_t)(t + 1) * kstep;
            const char* a2 = last ? nA : cA + (size_t)(t + 2) * kstep; const char* b2 = last ? nB : cB + (size_t)(t + 2) * kstep;
            const char* a3 = a2 + kstep; const char* b3 = b2 + kstep;
            PG8_LDB(B0, 0, 0); PG8_LDB(B1, 0, 1); PG8_SCHED; PG8_LDA(At, 0, 0); PG8_STAGE(PG8_SA(1, 1), a1 + hA, voffA);
            PG8_WAIT_V(8); PG8_WAIT_L(0); PG8_BAR; PG8_MMA(0, 0, At, B0); PG8_MMA(0, 1, At, B1); PG8_BAR; PG8_SCHED;
            PG8_LDA(At, 0, 1); PG8_STAGE(PG8_SB(0, 0), b2, voffB); PG8_STAGE(PG8_SB(0, 1), b2 + hB, voffB); PG8_STAGE(PG8_SA(0, 0), a2, voffA);
            PG8_WAIT_V(8); PG8_WAIT_L(0); PG8_BAR; PG8_MMA(1, 0, At, B0); PG8_MMA(1, 1, At, B1); PG8_BAR; PG8_SCHED;
            PG8_LDB(B0, 1, 0); PG8_LDB(B1, 1, 1); PG8_SCHED; PG8_LDA(At, 1, 0); PG8_STAGE(PG8_SA(0, 1), a2 + hA, voffA);
            PG8_WAIT_V(8); PG8_WAIT_L(0); PG8_BAR; PG8_MMA(0, 0, At, B0); PG8_MMA(0, 1, At, B1); PG8_BAR; PG8_SCHED;
            PG8_LDA(At, 1, 1); PG8_STAGE(PG8_SB(1, 0), b3, voffB); PG8_STAGE(PG8_SB(1, 1), b3 + hB, voffB); PG8_STAGE(PG8_SA(1, 0), a3, voffA);
            PG8_WAIT_V(8); PG8_WAIT_L(0); PG8_BAR; PG8_MMA(1, 0, At, B0); PG8_MMA(1, 1, At, B1); PG8_BAR; PG8_SCHED;
        }
        if (wr == 0) PG8_BAR;
        { const int t2 = tid_opaque(g.wv), w2 = __builtin_amdgcn_readfirstlane(t2 >> 6), l2 = t2 & 63;
          E(acc, cur, S, w2 >> 2, w2 & 3, l2 & 15, l2 >> 4, lds, w2, l2); }
        if (!has_next) break;
#pragma unroll
        for (int a = 0; a < 2; ++a)
#pragma unroll
            for (int b = 0; b < 2; ++b)
#pragma unroll
                for (int m = 0; m < 4; ++m)
#pragma unroll
                    for (int n = 0; n < 2; ++n) acc[a][b][m][n] = (f32x4){0.f, 0.f, 0.f, 0.f};
        cur = nxt; cA = nA; cB = nB; ++ui;
        if (wr == 1) PG8_BAR;
    }
    PG8_WAIT_V(0);
    PG8_BAR;
#undef PG8_SA
#undef PG8_SB
#undef PG8_STAGE
#undef PG8_LDA
#undef PG8_LDB
#undef PG8_MMA
#undef PG8_WAIT_V
#undef PG8_WAIT_L
#undef PG8_BAR
#undef PG8_SCHED
}

typedef f32x4 Acc[2][2][4][2];

struct EpiProj {
    static constexpr bool PERM = true;
    bf16_t* O; float* dtraw; const unsigned long long* rowsq; const float* bias;
    __device__ __forceinline__ void operator()(Acc& acc, const Unit& u, const Order&, int wr, int wc, int fr, int fq, LAS unsigned char*, int, int) const {
        const int row0 = u.pm * BM + wr * 64 + fr, col0 = u.pn * BM + wc * 32 + 8 * fq;
        const float* bp = bias + (size_t)((u.pm * BM) / SEQ) * NPROJ + col0;
        f32x4 bv[2][2];
#pragma unroll
        for (int bj = 0; bj < 2; ++bj) { bv[bj][0] = *(const f32x4*)(bp + bj * HALF); bv[bj][1] = *(const f32x4*)(bp + bj * HALF + 4); }
        float r8[2][4];
#pragma unroll
        for (int ai = 0; ai < 2; ++ai)
#pragma unroll
            for (int m = 0; m < 4; ++m) r8[ai][m] = (float)rowsq[row0 + ai * HALF + m * 16] * (1.f / RSQ_SCALE);
#pragma unroll
        for (int ai = 0; ai < 2; ++ai)
#pragma unroll
            for (int m = 0; m < 4; ++m) { const int row = row0 + ai * HALF + m * 16; bf16_t* rowp = O + (size_t)row * NPROJ + col0;
                const float r = __builtin_amdgcn_rsqf(r8[ai][m] * (1.f / D) + EPS);
#pragma unroll
                for (int bj = 0; bj < 2; ++bj) { const f32x4 v0 = acc[ai][bj][m][0] * r + bv[bj][0], v1 = acc[ai][bj][m][1] * r + bv[bj][1];
                    u32x4 w; w.x = cvt_pk_bf16(v0[0], v0[1]); w.y = cvt_pk_bf16(v0[2], v0[3]); w.z = cvt_pk_bf16(v1[0], v1[1]); w.w = cvt_pk_bf16(v1[2], v1[3]);
                    *(u32x4*)(rowp + bj * HALF) = w;
                    if (bj == 1 && col0 + HALF == PC_DT) { *(f32x4*)(dtraw + (size_t)row * 8) = v0; *(f32x4*)(dtraw + (size_t)row * 8 + 4) = v1; } } }
    }
};
struct EpiRes {
    static constexpr bool PERM = false;
    const float* base; float* out; const float* gate;
    bf16_t* hb; const float* ng; const float* sc; unsigned long long* rowsq;
    __device__ __forceinline__ void operator()(Acc& acc, const Unit& u, const Order&, int wr, int wc, int fr, int fq, LAS unsigned char*, int, int lane) const {
        const int row0 = u.pm * BM + wr * 64 + fr, col0 = u.pn * BM + wc * 32 + 4 * fq, b = (u.pm * BM) / SEQ;
        const float* gp = gate + (size_t)b * 6144 + col0;
        f32x4 gv[2][2], gm[2][2];
        {
            f32x4 nv[2][2], sv[2][2];
#pragma unroll
            for (int bj = 0; bj < 2; ++bj)
#pragma unroll
                for (int n = 0; n < 2; ++n) { gv[bj][n] = *(const f32x4*)(gp + bj * HALF + n * 16);
                    nv[bj][n] = hb ? *(const f32x4*)(ng + col0 + bj * HALF + n * 16) : (f32x4){0.f, 0.f, 0.f, 0.f};
                    sv[bj][n] = hb ? *(const f32x4*)(sc + (size_t)b * 6144 + col0 + bj * HALF + n * 16) : (f32x4){0.f, 0.f, 0.f, 0.f}; }
#pragma unroll
            for (int bj = 0; bj < 2; ++bj)
#pragma unroll
                for (int n = 0; n < 2; ++n) gm[bj][n] = nv[bj][n] * (sv[bj][n] + 1.f);
        }
        constexpr int EPI_PF = 2;
        f32x4 bsv[8][2][2];
#define RES_LOAD(k) do { const size_t off_ = (size_t)(row0 + ((k) >> 2) * HALF + ((k) & 3) * 16) * D + col0; \
            _Pragma("unroll") for (int bj = 0; bj < 2; ++bj) _Pragma("unroll") for (int n = 0; n < 2; ++n) bsv[k][bj][n] = *(const f32x4*)(base + off_ + bj * HALF + n * 16); } while (0)
#pragma unroll
        for (int k = 0; k < EPI_PF; ++k) RES_LOAD(k);
#pragma unroll
        for (int k = 0; k < 8; ++k) { const int ai = k >> 2, m = k & 3; const int row = row0 + ai * HALF + m * 16; const size_t off = (size_t)row * D + col0; float ss = 0.f;
            f32x4 v[2][2];
#pragma unroll
            for (int bj = 0; bj < 2; ++bj)
#pragma unroll
                for (int n = 0; n < 2; ++n) v[bj][n] = bsv[k][bj][n] + gv[bj][n] * acc[ai][bj][m][n];
            if (k + EPI_PF < 8) RES_LOAD(k + EPI_PF);
#pragma unroll
            for (int bj = 0; bj < 2; ++bj)
#pragma unroll
                for (int n = 0; n < 2; ++n) { const f32x4 vv = v[bj][n];
                    *(f32x4*)(out + off + bj * HALF + n * 16) = vv;
                    if (hb) { ss += (vv.x * vv.x + vv.y * vv.y) + (vv.z * vv.z + vv.w * vv.w); const f32x4 hv = vv * gm[bj][n];
                        u32x2 w; w.x = cvt_pk_bf16(hv.x, hv.y); w.y = cvt_pk_bf16(hv.z, hv.w); *(u32x2*)(hb + off + bj * HALF + n * 16) = w; } }
            if (hb) { ss += shx(ss, 16, lane); ss += shx(ss, 32, lane); if (fq == 0) atomicAdd(rowsq + row, (unsigned long long)(ss * RSQ_SCALE + 0.5f)); }
        }
#undef RES_LOAD
    }
};
struct EpiMla {
    static constexpr bool PERM = true;
    bf16_t* Q; bf16_t* KV; const float* rs; int isq_;
    __device__ __forceinline__ void operator()(Acc& acc, const Unit& u, const Order&, int wr, int wc, int fr, int fq, LAS unsigned char*, int, int) const {
        const bool isq = isq_ != 0;
        const int row0 = u.pm * BM + wr * 64 + fr, col0 = u.pn * BM + wc * 32 + 8 * fq;
        bf16_t* O = isq ? Q : KV; const int ldo = isq ? 384 : 512; const float* rsp = isq ? rs : rs + M; const float scale = isq ? MLA_QSCALE : 1.f;
        float r8[2][4];
#pragma unroll
        for (int ai = 0; ai < 2; ++ai)
#pragma unroll
            for (int m = 0; m < 4; ++m) r8[ai][m] = rsp[row0 + ai * HALF + m * 16];
#pragma unroll
        for (int ai = 0; ai < 2; ++ai)
#pragma unroll
            for (int m = 0; m < 4; ++m) { const int row = row0 + ai * HALF + m * 16; const float r = r8[ai][m] * scale;
#pragma unroll
                for (int bj = 0; bj < 2; ++bj) { const int c8 = col0 + bj * HALF; if (c8 < ldo) { const f32x4 v0 = acc[ai][bj][m][0] * r, v1 = acc[ai][bj][m][1] * r;
                    u32x4 w; w.x = cvt_pk_bf16(v0[0], v0[1]); w.y = cvt_pk_bf16(v0[2], v0[3]); w.z = cvt_pk_bf16(v1[0], v1[1]); w.w = cvt_pk_bf16(v1[2], v1[3]);
                    *(u32x4*)(O + (size_t)row * ldo + c8) = w; } } }
    }
};
#define DPPR(src, ctrl) __builtin_bit_cast(float, __builtin_amdgcn_update_dpp(0, __builtin_bit_cast(int, (float)(src)), (ctrl), 0xf, 0xf, true))
#define DPPF(old, src, ctrl) __builtin_bit_cast(float, __builtin_amdgcn_update_dpp(__builtin_bit_cast(int, (float)(old)), __builtin_bit_cast(int, (float)(src)), (ctrl), 0xf, 0xf, false))
struct EpiUp {
    static constexpr bool PERM = true;
    bf16_t* O; const float* cw; const float* cb;
    const unsigned long long* rowsq; const float* bias;
    __device__ __forceinline__ void operator()(Acc& acc, const Unit& u, const Order&, int wr, int wc, int fr, int fq, LAS unsigned char* lds, int, int) const {
        LAS float* bnd = (LAS float*)(lds + LDS_EXTRA);
        const int cl = wc * 32 + 8 * fq;
        {
            const int bq = u.pm / 17, tq0 = (u.pm % 17) * 254 - 2;
            const float* bp = bias + (size_t)bq * (2 * DFF) + u.pn * BM + cl;
            f32x4 bv[2][2];
#pragma unroll
            for (int bj = 0; bj < 2; ++bj) { bv[bj][0] = *(const f32x4*)(bp + bj * HALF); bv[bj][1] = *(const f32x4*)(bp + bj * HALF + 4); }
#pragma unroll
            for (int ai = 0; ai < 2; ++ai)
#pragma unroll
                for (int m = 0; m < 4; ++m) { int gr = bq * SEQ + tq0 + ai * HALF + wr * 64 + m * 16 + fr; gr = gr < 0 ? 0 : (gr > M - 1 ? M - 1 : gr);
                    const float r = __builtin_amdgcn_rsqf((float)rowsq[gr] * (1.f / RSQ_SCALE) * (1.f / D) + EPS);
#pragma unroll
                    for (int bj = 0; bj < 2; ++bj) { acc[ai][bj][m][0] = acc[ai][bj][m][0] * r + bv[bj][0]; acc[ai][bj][m][1] = acc[ai][bj][m][1] * r + bv[bj][1]; } }
        }
        if (fr >= 14) {
#pragma unroll
            for (int ai = 0; ai < 2; ++ai)
#pragma unroll
                for (int bj = 0; bj < 2; ++bj)
#pragma unroll
                    for (int n = 0; n < 2; ++n) *(LAS f32x4*)(bnd + ((ai * 2 + wr) * 2 + (fr - 14)) * 256 + bj * HALF + cl + 4 * n) = acc[ai][bj][3][n];
        }
        asm volatile("s_waitcnt lgkmcnt(0)" ::: "memory"); __builtin_amdgcn_s_barrier(); asm volatile("" ::: "memory");
        const int b = u.pm / 17, t0 = (u.pm % 17) * 254 - 2;
        const int ch0 = u.pn * HALF + cl;
#pragma unroll
        for (int ai = 0; ai < 2; ++ai) {
        u32x2 stash[4];
#pragma unroll
        for (int n = 0; n < 2; ++n) {
            f32x4 w0[2], w1[2], w2[2], bb[2];
#pragma unroll
            for (int bj = 0; bj < 2; ++bj) { const int cc = bj * DFF + ch0 + 4 * n;
                w0[bj] = *(const f32x4*)(cw + cc); w1[bj] = *(const f32x4*)(cw + 2 * DFF + cc); w2[bj] = *(const f32x4*)(cw + 4 * DFF + cc); bb[bj] = *(const f32x4*)(cb + cc); }
#pragma unroll
                for (int m = 0; m < 4; ++m) {
                    f32x4 uu[2];
#pragma unroll
                    for (int bj = 0; bj < 2; ++bj) {
                        const f32x4 v = acc[ai][bj][m][n];
                        f32x4 pv;
                        if (m > 0) pv = acc[ai][bj][m - 1][n];
                        else if (wr == 1 || ai == 1) { const int src = (wr == 1) ? (ai * 2 + 0) : (0 * 2 + 1); pv = *(const LAS f32x4*)(bnd + (src * 2 + ((fr - 14) & 1)) * 256 + bj * HALF + cl + 4 * n); }
                        else pv = (f32x4){0.f, 0.f, 0.f, 0.f};
                        f32x4 p1, p2;
#pragma unroll
                        for (int j = 0; j < 4; ++j) { const float c1 = (fr == 15) ? pv[j] : v[j], c2 = (fr >= 14) ? pv[j] : v[j];
                            p1[j] = DPPR(c1, 0x121); p2[j] = DPPR(c2, 0x122); }
                        if (ai == 0 && m == 0 && wr == 0 && t0 < 0) { const int tq = t0 + fr; if (tq < 1) p1 = (f32x4){0.f, 0.f, 0.f, 0.f}; if (tq < 2) p2 = (f32x4){0.f, 0.f, 0.f, 0.f}; }
                        uu[bj] = bb[bj] + w2[bj] * v + w1[bj] * p1 + w0[bj] * p2;
                    }
                    const int r = ai * HALF + wr * 64 + m * 16 + fr, t = t0 + r;
                    f32x4 o;
#pragma unroll
                    for (int j = 0; j < 4; ++j) o[j] = silu_f(uu[0][j]) * uu[1][j];
                    if (n == 0) { stash[m].x = cvt_pk_bf16(o[0], o[1]); stash[m].y = cvt_pk_bf16(o[2], o[3]); }
                    else if (r >= 2 && t < SEQ) { u32x4 w; w.x = stash[m].x; w.y = stash[m].y; w.z = cvt_pk_bf16(o[0], o[1]); w.w = cvt_pk_bf16(o[2], o[3]);
                        *(u32x4*)(O + ((size_t)b * SEQ + t) * DFF + ch0) = w; }
                    asm volatile("" ::: "memory");
                }
        }
        }
    }
};
}

struct Args {
    const float* x; const float* c; const int* pos;
    const float* ada_w; const float* ada_b; const float* n1g; const float* n2g; const float* w_in;
    const float* sconv_w; const float* sconv_b; const float* dt_bias; const float* a_log; const float* ssd_d; const float* ssd_ng;
    const float* qng; const float* w_uq; const float* kvng; const float* w_ukv; const float* sinks; const float* w_out;
    const float* w_up; const float* fconv_w; const float* fconv_b; const float* w_dn; const float* fng;
    float* out; unsigned char* ws; int ph_lo, ph_hi, wv, pad2;
};

__device__ __forceinline__ void phase_mod(const Args& a, LAS unsigned char* lds, int G) {
    LAS float* cact = (LAS float*)lds;
    LAS float* red = (LAS float*)(lds + 32768);
    const int tid = tid_opaque(a.wv), lane = tid & 63, wave = __builtin_amdgcn_readfirstlane(tid >> 6);
    for (int i = tid; i < 8 * 1024; i += 512) cact[i] = silu_f(a.c[i]);
    __syncthreads();
    float* mod = (float*)(a.ws + WS_MOD);
    for (int item = blockIdx.x; item < 4 * 96; item += G) {
        const int l = item / 96, col = (item % 96) * 64 + lane;
        const float* W = a.ada_w + (size_t)l * 1024 * 6144 + col;
        float s[8];
#pragma unroll
        for (int b = 0; b < 8; ++b) s[b] = 0.f;
        for (int k0 = wave * 128; k0 < wave * 128 + 128; k0 += 16) { float wv16[16];
#pragma unroll
            for (int q = 0; q < 16; ++q) wv16[q] = W[(size_t)(k0 + q) * 6144];
#pragma unroll
            for (int q = 0; q < 16; ++q)
#pragma unroll
                for (int b = 0; b < 8; ++b) s[b] += cact[b * 1024 + k0 + q] * wv16[q]; }
#pragma unroll
        for (int b = 0; b < 8; ++b) red[(wave * 8 + b) * 64 + lane] = s[b];
        __syncthreads();
        float t = 0.f;
#pragma unroll
        for (int w = 0; w < 8; ++w) t += red[(w * 8 + wave) * 64 + lane];
        mod[((size_t)l * 8 + wave) * 6144 + col] = t + a.ada_b[(size_t)l * 6144 + col];
        __syncthreads();
    }
}
__device__ __forceinline__ void phase_rope(const Args& a, int G) {
    float* rope = (float*)(a.ws + WS_ROPE);
    for (int idx = blockIdx.x * 512 + tid_opaque(a.wv); idx < M * 16; idx += G * 512) {
        const int row = idx >> 4, i = idx & 15;
        float inv = 1.778279402e-04f;
        inv = (i == 14) ? 3.162277571e-04f : inv;
        inv = (i == 13) ? 5.623413017e-04f : inv;
        inv = (i == 12) ? 1.000000047e-03f : inv;
        inv = (i == 11) ? 1.778279431e-03f : inv;
        inv = (i == 10) ? 3.162277630e-03f : inv;
        inv = (i == 9) ? 5.623413250e-03f : inv;
        inv = (i == 8) ? 9.999999776e-03f : inv;
        inv = (i == 7) ? 1.778279431e-02f : inv;
        inv = (i == 6) ? 3.162277490e-02f : inv;
        inv = (i == 5) ? 5.623413250e-02f : inv;
        inv = (i == 4) ? 1.000000015e-01f : inv;
        inv = (i == 3) ? 1.778279394e-01f : inv;
        inv = (i == 2) ? 3.162277639e-01f : inv;
        inv = (i == 1) ? 5.623413324e-01f : inv;
        inv = (i == 0) ? 1.000000000e+00f : inv;
        const float ang = (float)a.pos[row] * inv;
        const double rev = (double)ang * 0.15915494309189535;
        const float fr = (float)(rev - (double)(int)rev);
        rope[(size_t)row * 32 + i] = __builtin_amdgcn_cosf(fr);
        rope[(size_t)row * 32 + 16 + i] = __builtin_amdgcn_sinf(fr);
    }
}
enum { MAP_ID = 0, MAP_IN = 1, MAP_UP = 2, MAP_UQ = 3, MAP_ZERO = 4 };
__device__ __forceinline__ int map_col(int kind, int n) {
    if (kind == MAP_ID) return n;
    if (kind == MAP_ZERO) return -1;
    if (kind == MAP_IN) {
        if (n < 1536) return n;
        if (n < 1920) return n + 8;
        if (n < 1952) { const int e = n - 1920; return 1928 + 16 * (e & 1) + (e >> 1); }
        if (n < 2464) return n + 8;
        if (n < 2472) return n - 2464 + 1536;
        return -1;
    }
    if (kind == MAP_UP) { const int pn = n >> 8, cl = n & 255; return cl < 128 ? pn * 128 + cl : DFF + pn * 128 + (cl - 128); }
    if (n >= 384) return -1;
    { const int h = n / 96, d = n % 96; if (d < 64) return h * 96 + d; const int e = d - 64; return h * 96 + 64 + 16 * (e & 1) + (e >> 1); }
}
__device__ __forceinline__ void tr_item(const float* W, int N, int ks0, bf16_t* WT, int Kd, int kd0, int n0, int kind, const float* ksc, LAS float* scr, int lane) {
    const int src = map_col(kind, n0 + (lane & 31));
    const int srcc = src < 0 ? 0 : src; const float msk = src < 0 ? 0.f : 1.f;
    float vals[32];
#pragma unroll
    for (int i = 0; i < 32; ++i) vals[i] = W[(size_t)(ks0 + 2 * i + (lane >> 5)) * N + srcc];
    if (ksc) {
#pragma unroll
        for (int i = 0; i < 32; ++i) vals[i] *= ksc[ks0 + 2 * i + (lane >> 5)];
    }
#pragma unroll
    for (int i = 0; i < 32; ++i) scr[(2 * i + (lane >> 5)) * 33 + (lane & 31)] = vals[i] * msk;
    asm volatile("s_waitcnt lgkmcnt(0)" ::: "memory");
    const int c = lane & 7;
#pragma unroll
    for (int j = 0; j < 4; ++j) { const int n = (lane >> 3) + 8 * j; const LAS float* s = scr + (8 * c) * 33 + n;
        u32x4 o; o.x = pk2(s[0 * 33], s[1 * 33]); o.y = pk2(s[2 * 33], s[3 * 33]); o.z = pk2(s[4 * 33], s[5 * 33]); o.w = pk2(s[6 * 33], s[7 * 33]);
        *(u32x4*)(WT + (size_t)(n0 + n) * Kd + kd0 + 8 * c) = o; }
    asm volatile("s_waitcnt lgkmcnt(0)" ::: "memory");
}
__device__ __forceinline__ void phase_weights(const Args& a, int l, unsigned char* wb, LAS unsigned char* lds, int G) {
    const int tid_ = tid_opaque(a.wv), lane = tid_ & 63, wave = tid_ >> 6;
    LAS float* scr = (LAS float*)(lds + wave * 16384);
    constexpr int I_IN = 16 * 80, I_OUT = 16 * 32, I_UP = 16 * 176, I_DN = 44 * 32, I_QKV = 4 * 16 + 2 * 16;
    constexpr int NIT = I_IN + I_OUT + I_UP + I_DN + I_QKV;
    for (int it = blockIdx.x * 8 + wave; it < NIT; it += G * 8) {
        int r = it;
        if (r < I_IN) { tr_item(a.w_in + (size_t)l * D * DIN, DIN, 64 * (r / 80), (bf16_t*)(wb + WO_IN), D, 64 * (r / 80), 32 * (r % 80), MAP_IN, nullptr, scr, lane); continue; } r -= I_IN;
        if (r < I_OUT) { tr_item(a.w_out + (size_t)l * D * D, D, 64 * (r / 32), (bf16_t*)(wb + WO_OUT), D, 64 * (r / 32), 32 * (r % 32), MAP_ID, nullptr, scr, lane); continue; } r -= I_OUT;
        if (r < I_UP) { tr_item(a.w_up + (size_t)l * D * 2 * DFF, 2 * DFF, 64 * (r / 176), (bf16_t*)(wb + WO_UP), D, 64 * (r / 176), 32 * (r % 176), MAP_UP, nullptr, scr, lane); continue; } r -= I_UP;
        if (r < I_DN) { tr_item(a.w_dn + (size_t)l * DFF * D, D, 64 * (r / 32), (bf16_t*)(wb + WO_DN), DFF, 64 * (r / 32), 32 * (r % 32), MAP_ID, nullptr, scr, lane); continue; } r -= I_DN;
        { if (r < 4 * 16) tr_item(a.w_uq + (size_t)l * 256 * 384, 384, 64 * (r / 16), (bf16_t*)(wb + WO_UQ), 256, 64 * (r / 16), 32 * (r % 16), MAP_UQ, a.qng + l * 256, scr, lane);
          else { r -= 64; tr_item(a.w_ukv + (size_t)l * 128 * 512, 512, 64 * (r / 16), (bf16_t*)(wb + WO_UKV), 128, 64 * (r / 16), 32 * (r % 16), MAP_ID, a.kvng + l * 128, scr, lane); } }
    }
}

__device__ __forceinline__ void phase_bias(const Args& a, int l, float* bias, LAS unsigned char* lds, int G) {
    LAS float* shv = (LAS float*)lds;
    LAS float* red = (LAS float*)(lds + 65536);
    const int tid = tid_opaque(a.wv), lane = tid & 63, wave = __builtin_amdgcn_readfirstlane(tid >> 6);
    const float* ml = (const float*)(a.ws + WS_MOD) + (size_t)l * 8 * 6144;
    __syncthreads();
    for (int i = tid; i < 2 * 8 * 1024; i += 512) { const int which = i >> 13, b = (i >> 10) & 7, k = i & 1023; shv[i] = ml[(size_t)b * 6144 + (which ? 3072 : 0) + k]; }
    __syncthreads();
    for (int item = blockIdx.x; item < 80 + 176; item += G) {
        const bool up = item >= 80; const int n = (up ? item - 80 : item) * 32 + (lane & 31), N = up ? 2 * DFF : DIN;
        const int src = map_col(up ? MAP_UP : MAP_IN, n);
        const float* W = (up ? a.w_up + (size_t)l * D * 2 * DFF : a.w_in + (size_t)l * D * DIN) + (src < 0 ? 0 : src);
        const LAS float* sv = shv + (up ? 8192 : 0);
        float s8[8];
#pragma unroll
        for (int b = 0; b < 8; ++b) s8[b] = 0.f;
        const int kb = wave * 128 + (lane >> 5) * 64;
        for (int k0 = kb; k0 < kb + 64; k0 += 16) { float wv16[16];
#pragma unroll
            for (int q = 0; q < 16; ++q) wv16[q] = W[(size_t)(k0 + q) * N];
#pragma unroll
            for (int q = 0; q < 16; ++q)
#pragma unroll
                for (int b = 0; b < 8; ++b) s8[b] += sv[b * 1024 + k0 + q] * wv16[q]; }
#pragma unroll
        for (int b = 0; b < 8; ++b) { s8[b] += shx(s8[b], 32, lane); red[(wave * 8 + b) * 64 + lane] = s8[b]; }
        __syncthreads();
        if (lane < 32) { float t = 0.f;
#pragma unroll
            for (int w = 0; w < 8; ++w) t += red[(w * 8 + wave) * 64 + lane];
            (up ? bias + 8 * NPROJ : bias)[(size_t)wave * (up ? 2 * DFF : NPROJ) + n] = src < 0 ? 0.f : t; }
        __syncthreads();
    }
}
__device__ __forceinline__ void phase_norm0(const float* xin, const float* g, const float* sc, bf16_t* hout, unsigned long long* rowsq, int G, int wv) {
    const int tid_ = tid_opaque(wv), lane = tid_ & 63, wave = tid_ >> 6;
    for (int row = blockIdx.x * 8 + wave; row < M; row += G * 8) {
        const int b = row / SEQ;
        const f32x4* xr = (const f32x4*)(xin + (size_t)row * D) + lane;
        f32x4 v[4]; float s = 0.f;
#pragma unroll
        for (int j = 0; j < 4; ++j) { v[j] = xr[64 * j]; s += (v[j].x * v[j].x + v[j].y * v[j].y) + (v[j].z * v[j].z + v[j].w * v[j].w); }
        s = wave_sum(s, lane);
        if (lane == 0) rowsq[row] = (unsigned long long)(s * RSQ_SCALE + 0.5f);
        u32x2* o8 = (u32x2*)(hout + (size_t)row * D) + lane;
#pragma unroll
        for (int j = 0; j < 4; ++j) { const int col = 4 * lane + 256 * j;
            const f32x4 y = v[j] * *(const f32x4*)(g + col) * (*(const f32x4*)(sc + (size_t)b * 6144 + col) + 1.f);
            u32x2 w; w.x = cvt_pk_bf16(y.x, y.y); w.y = cvt_pk_bf16(y.z, y.w); o8[64 * j] = w; }
    }
}
__device__ __forceinline__ void phase_final(float* x, const float* g, int G, int wv) {
    const int tid_ = tid_opaque(wv), lane = tid_ & 63, wave = tid_ >> 6;
    for (int row = blockIdx.x * 8 + wave; row < M; row += G * 8) {
        f32x4* xr = (f32x4*)(x + (size_t)row * D) + lane;
        f32x4 v[4]; float s = 0.f;
#pragma unroll
        for (int j = 0; j < 4; ++j) { v[j] = xr[64 * j]; s += (v[j].x * v[j].x + v[j].y * v[j].y) + (v[j].z * v[j].z + v[j].w * v[j].w); }
        const float r = 1.f / sqrtf(wave_sum(s, lane) * (1.f / D) + EPS);
#pragma unroll
        for (int j = 0; j < 4; ++j) { const f32x4 gg = *(const f32x4*)(g + 4 * lane + 256 * j); xr[64 * j] = v[j] * r * gg; }
    }
}
__device__ __forceinline__ void phase_prep(const Args& a, int l, int G) {
    const int tid_ = tid_opaque(a.wv), lane = tid_ & 63, wave = tid_ >> 6;
    const bf16_t* proj = (const bf16_t*)(a.ws + WS_PROJ);
    bf16_t* xbc = (bf16_t*)(a.ws + WS_H);
    const float* cw = a.sconv_w + (size_t)l * 4 * 1024; const float* cb = a.sconv_b + (size_t)l * 1024;
    const float* dtraw = (const float*)(a.ws + WS_DTRAW); float* dtsp = (float*)(a.ws + WS_DTSP);
    float* rq = (float*)(a.ws + WS_RS); float* rkv = rq + M; unsigned long long* rsq = (unsigned long long*)(a.ws + WS_RSQ);
    const float* rope = (const float*)(a.ws + WS_ROPE); bf16_t* kr = (bf16_t*)(a.ws + WS_KR);
    f32x4 wk[2][4][2], bk[2][2];
#pragma unroll
    for (int j = 0; j < 2; ++j) { const int ch = 8 * lane + 512 * j; bk[j][0] = *(const f32x4*)(cb + ch); bk[j][1] = *(const f32x4*)(cb + ch + 4);
#pragma unroll
        for (int k = 0; k < 4; ++k) { wk[j][k][0] = *(const f32x4*)(cw + k * 1024 + ch); wk[j][k][1] = *(const f32x4*)(cw + k * 1024 + ch + 4); } }
    const float dtb = lane < 8 ? a.dt_bias[l * 8 + lane] : 0.f;
    for (int run = blockIdx.x * 8 + wave; run < M / 16; run += G * 8) {
        const int rowb = run * 16, tb = rowb % SEQ;
        u32x4 win[2][3];
#pragma unroll
        for (int j = 0; j < 2; ++j)
#pragma unroll
            for (int k = 0; k < 3; ++k) { win[j][k] = (u32x4){0u, 0u, 0u, 0u}; if (tb - 3 + k >= 0) win[j][k] = *(const u32x4*)(proj + (size_t)(rowb - 3 + k) * NPROJ + PC_X + 8 * lane + 512 * j); }
        for (int r4 = 0; r4 < 16; r4 += 4) {
            u32x4 curv[4][2], cqv[4]; float dtr[4], rcs[4], rsn[4]; unsigned krv[4];
#pragma unroll
            for (int q = 0; q < 4; ++q) { const size_t row = (size_t)(rowb + r4 + q);
                curv[q][0] = *(const u32x4*)(proj + row * NPROJ + PC_X + 8 * lane); curv[q][1] = *(const u32x4*)(proj + row * NPROJ + PC_X + 8 * lane + 512);
                cqv[q] = (u32x4){0u, 0u, 0u, 0u}; if (lane < 48) cqv[q] = *(const u32x4*)(proj + row * NPROJ + PC_CQ + 8 * lane);
                dtr[q] = lane < 8 ? dtraw[row * 8 + lane] : 0.f;
                krv[q] = 0u; rcs[q] = 0.f; rsn[q] = 0.f;
                if (lane < 16) { krv[q] = *(const unsigned*)(proj + row * NPROJ + PC_KR + 2 * lane); rcs[q] = rope[row * 32 + lane]; rsn[q] = rope[row * 32 + 16 + lane]; } }
#pragma unroll
            for (int q = 0; q < 4; ++q) { const int row = rowb + r4 + q;
#pragma unroll
                for (int j = 0; j < 2; ++j) { const int ch = 8 * lane + 512 * j;
                    const u32x4 cur = curv[q][j];
                    f32x4 a0 = bk[j][0], a1 = bk[j][1];
#pragma unroll
                    for (int k = 0; k < 4; ++k) { const u32x4 pv = k < 3 ? win[j][k] : cur;
                        a0 += wk[j][k][0] * (f32x4){bflo(pv.x), bfhi(pv.x), bflo(pv.y), bfhi(pv.y)}; a1 += wk[j][k][1] * (f32x4){bflo(pv.z), bfhi(pv.z), bflo(pv.w), bfhi(pv.w)}; }
                    win[j][0] = win[j][1]; win[j][1] = win[j][2]; win[j][2] = cur;
                    u32x4 o; o.x = cvt_pk_bf16(silu_f(a0.x), silu_f(a0.y)); o.y = cvt_pk_bf16(silu_f(a0.z), silu_f(a0.w)); o.z = cvt_pk_bf16(silu_f(a1.x), silu_f(a1.y)); o.w = cvt_pk_bf16(silu_f(a1.z), silu_f(a1.w));
                    *(u32x4*)(xbc + (size_t)row * 1024 + ch) = o; }
                if (lane == 0) { rsq[row] = 0ull; rsq[M + row] = 0ull; }
                if (lane < 8) { const float v = dtr[q] + dtb; dtsp[(size_t)row * 8 + lane] = v > 15.f ? v : __logf(1.f + __expf(v)); }
                { const u32x4 pv = cqv[q];
                  const float f0 = bflo(pv.x), f1 = bfhi(pv.x), f2 = bflo(pv.y), f3 = bfhi(pv.y), f4 = bflo(pv.z), f5 = bfhi(pv.z), f6 = bflo(pv.w), f7 = bfhi(pv.w);
                  const float s = (f0 * f0 + f1 * f1) + (f2 * f2 + f3 * f3) + (f4 * f4 + f5 * f5) + (f6 * f6 + f7 * f7);
                  float sq = lane < 32 ? s : 0.f, sk = (lane >= 32 && lane < 48) ? s : 0.f;
                  sq = wave_sum(sq, lane); sk = wave_sum(sk, lane);
                  if (lane == 0) { rq[row] = __builtin_amdgcn_rsqf(sq * (1.f / 256.f) + EPS); rkv[row] = __builtin_amdgcn_rsqf(sk * (1.f / 128.f) + EPS); } }
                if (lane < 16) { const float x1 = bflo(krv[q]), x2 = bfhi(krv[q]);
                    *(unsigned*)(kr + (size_t)row * 32 + 2 * lane) = cvt_pk_bf16(x1 * rcs[q] - x2 * rsn[q], x1 * rsn[q] + x2 * rcs[q]); }
            }
        }
    }
}
__device__ __forceinline__ void phase_ssd_naive(const Args& a, int l, int G) {
    const int tid = tid_opaque(a.wv), pl = tid >> 5, nq = tid & 31, lane = tid & 63;
    const bf16_t* xbc = (const bf16_t*)(a.ws + WS_H);
    const bf16_t* proj = (const bf16_t*)(a.ws + WS_PROJ);
    const float* dtsp = (const float*)(a.ws + WS_DTSP);
    float* ytmp = (float*)(a.ws + WS_YS);
    for (int unit = blockIdx.x; unit < 256; unit += G) {
        const int b = unit >> 5, h = (unit >> 2) & 7, pq = unit & 3, g = h >> 2, p = pq * 16 + pl;
        const float av = -__expf(a.a_log[l * 8 + h]), dsk = a.ssd_d[l * 8 + h];
        float s0 = 0.f, s1 = 0.f, s2 = 0.f, s3 = 0.f;
        for (int t = 0; t < SEQ; ++t) {
            const size_t row = (size_t)b * SEQ + t;
            const float dt = dtsp[row * 8 + h];
            const float x = bf2f(xbc[row * 1024 + h * 64 + p]);
            const u32x2 bv = *(const u32x2*)(xbc + row * 1024 + 512 + g * 128 + 4 * nq);
            const u32x2 cv = *(const u32x2*)(xbc + row * 1024 + 768 + g * 128 + 4 * nq);
            const float dA = __expf(dt * av), xd = dt * x;
            s0 = s0 * dA + xd * bflo(bv.x); s1 = s1 * dA + xd * bfhi(bv.x); s2 = s2 * dA + xd * bflo(bv.y); s3 = s3 * dA + xd * bfhi(bv.y);
            float y = (s0 * bflo(cv.x) + s1 * bfhi(cv.x)) + (s2 * bflo(cv.y) + s3 * bfhi(cv.y));
            y += shx(y, 16, lane); y += shx(y, 8, lane); y += shx(y, 4, lane); y += shx(y, 2, lane); y += shx(y, 1, lane);
            if (nq == 0) { const float z = bf2f(proj[row * NPROJ + PC_Z + h * 64 + p]); ytmp[row * 512 + h * 64 + p] = (y + dsk * x) * silu_f(z); }
        }
    }
}
__device__ __forceinline__ void phase_ssd_norm(const Args& a, int l, int G) {
    const int tid_ = tid_opaque(a.wv), lane = tid_ & 63, wave = tid_ >> 6;
    const float* ytmp = (const float*)(a.ws + WS_YS); bf16_t* ycat = (bf16_t*)(a.ws + WS_YCAT);
    const float* ng = a.ssd_ng + l * 512;
    for (int row = blockIdx.x * 8 + wave; row < M; row += G * 8) {
        const f32x4 v0 = *(const f32x4*)(ytmp + (size_t)row * 512 + 8 * lane), v1 = *(const f32x4*)(ytmp + (size_t)row * 512 + 8 * lane + 4);
        float s = (v0.x * v0.x + v0.y * v0.y) + (v0.z * v0.z + v0.w * v0.w) + (v1.x * v1.x + v1.y * v1.y) + (v1.z * v1.z + v1.w * v1.w);
        s += shx(s, 16, lane); s += shx(s, 8, lane); s += shx(s, 4, lane); s += shx(s, 2, lane); s += shx(s, 1, lane);
        const float r = 1.f / sqrtf(s * (1.f / 256.f) + EPS);
        const f32x4 g0 = *(const f32x4*)(ng + 8 * lane), g1 = *(const f32x4*)(ng + 8 * lane + 4);
        u32x4 o; o.x = cvt_pk_bf16(v0.x * r * g0.x, v0.y * r * g0.y); o.y = cvt_pk_bf16(v0.z * r * g0.z, v0.w * r * g0.w); o.z = cvt_pk_bf16(v1.x * r * g1.x, v1.y * r * g1.y); o.w = cvt_pk_bf16(v1.z * r * g1.z, v1.w * r * g1.w);
        *(u32x4*)(ycat + (size_t)row * 1024 + 8 * lane) = o;
    }
}

constexpr size_t WS_CDEC = 399 * MiB;
__device__ __forceinline__ void phase_ssd_states(const Args& a, int l, int G) {
    const int tid = tid_opaque(a.wv), p = tid >> 3, no = tid & 7;
    const bf16_t* xbc = (const bf16_t*)(a.ws + WS_H); const float* dtsp = (const float*)(a.ws + WS_DTSP);
    float* states = (float*)(a.ws + WS_YS); float* cdec = (float*)(a.ws + WS_CDEC);
    for (int u = blockIdx.x; u < 2048; u += G) {
        const int b = u >> 8, c = (u >> 3) & 31, h = u & 7, g = h >> 2;
        const float av = -__expf(a.a_log[l * 8 + h]);
        float st[16];
#pragma unroll
        for (int j = 0; j < 16; ++j) st[j] = 0.f;
        float asum = 0.f;
        const size_t row0 = (size_t)b * SEQ + c * 128;
#pragma unroll 2
        for (int s2 = 0; s2 < 128; ++s2) { const size_t row = row0 + s2;
            const float dt = dtsp[row * 8 + h], da = dt * av, dA = __expf(da), xd = dt * bf2f(xbc[row * 1024 + h * 64 + p]);
            const u32x4 b0 = *(const u32x4*)(xbc + row * 1024 + 512 + g * 128 + 16 * no), b1 = *(const u32x4*)(xbc + row * 1024 + 512 + g * 128 + 16 * no + 8);
            asum += da;
            st[0] = st[0] * dA + xd * bflo(b0.x); st[1] = st[1] * dA + xd * bfhi(b0.x); st[2] = st[2] * dA + xd * bflo(b0.y); st[3] = st[3] * dA + xd * bfhi(b0.y);
            st[4] = st[4] * dA + xd * bflo(b0.z); st[5] = st[5] * dA + xd * bfhi(b0.z); st[6] = st[6] * dA + xd * bflo(b0.w); st[7] = st[7] * dA + xd * bfhi(b0.w);
            st[8] = st[8] * dA + xd * bflo(b1.x); st[9] = st[9] * dA + xd * bfhi(b1.x); st[10] = st[10] * dA + xd * bflo(b1.y); st[11] = st[11] * dA + xd * bfhi(b1.y);
            st[12] = st[12] * dA + xd * bflo(b1.z); st[13] = st[13] * dA + xd * bfhi(b1.z); st[14] = st[14] * dA + xd * bflo(b1.w); st[15] = st[15] * dA + xd * bfhi(b1.w); }
        float* sp = states + (size_t)u * 8192 + p * 128 + 16 * no;
#pragma unroll
        for (int j = 0; j < 4; ++j) *(f32x4*)(sp + 4 * j) = (f32x4){st[4 * j], st[4 * j + 1], st[4 * j + 2], st[4 * j + 3]};
        if (tid == 0) cdec[u] = __expf(asum);
    }
}
__device__ __forceinline__ void phase_ssd_scan(const Args& a, int G) {
    bf16_t* states = (bf16_t*)(a.ws + WS_YS); const float* cdec = (const float*)(a.ws + WS_CDEC);
    for (int e = blockIdx.x * 512 + tid_opaque(a.wv); e < 8 * 8 * 2048; e += G * 512) {
        const int b = e >> 14, h = (e >> 11) & 7, pn = e & 2047;
        f32x4 hc = (f32x4){0.f, 0.f, 0.f, 0.f};
#pragma unroll 8
        for (int c = 0; c < 32; ++c) { const int u = (b * 32 + c) * 8 + h; u32x2* sp = (u32x2*)(states + (size_t)u * 8192) + pn;
            const u32x2 v = *sp; u32x2 w; w.x = cvt_pk_bf16(hc.x, hc.y); w.y = cvt_pk_bf16(hc.z, hc.w); *sp = w;
            hc = hc * cdec[u] + (f32x4){bflo(v.x), bfhi(v.x), bflo(v.y), bfhi(v.y)}; }
    }
}
__device__ __forceinline__ void phase_ssd_out(const Args& a, int l, LAS unsigned char* lds, int G) {
    const int tid = tid_opaque(a.wv), p = tid >> 3, no = tid & 7, lane = tid & 63, wave = tid >> 6;
    const bf16_t* xbc = (const bf16_t*)(a.ws + WS_H); const bf16_t* proj = (const bf16_t*)(a.ws + WS_PROJ); const float* dtsp = (const float*)(a.ws + WS_DTSP);
    const float* states = (const float*)(a.ws + WS_YS); bf16_t* ycat = (bf16_t*)(a.ws + WS_YCAT);
    LAS float* yb = (LAS float*)lds;
    for (int u = blockIdx.x; u < 512; u += G) {
        const int b = u >> 6, c = (u >> 1) & 31, g = u & 1;
        const size_t row0 = (size_t)b * SEQ + c * 128;
        for (int hg = 0; hg < 4; ++hg) { const int h = g * 4 + hg;
            const float av = -__expf(a.a_log[l * 8 + h]), dsk = a.ssd_d[l * 8 + h];
            float st[16];
            { const float* sp = states + (size_t)((b * 32 + c) * 8 + h) * 8192 + p * 128 + 16 * no;
#pragma unroll
              for (int j = 0; j < 4; ++j) { const f32x4 v = *(const f32x4*)(sp + 4 * j); st[4 * j] = v.x; st[4 * j + 1] = v.y; st[4 * j + 2] = v.z; st[4 * j + 3] = v.w; } }
#pragma unroll 2
            for (int s2 = 0; s2 < 128; ++s2) { const size_t row = row0 + s2;
                const float dt = dtsp[row * 8 + h], dA = __expf(dt * av), x = bf2f(xbc[row * 1024 + h * 64 + p]), xd = dt * x;
                const bf16_t* bp = xbc + row * 1024 + 512 + g * 128 + 16 * no;
                const u32x4 b0 = *(const u32x4*)bp, b1 = *(const u32x4*)(bp + 8), c0 = *(const u32x4*)(bp + 256), c1 = *(const u32x4*)(bp + 264);
                st[0] = st[0] * dA + xd * bflo(b0.x); st[1] = st[1] * dA + xd * bfhi(b0.x); st[2] = st[2] * dA + xd * bflo(b0.y); st[3] = st[3] * dA + xd * bfhi(b0.y);
                st[4] = st[4] * dA + xd * bflo(b0.z); st[5] = st[5] * dA + xd * bfhi(b0.z); st[6] = st[6] * dA + xd * bflo(b0.w); st[7] = st[7] * dA + xd * bfhi(b0.w);
                st[8] = st[8] * dA + xd * bflo(b1.x); st[9] = st[9] * dA + xd * bfhi(b1.x); st[10] = st[10] * dA + xd * bflo(b1.y); st[11] = st[11] * dA + xd * bfhi(b1.y);
                st[12] = st[12] * dA + xd * bflo(b1.z); st[13] = st[13] * dA + xd * bfhi(b1.z); st[14] = st[14] * dA + xd * bflo(b1.w); st[15] = st[15] * dA + xd * bfhi(b1.w);
                float y = ((st[0] * bflo(c0.x) + st[1] * bfhi(c0.x)) + (st[2] * bflo(c0.y) + st[3] * bfhi(c0.y))) + ((st[4] * bflo(c0.z) + st[5] * bfhi(c0.z)) + (st[6] * bflo(c0.w) + st[7] * bfhi(c0.w)))
                        + ((st[8] * bflo(c1.x) + st[9] * bfhi(c1.x)) + (st[10] * bflo(c1.y) + st[11] * bfhi(c1.y))) + ((st[12] * bflo(c1.z) + st[13] * bfhi(c1.z)) + (st[14] * bflo(c1.w) + st[15] * bfhi(c1.w)));
                y += shx(y, 4, lane); y += shx(y, 2, lane); y += shx(y, 1, lane);
                if (no == 0) { const float z = bf2f(proj[row * NPROJ + PC_Z + h * 64 + p]); yb[s2 * 256 + hg * 64 + p] = (y + dsk * x) * silu_f(z); }
            }
        }
        __syncthreads();
        const float* ng = a.ssd_ng + l * 512 + g * 256;
        const f32x4 gg = *(const f32x4*)(ng + 4 * lane);
        for (int tk = wave; tk < 128; tk += 8) {
            const f32x4 v = *(const LAS f32x4*)(yb + tk * 256 + 4 * lane);
            const float sq = wave_sum((v.x * v.x + v.y * v.y) + (v.z * v.z + v.w * v.w), lane);
            const float r = 1.f / sqrtf(sq * (1.f / 256.f) + EPS);
            u32x2 w; w.x = cvt_pk_bf16(v.x * r * gg.x, v.y * r * gg.y); w.y = cvt_pk_bf16(v.z * r * gg.z, v.w * r * gg.w);
            *(u32x2*)(ycat + (row0 + tk) * 1024 + g * 256 + 4 * lane) = w;
        }
        __syncthreads();
    }
}

__device__ __forceinline__ void phase_mla_naive(const Args& a, int G) {
    const int tid_ = tid_opaque(a.wv), lane = tid_ & 63, wave = tid_ >> 6;
    const bf16_t* qb = (const bf16_t*)(a.ws + WS_Q); const bf16_t* kv = (const bf16_t*)(a.ws + WS_KV); const bf16_t* kr = (const bf16_t*)(a.ws + WS_KR);
    bf16_t* ycat = (bf16_t*)(a.ws + WS_YCAT);
    for (int blk = blockIdx.x; blk < 256; blk += G) {
        const int bh = blk >> 3, s = blk & 7, b = bh >> 2, h = bh & 3;
        const int c = (wave & 1) ? (16 * (wave >> 1) + 15 - s) : (16 * (wave >> 1) + s);
        const int t = c * 64 + lane; const size_t row = (size_t)b * SEQ + t;
        u32x4 qw[12];
#pragma unroll
        for (int i = 0; i < 12; ++i) qw[i] = *(const u32x4*)(qb + row * 384 + h * 96 + 8 * i);
        { const float* rp = (const float*)(a.ws + WS_ROPE) + row * 32;
#pragma unroll
          for (int i = 0; i < 4; ++i) { const f32x4 cs = *(const f32x4*)(rp + 4 * i), sn = *(const f32x4*)(rp + 16 + 4 * i); u32x4 w = qw[8 + i];
              w.x = cvt_pk_bf16(bflo(w.x) * cs.x - bfhi(w.x) * sn.x, bflo(w.x) * sn.x + bfhi(w.x) * cs.x); w.y = cvt_pk_bf16(bflo(w.y) * cs.y - bfhi(w.y) * sn.y, bflo(w.y) * sn.y + bfhi(w.y) * cs.y);
              w.z = cvt_pk_bf16(bflo(w.z) * cs.z - bfhi(w.z) * sn.z, bflo(w.z) * sn.z + bfhi(w.z) * cs.z); w.w = cvt_pk_bf16(bflo(w.w) * cs.w - bfhi(w.w) * sn.w, bflo(w.w) * sn.w + bfhi(w.w) * cs.w);
              qw[8 + i] = w; } }
        float o[64];
#pragma unroll
        for (int i = 0; i < 64; ++i) o[i] = 0.f;
        float mx = -1e30f, ls = 0.f;
        const int jend = c * 64 + 63;
        for (int j = 0; j <= jend; ++j) {
            const size_t rj = (size_t)b * SEQ + j;
            const bf16_t* kp = kv + rj * 512 + h * 128; const bf16_t* krp = kr + rj * 32;
            float sc = 0.f;
#pragma unroll
            for (int i = 0; i < 8; ++i) { const u32x4 w = *(const u32x4*)(kp + 8 * i); const u32x4 qq = qw[i];
                sc += bflo(qq.x) * bflo(w.x) + bfhi(qq.x) * bfhi(w.x) + bflo(qq.y) * bflo(w.y) + bfhi(qq.y) * bfhi(w.y) + bflo(qq.z) * bflo(w.z) + bfhi(qq.z) * bfhi(w.z) + bflo(qq.w) * bflo(w.w) + bfhi(qq.w) * bfhi(w.w); }
#pragma unroll
            for (int i = 0; i < 4; ++i) { const u32x4 w = *(const u32x4*)(krp + 8 * i); const u32x4 qq = qw[8 + i];
                sc += bflo(qq.x) * bflo(w.x) + bfhi(qq.x) * bfhi(w.x) + bflo(qq.y) * bflo(w.y) + bfhi(qq.y) * bfhi(w.y) + bflo(qq.z) * bflo(w.z) + bfhi(qq.z) * bfhi(w.z) + bflo(qq.w) * bflo(w.w) + bfhi(qq.w) * bfhi(w.w); }
            if (j <= t) {
                const float mn = fmaxf(mx, sc), f = exp2f(mx - mn), p = exp2f(sc - mn);
                ls = ls * f + p; mx = mn;
#pragma unroll
                for (int i = 0; i < 8; ++i) { const u32x4 w = *(const u32x4*)(kp + 64 + 8 * i);
                    o[8 * i] = o[8 * i] * f + p * bflo(w.x); o[8 * i + 1] = o[8 * i + 1] * f + p * bfhi(w.x); o[8 * i + 2] = o[8 * i + 2] * f + p * bflo(w.y); o[8 * i + 3] = o[8 * i + 3] * f + p * bfhi(w.y);
                    o[8 * i + 4] = o[8 * i + 4] * f + p * bflo(w.z); o[8 * i + 5] = o[8 * i + 5] * f + p * bfhi(w.z); o[8 * i + 6] = o[8 * i + 6] * f + p * bflo(w.w); o[8 * i + 7] = o[8 * i + 7] * f + p * bfhi(w.w); }
            }
        }
        const float il = 1.f / ls;
#pragma unroll
        for (int i = 0; i < 8; ++i) { u32x4 w; w.x = cvt_pk_bf16(o[8 * i] * il, o[8 * i + 1] * il); w.y = cvt_pk_bf16(o[8 * i + 2] * il, o[8 * i + 3] * il); w.z = cvt_pk_bf16(o[8 * i + 4] * il, o[8 * i + 5] * il); w.w = cvt_pk_bf16(o[8 * i + 6] * il, o[8 * i + 7] * il);
            *(u32x4*)(ycat + row * 1024 + 512 + h * 64 + 8 * i) = w; }
    }
}
__device__ __forceinline__ void phase_swa_naive(const Args& a, int l, int G) {
    const int tid_ = tid_opaque(a.wv), lane = tid_ & 63, wave = tid_ >> 6;
    const bf16_t* proj = (const bf16_t*)(a.ws + WS_PROJ); bf16_t* ycat = (bf16_t*)(a.ws + WS_YCAT);
    for (int blk = blockIdx.x; blk < 256; blk += G) {
        const int bh = blk >> 3, b = bh >> 2, h = bh & 3, c = (blk & 7) * 8 + wave, hk = h >> 1;
        const int t = c * 64 + lane; const size_t row = (size_t)b * SEQ + t;
        u32x4 qw[8];
#pragma unroll
        for (int i = 0; i < 8; ++i) qw[i] = *(const u32x4*)(proj + row * NPROJ + PC_SQ + h * 64 + 8 * i);
        float o[64];
#pragma unroll
        for (int i = 0; i < 64; ++i) o[i] = 0.f;
        float mx = a.sinks[l * 4 + h] * LOG2E, ls = 1.f;
        const int j0 = (c * 64 - 127) > 0 ? (c * 64 - 127) : 0, jend = c * 64 + 63;
        for (int j = j0; j <= jend; ++j) {
            const size_t rj = (size_t)b * SEQ + j;
            const bf16_t* kp = proj + rj * NPROJ + PC_SK + hk * 64; const bf16_t* vp = proj + rj * NPROJ + PC_SV + hk * 64;
            float sc = 0.f;
#pragma unroll
            for (int i = 0; i < 8; ++i) { const u32x4 w = *(const u32x4*)(kp + 8 * i); const u32x4 qq = qw[i];
                sc += bflo(qq.x) * bflo(w.x) + bfhi(qq.x) * bfhi(w.x) + bflo(qq.y) * bflo(w.y) + bfhi(qq.y) * bfhi(w.y) + bflo(qq.z) * bflo(w.z) + bfhi(qq.z) * bfhi(w.z) + bflo(qq.w) * bflo(w.w) + bfhi(qq.w) * bfhi(w.w); }
            sc *= SWA_QSCALE;
            if (j <= t && t - j < 128) {
                const float mn = fmaxf(mx, sc), f = exp2f(mx - mn), p = exp2f(sc - mn);
                ls = ls * f + p; mx = mn;
#pragma unroll
                for (int i = 0; i < 8; ++i) { const u32x4 w = *(const u32x4*)(vp + 8 * i);
                    o[8 * i] = o[8 * i] * f + p * bflo(w.x); o[8 * i + 1] = o[8 * i + 1] * f + p * bfhi(w.x); o[8 * i + 2] = o[8 * i + 2] * f + p * bflo(w.y); o[8 * i + 3] = o[8 * i + 3] * f + p * bfhi(w.y);
                    o[8 * i + 4] = o[8 * i + 4] * f + p * bflo(w.z); o[8 * i + 5] = o[8 * i + 5] * f + p * bfhi(w.z); o[8 * i + 6] = o[8 * i + 6] * f + p * bflo(w.w); o[8 * i + 7] = o[8 * i + 7] * f + p * bfhi(w.w); }
            }
        }
        const float il = 1.f / ls;
#pragma unroll
        for (int i = 0; i < 8; ++i) { u32x4 w; w.x = cvt_pk_bf16(o[8 * i] * il, o[8 * i + 1] * il); w.y = cvt_pk_bf16(o[8 * i + 2] * il, o[8 * i + 3] * il); w.z = cvt_pk_bf16(o[8 * i + 4] * il, o[8 * i + 5] * il); w.w = cvt_pk_bf16(o[8 * i + 6] * il, o[8 * i + 7] * il);
            *(u32x4*)(ycat + row * 1024 + 768 + h * 64 + 8 * i) = w; }
    }
}


typedef float f32x16 __attribute__((ext_vector_type(16)));
typedef short s16x4 __attribute__((ext_vector_type(4)));
__device__ __forceinline__ s16x4 lds_tr16(LAS unsigned char* p) { return __builtin_bit_cast(s16x4, __builtin_amdgcn_ds_read_tr16_b64_v4i16((LAS s16x4*)p)); }
template <bool MLA>
__device__ __forceinline__ void attn_unit(const Args& a, int l, LAS unsigned char* lds, int b, int hd, int qb) {
    constexpr int KS = MLA ? 6 : 4, KROW = MLA ? 208 : 144, KBUF = 128 * KROW, VBUF = 16384, VOFF = 2 * KBUF;
    const int tid = tid_opaque(a.wv), lane = tid & 63, wave = __builtin_amdgcn_readfirstlane(tid >> 6), r = lane & 31, h = lane >> 5;
    const bf16_t* proj = (const bf16_t*)(a.ws + WS_PROJ);
    const bf16_t* Kp; const bf16_t* Vp; int ldk;
    if (MLA) { Kp = (const bf16_t*)(a.ws + WS_KV) + (size_t)b * SEQ * 512 + hd * 128; Vp = Kp + 64; ldk = 512; }
    else { Kp = proj + (size_t)b * SEQ * NPROJ + PC_SK + (hd >> 1) * 64; Vp = proj + (size_t)b * SEQ * NPROJ + PC_SV + (hd >> 1) * 64; ldk = NPROJ; }
    const bf16_t* Krp = (const bf16_t*)(a.ws + WS_KR) + (size_t)b * SEQ * 32;
    const int q0 = qb * 256, Q0 = q0 + wave * 32, qpos = Q0 + r;
    const size_t qrow = (size_t)b * SEQ + qpos;
    bf16x8 qr[KS];
    if (MLA) { const bf16_t* qp = (const bf16_t*)(a.ws + WS_Q) + qrow * 384 + hd * 96 + 8 * h;
#pragma unroll
        for (int ks = 0; ks < KS; ++ks) { u32x4 w = *(const u32x4*)(qp + 16 * ks);
            if (ks >= 4) { const float* rp = (const float*)(a.ws + WS_ROPE) + qrow * 32 + 8 * (ks - 4) + 4 * h; const f32x4 cs = *(const f32x4*)rp, sn = *(const f32x4*)(rp + 16);
                w.x = cvt_pk_bf16(bflo(w.x) * cs.x - bfhi(w.x) * sn.x, bflo(w.x) * sn.x + bfhi(w.x) * cs.x); w.y = cvt_pk_bf16(bflo(w.y) * cs.y - bfhi(w.y) * sn.y, bflo(w.y) * sn.y + bfhi(w.y) * cs.y);
                w.z = cvt_pk_bf16(bflo(w.z) * cs.z - bfhi(w.z) * sn.z, bflo(w.z) * sn.z + bfhi(w.z) * cs.z); w.w = cvt_pk_bf16(bflo(w.w) * cs.w - bfhi(w.w) * sn.w, bflo(w.w) * sn.w + bfhi(w.w) * cs.w); }
            qr[ks] = __builtin_bit_cast(bf16x8, w); } }
    else { const bf16_t* qp = proj + qrow * NPROJ + PC_SQ + hd * 64 + 8 * h;
#pragma unroll
        for (int ks = 0; ks < KS; ++ks) { u32x4 w = *(const u32x4*)(qp + 16 * ks);
            w.x = cvt_pk_bf16(bflo(w.x) * SWA_QSCALE, bfhi(w.x) * SWA_QSCALE); w.y = cvt_pk_bf16(bflo(w.y) * SWA_QSCALE, bfhi(w.y) * SWA_QSCALE);
            w.z = cvt_pk_bf16(bflo(w.z) * SWA_QSCALE, bfhi(w.z) * SWA_QSCALE); w.w = cvt_pk_bf16(bflo(w.w) * SWA_QSCALE, bfhi(w.w) * SWA_QSCALE); qr[ks] = __builtin_bit_cast(bf16x8, w); } }
    const int T_lo = MLA ? 0 : (qb == 0 ? 0 : 2 * qb - 1), T_hi = 2 * qb + 1;
    const int skey = tid >> 3, sch = tid & 7, rkey = tid >> 2, rch = tid & 3;
    u32x4 kreg[2], vreg[2], k2reg[2];
    auto gload = [&](int T) {
#pragma unroll
        for (int sub = 0; sub < 2; ++sub) { const int t = 2 * T + sub;
            kreg[sub] = *(const u32x4*)(Kp + (size_t)(64 * t + skey) * ldk + 8 * sch);
            vreg[sub] = *(const u32x4*)(Vp + (size_t)(64 * t + skey) * ldk + 8 * sch);
            if (MLA && tid < 256) k2reg[sub] = *(const u32x4*)(Krp + (size_t)(64 * t + rkey) * 32 + 8 * rch); }
    };
    auto lstore = [&](int buf) {
#pragma unroll
        for (int sub = 0; sub < 2; ++sub) {
            *(LAS u32x4*)(lds + buf * KBUF + (64 * sub + skey) * KROW + 16 * sch) = kreg[sub];
            *(LAS u32x4*)(lds + VOFF + buf * VBUF + sub * 8192 + (sch >> 2) * 4096 + skey * 64 + (sch & 3) * 16) = vreg[sub];
            if (MLA && tid < 256) *(LAS u32x4*)(lds + buf * KBUF + (64 * sub + rkey) * KROW + 128 + 16 * rch) = k2reg[sub]; }
    };
    f32x16 o0, o1;
#pragma unroll
    for (int i = 0; i < 16; ++i) { o0[i] = 0.f; o1[i] = 0.f; }
    float mx = MLA ? 0.f : a.sinks[l * 4 + hd] * LOG2E, ls = (MLA || h == 1) ? 0.f : 1.f;
    f32x16 negm;
#pragma unroll
    for (int i = 0; i < 16; ++i) negm[i] = -mx;
    gload(T_lo); lstore(0);
    __syncthreads();
    const int trb = (4 * h + ((lane & 15) >> 2)) * 64 + ((lane >> 4) & 1) * 32 + (lane & 3) * 8;
    for (int T = T_lo; T <= T_hi; ++T) {
        const int buf = (T - T_lo) & 1;
        if (T < T_hi) gload(T + 1);
#pragma unroll
        for (int sub = 0; sub < 2; ++sub) {
        const int t = 2 * T + sub;
        const bool active = (64 * t <= Q0 + 31) && (MLA || 64 * t + 63 >= Q0 - 127);
        if (active) {
            LAS unsigned char* Kb = lds + buf * KBUF + (64 * sub + r) * KROW + 16 * h;
            f32x16 p0 = negm, p1 = negm;
#pragma unroll
            for (int ks = 0; ks < KS; ++ks) {
                const bf16x8 k0 = *(const LAS bf16x8*)(Kb + 32 * ks), k1 = *(const LAS bf16x8*)(Kb + 32 * KROW + 32 * ks);
                p0 = __builtin_amdgcn_mfma_f32_32x32x16_bf16(k0, qr[ks], p0, 0, 0, 0);
                p1 = __builtin_amdgcn_mfma_f32_32x32x16_bf16(k1, qr[ks], p1, 0, 0, 0);
            }
            const bool need_mask = (64 * t + 63 > Q0) || (!MLA && 64 * t < Q0 + 31 - 127);
            if (need_mask) {
#pragma unroll
                for (int i = 0; i < 16; ++i) { const int kp = 64 * t + (i & 3) + 8 * (i >> 2) + 4 * h;
                    if (kp > qpos || (!MLA && qpos - kp >= 128)) p0[i] = -1e30f;
                    if (kp + 32 > qpos || (!MLA && qpos - kp - 32 >= 128)) p1[i] = -1e30f; } }
            float mt = fmaxf(p0[0], p1[0]);
#pragma unroll
            for (int i = 1; i < 16; ++i) mt = fmaxf(mt, fmaxf(p0[i], p1[i]));
            mt = fmaxf(mt, shx(mt, 32, lane));
            const bool first = MLA && (t == 0);
            if (first || __builtin_amdgcn_ballot_w64(mt > 0.f) != 0ull) {
                const float dl = first ? mt : fmaxf(mt, 0.f), f = first ? 1.f : __builtin_amdgcn_exp2f(-dl);
                mx += dl; ls *= f;
#pragma unroll
                for (int i = 0; i < 16; ++i) { p0[i] -= dl; p1[i] -= dl; o0[i] *= f; o1[i] *= f; negm[i] = -mx; }
            }
            float sum = 0.f;
#pragma unroll
            for (int i = 0; i < 16; ++i) { p0[i] = __builtin_amdgcn_exp2f(p0[i]); p1[i] = __builtin_amdgcn_exp2f(p1[i]); sum += p0[i] + p1[i]; }
            ls += sum;
            bf16x8 pw[2][2];
#pragma unroll
            for (int s2 = 0; s2 < 2; ++s2) {
                u32x4 w0, w1;
                w0.x = cvt_pk_bf16(p0[8 * s2], p0[8 * s2 + 1]); w0.y = cvt_pk_bf16(p0[8 * s2 + 2], p0[8 * s2 + 3]); w0.z = cvt_pk_bf16(p0[8 * s2 + 4], p0[8 * s2 + 5]); w0.w = cvt_pk_bf16(p0[8 * s2 + 6], p0[8 * s2 + 7]);
                w1.x = cvt_pk_bf16(p1[8 * s2], p1[8 * s2 + 1]); w1.y = cvt_pk_bf16(p1[8 * s2 + 2], p1[8 * s2 + 3]); w1.z = cvt_pk_bf16(p1[8 * s2 + 4], p1[8 * s2 + 5]); w1.w = cvt_pk_bf16(p1[8 * s2 + 6], p1[8 * s2 + 7]);
                pw[0][s2] = __builtin_bit_cast(bf16x8, w0); pw[1][s2] = __builtin_bit_cast(bf16x8, w1);
            }
            LAS unsigned char* Vb = lds + VOFF + buf * VBUF + sub * 8192 + trb;
#pragma unroll
            for (int kb = 0; kb < 2; ++kb)
#pragma unroll
                for (int s2 = 0; s2 < 2; ++s2) {
                    const int ko = (32 * kb + 16 * s2) * 64;
                    const s16x4 a0l = lds_tr16(Vb + ko), a0h = lds_tr16(Vb + ko + 512), a1l = lds_tr16(Vb + 4096 + ko), a1h = lds_tr16(Vb + 4096 + ko + 512);
                    const bf16x8 A0 = {a0l[0], a0l[1], a0l[2], a0l[3], a0h[0], a0h[1], a0h[2], a0h[3]}, A1 = {a1l[0], a1l[1], a1l[2], a1l[3], a1h[0], a1h[1], a1h[2], a1h[3]};
                    o0 = __builtin_amdgcn_mfma_f32_32x32x16_bf16(A0, pw[kb][s2], o0, 0, 0, 0);
                    o1 = __builtin_amdgcn_mfma_f32_32x32x16_bf16(A1, pw[kb][s2], o1, 0, 0, 0);
                }
        }
        }
        if (T < T_hi) lstore(buf ^ 1);
        __syncthreads();
    }
    ls += shx(ls, 32, lane);
    const float il = 1.f / ls;
    bf16_t* op = (bf16_t*)(a.ws + WS_YCAT) + qrow * 1024 + (MLA ? 512 : 768) + hd * 64 + 4 * h;
#pragma unroll
    for (int g4 = 0; g4 < 4; ++g4) {
        u32x2 w; w.x = cvt_pk_bf16(o0[4 * g4] * il, o0[4 * g4 + 1] * il); w.y = cvt_pk_bf16(o0[4 * g4 + 2] * il, o0[4 * g4 + 3] * il); *(u32x2*)(op + 8 * g4) = w;
        w.x = cvt_pk_bf16(o1[4 * g4] * il, o1[4 * g4 + 1] * il); w.y = cvt_pk_bf16(o1[4 * g4 + 2] * il, o1[4 * g4 + 3] * il); *(u32x2*)(op + 32 + 8 * g4) = w;
    }
}
__device__ __forceinline__ int xcd_vid(int blk, int G) { return (G % 8 == 0) ? (blk % 8) * (G / 8) + blk / 8 : blk; }
__device__ __forceinline__ void phase_mla(const Args& a, int l, LAS unsigned char* lds, int G) {
    for (int v0 = blockIdx.x; v0 < 256; v0 += G) { const int v = (G == 256) ? xcd_vid(v0, G) : v0; const int bh = v >> 3, s = v & 7;
        attn_unit<true>(a, l, lds, bh >> 2, bh & 3, s); attn_unit<true>(a, l, lds, bh >> 2, bh & 3, 15 - s); }
}
__device__ __forceinline__ void phase_swa(const Args& a, int l, LAS unsigned char* lds, int G) {
    for (int v0 = blockIdx.x; v0 < 512; v0 += G) { const int v = (G == 256) ? 2 * xcd_vid(v0 & 255, G) + (v0 >> 8) : v0; const int bh = v >> 4; attn_unit<false>(a, l, lds, bh >> 2, bh & 3, v & 15); }
}
__device__ __forceinline__ int crow16(int i, int h2) { return (i & 3) + 8 * (i >> 2) + 4 * h2; }
__device__ __forceinline__ void ssd_tables(const Args& a, int l, LAS float* dts, LAS float* acs, size_t row0, int g, int tid) {
    const int hg = tid >> 7, s = tid & 127, h = 4 * g + hg;
    const float av = -__expf(a.a_log[l * 8 + h]);
    const float dt = ((const float*)(a.ws + WS_DTSP))[(row0 + s) * 8 + h];
    dts[hg * 128 + s] = dt;
    const int lane = tid & 63;
    float v = dt * av;
#pragma unroll
    for (int d = 1; d < 64; d <<= 1) { const float o = __builtin_bit_cast(float, __builtin_amdgcn_ds_bpermute(((lane - d) & 63) << 2, __builtin_bit_cast(int, v))); v += (lane >= d) ? o : 0.f; }
    if ((tid & 127) == 63) acs[hg * 128] = v;
    __syncthreads();
    const float add = (tid & 64) ? acs[hg * 128] : 0.f;
    __syncthreads();
    acs[hg * 128 + s] = v + add;
    __syncthreads();
}
template <bool SCALED>
__device__ __forceinline__ void ssd_stage_x(const bf16_t* xbc, size_t row0, int g, LAS unsigned char* Xi, const LAS float* dts, const LAS float* acs, int tid) {
    u32x4 vv[8];
#pragma unroll
    for (int i = 0; i < 8; ++i) { const int ch = tid + 512 * i, hg = ch >> 10, s = (ch >> 3) & 127, c8 = ch & 7;
        vv[i] = *(const u32x4*)(xbc + (row0 + s) * 1024 + (4 * g + hg) * 64 + 8 * c8); }
#pragma unroll
    for (int i = 0; i < 8; ++i) { const int ch = tid + 512 * i, hg = ch >> 10, s = (ch >> 3) & 127, c8 = ch & 7;
        u32x4 v = vv[i];
        if (SCALED) { const float w = dts[hg * 128 + s] * __expf(acs[hg * 128 + 127] - acs[hg * 128 + s]);
            v.x = cvt_pk_bf16(bflo(v.x) * w, bfhi(v.x) * w); v.y = cvt_pk_bf16(bflo(v.y) * w, bfhi(v.y) * w); v.z = cvt_pk_bf16(bflo(v.z) * w, bfhi(v.z) * w); v.w = cvt_pk_bf16(bflo(v.w) * w, bfhi(v.w) * w); }
        *(LAS u32x4*)(Xi + hg * 16384 + (c8 >> 2) * 8192 + s * 64 + (c8 & 3) * 16) = v; }
}
__device__ __forceinline__ bf16x8 tr_frag(LAS unsigned char* p, int hi_off) {
    const s16x4 lo = lds_tr16(p), hi = lds_tr16(p + hi_off);
    return (bf16x8){lo[0], lo[1], lo[2], lo[3], hi[0], hi[1], hi[2], hi[3]};
}
__device__ __forceinline__ void phase_ssd_states_mfma(const Args& a, int l, LAS unsigned char* lds, int G) {
    const int tid = tid_opaque(a.wv), lane = tid & 63, wave = __builtin_amdgcn_readfirstlane(tid >> 6), r = lane & 31, h2 = lane >> 5;
    const bf16_t* xbc = (const bf16_t*)(a.ws + WS_H);
    bf16_t* states = (bf16_t*)(a.ws + WS_YS); float* cdec = (float*)(a.ws + WS_CDEC);
    LAS unsigned char* Bi = lds; LAS unsigned char* Xi = lds + 32768; LAS float* dts = (LAS float*)(lds + 98304); LAS float* acs = dts + 512;
    const int trb2 = (8 * h2 + ((lane & 15) >> 2)) * 64 + ((lane >> 4) & 1) * 32 + (lane & 3) * 8;
    for (int u = blockIdx.x; u < 512; u += G) {
        const int b = u >> 6, c = (u >> 1) & 31, g = u & 1; const size_t row0 = (size_t)b * SEQ + c * 128;
        ssd_tables(a, l, dts, acs, row0, g, tid);
#pragma unroll
        for (int i = 0; i < 4; ++i) { const int ch = tid + 512 * i, s = ch >> 4, c16 = ch & 15;
            *(LAS u32x4*)(Bi + (c16 >> 2) * 8192 + s * 64 + (c16 & 3) * 16) = *(const u32x4*)(xbc + (row0 + s) * 1024 + 512 + g * 128 + 8 * c16); }
        ssd_stage_x<true>(xbc, row0, g, Xi, dts, acs, tid);
        __syncthreads();
        const int hg = wave >> 1, nbh = wave & 1;
        f32x16 d00, d01, d10, d11;
#pragma unroll
        for (int i = 0; i < 16; ++i) { d00[i] = 0.f; d01[i] = 0.f; d10[i] = 0.f; d11[i] = 0.f; }
        LAS unsigned char* xa = Xi + hg * 16384 + trb2; LAS unsigned char* ba = Bi + (2 * nbh) * 8192 + trb2;
#pragma unroll
        for (int ks = 0; ks < 8; ++ks) {
            const bf16x8 A0 = tr_frag(xa + ks * 1024, 256), A1 = tr_frag(xa + 8192 + ks * 1024, 256), B0 = tr_frag(ba + ks * 1024, 256), B1 = tr_frag(ba + 8192 + ks * 1024, 256);
            d00 = __builtin_amdgcn_mfma_f32_32x32x16_bf16(B0, A0, d00, 0, 0, 0); d01 = __builtin_amdgcn_mfma_f32_32x32x16_bf16(B0, A1, d01, 0, 0, 0);
            d10 = __builtin_amdgcn_mfma_f32_32x32x16_bf16(B1, A0, d10, 0, 0, 0); d11 = __builtin_amdgcn_mfma_f32_32x32x16_bf16(B1, A1, d11, 0, 0, 0);
        }
        asm volatile("s_nop 15\n\ts_nop 7" : "+v"(d00), "+v"(d01), "+v"(d10), "+v"(d11));
        bf16_t* sp = states + (size_t)((b * 32 + c) * 8 + 4 * g + hg) * 8192 + (size_t)r * 128 + 64 * nbh + 4 * h2;
#pragma unroll
        for (int g4 = 0; g4 < 4; ++g4) { u32x2 w;
            w.x = cvt_pk_bf16(d00[4 * g4], d00[4 * g4 + 1]); w.y = cvt_pk_bf16(d00[4 * g4 + 2], d00[4 * g4 + 3]); *(u32x2*)(sp + 8 * g4) = w;
            w.x = cvt_pk_bf16(d01[4 * g4], d01[4 * g4 + 1]); w.y = cvt_pk_bf16(d01[4 * g4 + 2], d01[4 * g4 + 3]); *(u32x2*)(sp + 32 * 128 + 8 * g4) = w;
            w.x = cvt_pk_bf16(d10[4 * g4], d10[4 * g4 + 1]); w.y = cvt_pk_bf16(d10[4 * g4 + 2], d10[4 * g4 + 3]); *(u32x2*)(sp + 32 + 8 * g4) = w;
            w.x = cvt_pk_bf16(d11[4 * g4], d11[4 * g4 + 1]); w.y = cvt_pk_bf16(d11[4 * g4 + 2], d11[4 * g4 + 3]); *(u32x2*)(sp + 32 * 128 + 32 + 8 * g4) = w; }
        if (tid < 4) cdec[(b * 32 + c) * 8 + 4 * g + tid] = __expf(acs[tid * 128 + 127]);
        __syncthreads();
    }
}
__device__ __forceinline__ void phase_ssd_out_mfma(const Args& a, int l, LAS unsigned char* lds, int G) {
    constexpr int RW = 272;
    const int tid = tid_opaque(a.wv), lane = tid & 63, wave = __builtin_amdgcn_readfirstlane(tid >> 6), r = lane & 31, h2 = lane >> 5;
    const bf16_t* xbc = (const bf16_t*)(a.ws + WS_H); const bf16_t* proj = (const bf16_t*)(a.ws + WS_PROJ);
    const bf16_t* states = (const bf16_t*)(a.ws + WS_YS); bf16_t* ycat = (bf16_t*)(a.ws + WS_YCAT);
    LAS unsigned char* Cr = lds; LAS unsigned char* Br = lds + 34816; LAS unsigned char* Xi = lds + 69632;
    LAS float* dts = (LAS float*)(lds + 135168); LAS float* acs = dts + 512; LAS float* sq = dts + 1024;
    const int trb = (4 * h2 + ((lane & 15) >> 2)) * 64 + ((lane >> 4) & 1) * 32 + (lane & 3) * 8;
    for (int u = blockIdx.x; u < 512; u += G) {
        const int b = u >> 6, c = (u >> 1) & 31, g = u & 1; const size_t row0 = (size_t)b * SEQ + c * 128;
        const int hg = wave >> 1, lh = wave & 1, h = 4 * g + hg;
        const float dsk = a.ssd_d[l * 8 + h];
        bf16x8 hf[2][8];
        { const bf16_t* hp = states + (size_t)((b * 32 + c) * 8 + h) * 8192 + (size_t)r * 128 + 8 * h2;
#pragma unroll
          for (int pb = 0; pb < 2; ++pb)
#pragma unroll
              for (int ks = 0; ks < 8; ++ks) hf[pb][ks] = *(const bf16x8*)(hp + pb * 4096 + 16 * ks); }
        ssd_tables(a, l, dts, acs, row0, g, tid);
#pragma unroll
        for (int i = 0; i < 4; ++i) { const int ch = tid + 512 * i, s = ch >> 4, c16 = ch & 15; const bf16_t* src = xbc + (row0 + s) * 1024 + 512 + g * 128 + 8 * c16;
            *(LAS u32x4*)(Br + s * RW + 16 * c16) = *(const u32x4*)src; *(LAS u32x4*)(Cr + s * RW + 16 * c16) = *(const u32x4*)(src + 256); }
        ssd_stage_x<false>(xbc, row0, g, Xi, dts, acs, tid);
        __syncthreads();
        f32x16 yv[2][2];
#pragma unroll
        for (int lb = 0; lb < 2; ++lb) {
            const int Lb = lb == 0 ? lh : 3 - lh, L0 = 32 * Lb, lq = L0 + r;
            bf16x8 cf[8];
#pragma unroll
            for (int ks = 0; ks < 8; ++ks) cf[ks] = *(const LAS bf16x8*)(Cr + lq * RW + 32 * ks + 16 * h2);
            f32x16 o0, o1;
#pragma unroll
            for (int i = 0; i < 16; ++i) { o0[i] = 0.f; o1[i] = 0.f; }
#pragma unroll
            for (int ks = 0; ks < 8; ++ks) {
                o0 = __builtin_amdgcn_mfma_f32_32x32x16_bf16(hf[0][ks], cf[ks], o0, 0, 0, 0);
                o1 = __builtin_amdgcn_mfma_f32_32x32x16_bf16(hf[1][ks], cf[ks], o1, 0, 0, 0);
            }
            const float Al = acs[hg * 128 + lq], eAl = __expf(Al);
#pragma unroll
            for (int i = 0; i < 16; ++i) { o0[i] *= eAl; o1[i] *= eAl; }
            for (int sb = 0; sb <= Lb; ++sb) {
                f32x16 X;
#pragma unroll
                for (int i = 0; i < 16; ++i) X[i] = 0.f;
#pragma unroll
                for (int ks = 0; ks < 8; ++ks) X = __builtin_amdgcn_mfma_f32_32x32x16_bf16(*(const LAS bf16x8*)(Br + (32 * sb + r) * RW + 32 * ks + 16 * h2), cf[ks], X, 0, 0, 0);
#pragma unroll
                for (int i = 0; i < 16; ++i) { const int s = 32 * sb + crow16(i, h2); X[i] = (s <= lq) ? X[i] * __expf(Al - acs[hg * 128 + s]) * dts[hg * 128 + s] : 0.f; }
                u32x4 w0, w1;
                w0.x = cvt_pk_bf16(X[0], X[1]); w0.y = cvt_pk_bf16(X[2], X[3]); w0.z = cvt_pk_bf16(X[4], X[5]); w0.w = cvt_pk_bf16(X[6], X[7]);
                w1.x = cvt_pk_bf16(X[8], X[9]); w1.y = cvt_pk_bf16(X[10], X[11]); w1.z = cvt_pk_bf16(X[12], X[13]); w1.w = cvt_pk_bf16(X[14], X[15]);
                LAS unsigned char* xa = Xi + hg * 16384 + trb + (32 * sb) * 64;
                o0 = __builtin_amdgcn_mfma_f32_32x32x16_bf16(tr_frag(xa, 512), __builtin_bit_cast(bf16x8, w0), o0, 0, 0, 0);
                o1 = __builtin_amdgcn_mfma_f32_32x32x16_bf16(tr_frag(xa + 8192, 512), __builtin_bit_cast(bf16x8, w0), o1, 0, 0, 0);
                o0 = __builtin_amdgcn_mfma_f32_32x32x16_bf16(tr_frag(xa + 1024, 512), __builtin_bit_cast(bf16x8, w1), o0, 0, 0, 0);
                o1 = __builtin_amdgcn_mfma_f32_32x32x16_bf16(tr_frag(xa + 8192 + 1024, 512), __builtin_bit_cast(bf16x8, w1), o1, 0, 0, 0);
            }
            float ssq = 0.f;
            const bf16_t* zp = proj + (row0 + lq) * NPROJ + PC_Z + h * 64 + 4 * h2;
#pragma unroll
            for (int g4 = 0; g4 < 4; ++g4) {
                const u32x2 x0 = *(const LAS u32x2*)(Xi + hg * 16384 + lq * 64 + (8 * g4 + 4 * h2) * 2), x1 = *(const LAS u32x2*)(Xi + hg * 16384 + 8192 + lq * 64 + (8 * g4 + 4 * h2) * 2);
                const u32x2 z0 = *(const u32x2*)(zp + 8 * g4), z1 = *(const u32x2*)(zp + 32 + 8 * g4);
                float v;
                v = (o0[4 * g4] + dsk * bflo(x0.x)) * silu_f(bflo(z0.x)); o0[4 * g4] = v; ssq += v * v;
                v = (o0[4 * g4 + 1] + dsk * bfhi(x0.x)) * silu_f(bfhi(z0.x)); o0[4 * g4 + 1] = v; ssq += v * v;
                v = (o0[4 * g4 + 2] + dsk * bflo(x0.y)) * silu_f(bflo(z0.y)); o0[4 * g4 + 2] = v; ssq += v * v;
                v = (o0[4 * g4 + 3] + dsk * bfhi(x0.y)) * silu_f(bfhi(z0.y)); o0[4 * g4 + 3] = v; ssq += v * v;
                v = (o1[4 * g4] + dsk * bflo(x1.x)) * silu_f(bflo(z1.x)); o1[4 * g4] = v; ssq += v * v;
                v = (o1[4 * g4 + 1] + dsk * bfhi(x1.x)) * silu_f(bfhi(z1.x)); o1[4 * g4 + 1] = v; ssq += v * v;
                v = (o1[4 * g4 + 2] + dsk * bflo(x1.y)) * silu_f(bflo(z1.y)); o1[4 * g4 + 2] = v; ssq += v * v;
                v = (o1[4 * g4 + 3] + dsk * bfhi(x1.y)) * silu_f(bfhi(z1.y)); o1[4 * g4 + 3] = v; ssq += v * v;
            }
            ssq += shx(ssq, 32, lane);
            if (h2 == 0) sq[lq * 4 + hg] = ssq;
            yv[lb][0] = o0; yv[lb][1] = o1;
        }
        f32x4 ngv[4][2];
        { const float* ngp = a.ssd_ng + l * 512 + g * 256 + hg * 64 + 4 * h2;
#pragma unroll
          for (int g4 = 0; g4 < 4; ++g4)
#pragma unroll
              for (int pb = 0; pb < 2; ++pb) ngv[g4][pb] = *(const f32x4*)(ngp + 32 * pb + 8 * g4); }
        __syncthreads();
#pragma unroll
        for (int lb = 0; lb < 2; ++lb) {
            const int Lb = lb == 0 ? lh : 3 - lh, lq = 32 * Lb + r;
            const f32x4 t4 = *(const LAS f32x4*)(sq + lq * 4);
            const float rinv = __builtin_amdgcn_rsqf(((t4.x + t4.y) + (t4.z + t4.w)) * (1.f / 256.f) + EPS);
            bf16_t* op = ycat + (row0 + lq) * 1024 + g * 256 + hg * 64 + 4 * h2;
#pragma unroll
            for (int g4 = 0; g4 < 4; ++g4)
#pragma unroll
                for (int pb = 0; pb < 2; ++pb) { const f32x4 gg = ngv[g4][pb];
                    u32x2 w; w.x = cvt_pk_bf16(yv[lb][pb][4 * g4] * rinv * gg.x, yv[lb][pb][4 * g4 + 1] * rinv * gg.y); w.y = cvt_pk_bf16(yv[lb][pb][4 * g4 + 2] * rinv * gg.z, yv[lb][pb][4 * g4 + 3] * rinv * gg.w);
                    *(u32x2*)(op + 32 * pb + 8 * g4) = w; }
        }
        __syncthreads();
    }
}


#define XB_TMO      128
#define XB_XCNT(j)  (256  + 64 * (j))
#define XB_XSUB(j)  (1280 + 64 * (j))
#define XB_XGEN(j)  (2304 + 64 * (j))
#define XB_TOP      3328
#define XB_TOPGEN   3392
#define XCD_BAR_WORDS 3456
#define XB_SPIN_CAP (1u << 18)
__device__ __forceinline__ unsigned xb_ld(unsigned* p)              { return __hip_atomic_load(p, __ATOMIC_RELAXED, __HIP_MEMORY_SCOPE_AGENT); }
__device__ __forceinline__ unsigned xb_add(unsigned* p, unsigned v) { return __hip_atomic_fetch_add(p, v, __ATOMIC_RELAXED, __HIP_MEMORY_SCOPE_AGENT); }
__device__ __forceinline__ unsigned xb_xcc_id() { return (unsigned)__builtin_amdgcn_s_getreg((3 << 11) | 20) & 0xFu; }
#define XB_SPIN(cond, bar) do { unsigned _sp = 0; while (cond) { __builtin_amdgcn_s_sleep(1); \
    if ((++_sp & 255u) == 0u) { if (xb_ld(&(bar)[XB_TMO])) break; if (_sp > XB_SPIN_CAP) { atomicAdd(&(bar)[XB_TMO], 1u); break; } } } } while (0)
struct XcdBarrier { unsigned* bar; unsigned x; volatile LAS unsigned* st; };
__device__ __forceinline__ XcdBarrier xcd_barrier_post(unsigned* bar, volatile LAS unsigned* st) {
    XcdBarrier b; b.bar = bar; b.x = xb_xcc_id(); b.st = st;
    if (threadIdx.x == 0) (void)xb_add(&bar[XB_XCNT(b.x)], 1u);
    return b;
}
__device__ __forceinline__ void xcd_barrier_complete(unsigned* bar, unsigned x, unsigned& nloc, unsigned& nx) {
    const unsigned G = gridDim.x * gridDim.y * gridDim.z;
    unsigned sum, cnt, mine, sp = 0u;
    for (;;) {
        sum = 0u; cnt = 0u; mine = 0u;
#pragma unroll
        for (unsigned j = 0; j < 16; ++j) { const unsigned c = xb_ld(&bar[XB_XCNT(j)]); sum += c; cnt += (c > 0u) ? 1u : 0u; mine = (j == x) ? c : mine; }
        if (sum == G) break;
        __builtin_amdgcn_s_sleep(1);
        if ((++sp & 255u) == 0u) { if (xb_ld(&bar[XB_TMO])) break; if (sp > XB_SPIN_CAP) { atomicAdd(&bar[XB_TMO], 1u); break; } }
    }
    nloc = mine > 0u ? mine : 1u; nx = cnt > 0u ? cnt : 1u;
}
__device__ __forceinline__ void xcd_barrier(const XcdBarrier& b) {
    asm volatile("s_waitcnt vmcnt(0)" ::: "memory");
    __syncthreads();
    if (threadIdx.x == 0) {
        unsigned* bar = b.bar;
        __builtin_amdgcn_s_waitcnt(0);
        unsigned nloc = b.st[0], nx = b.st[1];
        if (nloc == 0u) { xcd_barrier_complete(bar, b.x, nloc, nx); b.st[0] = nloc; b.st[1] = nx; }
        const unsigned old = xb_add(&bar[XB_XSUB(b.x)], 1u);
        const unsigned gen = old / nloc;
        if (old + 1u == (gen + 1u) * nloc) {
            __builtin_amdgcn_fence(__ATOMIC_RELEASE, "agent");
            asm volatile("s_waitcnt vmcnt(0)" ::: "memory");
            const unsigned og = xb_add(&bar[XB_TOP], 1u);
            const unsigned tg = og / nx;
            if (og + 1u == (tg + 1u) * nx) xb_add(&bar[XB_TOPGEN], 1u);
            else XB_SPIN(xb_ld(&bar[XB_TOPGEN]) == tg, bar);
            __builtin_amdgcn_fence(__ATOMIC_ACQUIRE, "agent");
            xb_add(&bar[XB_XGEN(b.x)], 1u);
            asm volatile("s_waitcnt vmcnt(0)" ::: "memory");
        } else {
            XB_SPIN(xb_ld(&bar[XB_XGEN(b.x)]) == gen, bar);
            __builtin_amdgcn_fence(__ATOMIC_ACQUIRE, "agent");
            asm volatile("s_waitcnt vmcnt(0)" ::: "memory");
        }
    }
    __syncthreads();
}

constexpr int PH_PER_LAYER = 8, N_PHASES = 2 + DEPTH * PH_PER_LAYER + 1;
__global__ void __launch_bounds__(512, 2) fwd_kernel(Args a0) {
    extern __shared__ __attribute__((aligned(16))) unsigned char lds_raw[];
    LAS unsigned char* lds = (LAS unsigned char*)lds_raw;
    const int G = gridDim.x;
    const int wave_s = __builtin_amdgcn_readfirstlane((int)threadIdx.x >> 6);
#if MK_PER_PHASE
#define SEAM() do {} while (0)
#else
    cg::grid_group grid = cg::this_grid();
    volatile LAS unsigned* bst = (volatile LAS unsigned*)(lds + LDS_BYTES - 64);
    if (threadIdx.x < 2) bst[threadIdx.x] = 0u;
    __syncthreads();
    const XcdBarrier xbar = xcd_barrier_post((unsigned*)a0.ws, bst);
#define SEAM() do { if (ph + 1 < a.ph_hi) { if (ph == 0) grid.sync(); else xcd_barrier(xbar); if (PROBE_MASK & 256) xcd_barrier(xbar); } } while (0)
#endif
    for (int ph = a0.ph_lo; ph < a0.ph_hi; ++ph) {
        unsigned long long wsi_ = (unsigned long long)a0.ws, oi_ = (unsigned long long)a0.out; asm volatile("" : "+s"(wsi_), "+s"(oi_));
        unsigned char* ws = (unsigned char*)(__attribute__((address_space(1))) unsigned char*)wsi_;
        Args a = a0; a.ws = ws; a.wv = wave_s;
        a.out = (float*)(__attribute__((address_space(1))) float*)oi_;
        const float* mod = (const float*)(ws + WS_MOD);
        bf16_t* hbuf = (bf16_t*)(ws + WS_H);
        unsigned long long* rowsq1 = (unsigned long long*)(ws + WS_RSQ); unsigned long long* rowsq2 = rowsq1 + M;
        if (ph == 0) { RUN(16, phase_mod(a, lds, G)); phase_rope(a, G); __syncthreads(); phase_weights(a, 0, ws + WS_W, lds, G); SEAM(); continue; }
        if (ph == 1) { phase_norm0(a.x, a.n1g, mod + 1024, hbuf, rowsq1, G, a.wv); phase_bias(a, 0, (float*)(ws + WS_BIAS), lds, G); SEAM(); continue; }
        if (ph == N_PHASES - 1) { phase_final(a.out, a.fng, G, a.wv); continue; }
        const int l = (ph - 2) / PH_PER_LAYER, sp = (ph - 2) % PH_PER_LAYER;
        const float* ml = mod + (size_t)l * 8 * 6144;
        const float* xcur = (l == 0) ? a.x : a.out;
        const unsigned char* Wb = ws + ((l & 1) ? WS_W2 : WS_W);
        const float* biasb = (const float*)(ws + WS_BIAS + (size_t)(l & 1) * 262144);
        if (sp == 0) {
            pg8::Gemm g{hbuf, (const bf16_t*)(Wb + WO_IN), D, D, a.wv}; pg8::Order S; S.init(M / 256, NPROJ / 256, G, (int)blockIdx.x, 0);
            pg8::EpiProj E{(bf16_t*)(ws + WS_PROJ), (float*)(ws + WS_DTRAW), rowsq1, biasb};
            RUN(32, pg8::gemm_phase(lds, g, S, E));
        } else if (sp == 1) {
            RUN(8, phase_prep(a, l, G));
        } else if (sp == 2) {
            { pg8::Gemm g{(const bf16_t*)(ws + WS_PROJ) + PC_CQ, (const bf16_t*)(Wb + WO_UQ), 256, NPROJ, a.wv}; pg8::Order S; S.init(M / 256, 2, G, (int)blockIdx.x, 0);
              pg8::EpiMla E{(bf16_t*)(ws + WS_Q), (bf16_t*)(ws + WS_KV), (const float*)(ws + WS_RS), 1};
              pg8::gemm_phase(lds, g, S, E); }
            { pg8::Gemm g{(const bf16_t*)(ws + WS_PROJ) + PC_CKV, (const bf16_t*)(Wb + WO_UKV), 128, NPROJ, a.wv}; pg8::Order S; S.init(M / 256, 2, G, (int)blockIdx.x, 0);
              pg8::EpiMla E{(bf16_t*)(ws + WS_Q), (bf16_t*)(ws + WS_KV), (const float*)(ws + WS_RS), 0};
              pg8::gemm_phase(lds, g, S, E); }
            RUN(4, phase_ssd_states_mfma(a, l, lds, G));
            RUN(2, phase_swa(a, l, lds, G));
        } else if (sp == 3) {
            phase_ssd_scan(a, G);
            RUN(2, phase_mla(a, l, lds, G));
            if (l + 1 < DEPTH) { __syncthreads(); RUN(1024, phase_weights(a, l + 1, ws + (((l + 1) & 1) ? WS_W2 : WS_W), lds, G)); RUN(512, phase_bias(a, l + 1, (float*)(ws + WS_BIAS + (size_t)((l + 1) & 1) * 262144), lds, G)); }
        } else if (sp == 4) {
            RUN(2048, phase_ssd_out_mfma(a, l, lds, G));
        } else if (sp == 5) {
            pg8::Gemm g{(const bf16_t*)(ws + WS_YCAT), (const bf16_t*)(Wb + WO_OUT), D, D, a.wv}; pg8::Order S; S.init(M / 256, D / 256, G, (int)blockIdx.x, 0);
            pg8::EpiRes E{xcur, a.out, ml + 2048, hbuf, a.n2g + l * D, ml + 4096, rowsq2};
            pg8::gemm_phase(lds, g, S, E);
        } else if (sp == 6) {
            pg8::Gemm g{hbuf, (const bf16_t*)(Wb + WO_UP), D, D, a.wv}; pg8::Order S; S.init(NB * 17, DFF / 128, G, (int)blockIdx.x, 1);
            pg8::EpiUp E{(bf16_t*)(ws + WS_PROJ), a.fconv_w + (size_t)l * 3 * 2 * DFF, a.fconv_b + (size_t)l * 2 * DFF, rowsq2, biasb + 8 * NPROJ};
            RUN(128, pg8::gemm_phase(lds, g, S, E));
        } else {
            pg8::Gemm g{(const bf16_t*)(ws + WS_PROJ), (const bf16_t*)(Wb + WO_DN), DFF, DFF, a.wv}; pg8::Order S; S.init(M / 256, D / 256, G, (int)blockIdx.x, 0);
            const bool nxt = l + 1 < DEPTH;
            pg8::EpiRes E{a.out, a.out, ml + 5120, nxt ? hbuf : nullptr, a.n1g + (nxt ? l + 1 : l) * D, ml + (nxt ? 8 * 6144 : 0) + 1024, rowsq1};
            pg8::gemm_phase(lds, g, S, E);
        }
        SEAM();
    }
}

extern "C" void kernel_launch(void* const* d_in, const int* in_sizes, int n_in, void* d_out, int out_size, void* d_ws, size_t ws_size, hipStream_t stream) {
    static int grid = 0;
    if (grid == 0) {
        if (n_in != 25 || ws_size < WS_END) { fprintf(stderr, "kernel_launch: unexpected n_in %d / ws %zu\n", n_in, ws_size); grid = -1; return; }
        int dev = 0, cus = 0, per_cu = 0;
        hipGetDevice(&dev); hipDeviceGetAttribute(&cus, hipDeviceAttributeMultiprocessorCount, dev);
        if (hipFuncSetAttribute((const void*)fwd_kernel, hipFuncAttributeMaxDynamicSharedMemorySize, LDS_BYTES) != hipSuccess) { fprintf(stderr, "hipFuncSetAttribute failed\n"); }
        hipOccupancyMaxActiveBlocksPerMultiprocessor(&per_cu, (const void*)fwd_kernel, 512, LDS_BYTES);
        (void)hipGetLastError();
        if (per_cu < 1) { fprintf(stderr, "occupancy query says %d blocks/CU\n", per_cu); per_cu = 1; }
        grid = cus;
    }
    if (grid < 0) return;
    if (hipMemsetAsync(d_ws, 0, 16384, stream) != hipSuccess) { fprintf(stderr, "kernel_launch: memset of the barrier words failed\n"); return; }
    Args a{};
    a.x = (const float*)d_in[0]; a.c = (const float*)d_in[1]; a.pos = (const int*)d_in[2];
    a.ada_w = (const float*)d_in[3]; a.ada_b = (const float*)d_in[4]; a.n1g = (const float*)d_in[5]; a.n2g = (const float*)d_in[6]; a.w_in = (const float*)d_in[7];
    a.sconv_w = (const float*)d_in[8]; a.sconv_b = (const float*)d_in[9]; a.dt_bias = (const float*)d_in[10]; a.a_log = (const float*)d_in[11]; a.ssd_d = (const float*)d_in[12]; a.ssd_ng = (const float*)d_in[13];
    a.qng = (const float*)d_in[14]; a.w_uq = (const float*)d_in[15]; a.kvng = (const float*)d_in[16]; a.w_ukv = (const float*)d_in[17]; a.sinks = (const float*)d_in[18]; a.w_out = (const float*)d_in[19];
    a.w_up = (const float*)d_in[20]; a.fconv_w = (const float*)d_in[21]; a.fconv_b = (const float*)d_in[22]; a.w_dn = (const float*)d_in[23]; a.fng = (const float*)d_in[24];
    a.out = (float*)d_out; a.ws = (unsigned char*)d_ws;
#if MK_PER_PHASE
    for (int ph = 0; ph < N_PHASES; ++ph) { a.ph_lo = ph; a.ph_hi = ph + 1; hipLaunchKernelGGL(fwd_kernel, dim3(grid), dim3(512), LDS_BYTES, stream, a); }
#else
    a.ph_lo = 0; a.ph_hi = N_PHASES;
    void* args[] = {&a};
    hipError_t e = hipLaunchCooperativeKernel((const void*)fwd_kernel, dim3(grid), dim3(512), args, LDS_BYTES, stream);
    if (e != hipSuccess) fprintf(stderr, "cooperative launch failed: %s (grid %d)\n", hipGetErrorString(e), grid);
#endif
}
```

```cpp
#include <hip/hip_runtime.h>
#include <hip/hip_cooperative_groups.h>
#include <cstdio>
#include <cstdint>
namespace cg = cooperative_groups;

#define LAS __attribute__((address_space(3)))
typedef unsigned short bf16_t;
typedef short bf16x8 __attribute__((ext_vector_type(8)));
typedef float f32x4 __attribute__((ext_vector_type(4)));
typedef float f32x2 __attribute__((ext_vector_type(2)));
typedef unsigned u32x4 __attribute__((ext_vector_type(4)));
typedef unsigned u32x2 __attribute__((ext_vector_type(2)));

#ifndef PROBE_MASK
#define PROBE_MASK 0
#endif
#define RUN(bit, call) do { call; if (PROBE_MASK & (bit)) { call; } } while (0)
#ifndef MK_PER_PHASE
#define MK_PER_PHASE 0
#endif

constexpr int D = 1024, NB = 8, SEQ = 4096, M = NB * SEQ, DEPTH = 4, DFF = 2816, DIN = 2472, NPROJ = 2560;
constexpr float EPS = 1e-6f;
constexpr int PC_Z = 0, PC_X = 512, PC_CQ = 1536, PC_CKV = 1792, PC_KR = 1920, PC_SQ = 1952, PC_SK = 2208, PC_SV = 2336, PC_DT = 2464;
constexpr float LOG2E = 1.4426950408889634f;
constexpr float RSQ_SCALE = 16777216.f;
constexpr float MLA_QSCALE = 0.10206207261596577f * LOG2E;
constexpr float SWA_QSCALE = 0.125f * LOG2E;

constexpr size_t MiB = 1u << 20;
constexpr size_t WS_MOD = 1 * MiB;
constexpr size_t WS_ROPE = 2 * MiB;
constexpr size_t WS_W = 6 * MiB;
constexpr size_t WO_IN = 0, WO_OUT = 5 * MiB, WO_UP = 7 * MiB, WO_DN = 18 * MiB, WO_UQ = 23 * MiB + 512 * 1024, WO_UKV = 23 * MiB + 768 * 1024;
constexpr size_t WS_H = 32 * MiB;
constexpr size_t WS_PROJ = 96 * MiB;
constexpr size_t WS_YCAT = 272 * MiB;
constexpr size_t WS_Q = 336 * MiB;
constexpr size_t WS_KV = 360 * MiB;
constexpr size_t WS_KR = 392 * MiB;
constexpr size_t WS_DTRAW = 394 * MiB;
constexpr size_t WS_DTSP = 395 * MiB;
constexpr size_t WS_RS = 396 * MiB;
constexpr size_t WS_YS = 400 * MiB;
constexpr size_t WS_RSQ = 396 * MiB + 256 * 1024;
constexpr size_t WS_BIAS = 397 * MiB;
constexpr size_t WS_W2 = 464 * MiB;
constexpr size_t WS_END = 490 * MiB;

constexpr int LDS_BYTES = 147456;
constexpr int LDS_EXTRA = 131072;

__device__ __forceinline__ unsigned f2bf(float f) { unsigned u = __builtin_bit_cast(unsigned, f); return (u + 0x7fffu + ((u >> 16) & 1u)) >> 16; }
__device__ __forceinline__ unsigned pk2(float lo, float hi) { return f2bf(lo) | (f2bf(hi) << 16); }
__device__ __forceinline__ float bflo(unsigned w) { return __builtin_bit_cast(float, w << 16); }
__device__ __forceinline__ float bfhi(unsigned w) { return __builtin_bit_cast(float, w & 0xffff0000u); }
__device__ __forceinline__ float bf2f(bf16_t h) { return __builtin_bit_cast(float, (unsigned)h << 16); }
__device__ __forceinline__ unsigned cvt_pk_bf16(float lo, float hi) { unsigned r; asm volatile("v_cvt_pk_bf16_f32 %0, %1, %2" : "=v"(r) : "v"(lo), "v"(hi)); return r; }
__device__ __forceinline__ float shx(float v, int o, int lane) { return __builtin_bit_cast(float, __builtin_amdgcn_ds_bpermute((lane ^ o) << 2, __builtin_bit_cast(int, v))); }
__device__ __forceinline__ float wave_sum(float v, int lane) {
#pragma unroll
    for (int o = 1; o < 64; o <<= 1) v += shx(v, o, lane);
    return v;
}
__device__ __forceinline__ int tid_opaque(int wv) { unsigned m = ~0u; asm volatile("" : "+s"(m), "+s"(wv)); int t = (wv << 6) | (int)__builtin_amdgcn_mbcnt_hi(m, __builtin_amdgcn_mbcnt_lo(m, 0u)); asm volatile("" : "+v"(t)); return t; }
__device__ __forceinline__ float silu_f(float v) { return v * __builtin_amdgcn_rcpf(1.f + __builtin_amdgcn_exp2f(v * -1.4426950408889634f)); }

namespace pg8 {
constexpr int BM = 256, BK = 64, HALF = 128, HTB = HALF * BK * 2, STAGE_BYTES = 8 * HTB, NXCD = 8, WGM = 8;
__host__ __device__ __forceinline__ int lds_byte(int r, int c) { const int st = (r >> 4) * 2 + (c >> 5), rr = r & 15, cc = c & 31, ob = rr * 64 + cc * 2; return st * 1024 + (ob ^ (((ob >> 9) & 1) << 5)); }
__host__ __device__ __forceinline__ void stage_rc(int b, int& R, int& C) { const int st = b / 1024, sb = b % 1024, swz = sb ^ (((sb >> 9) & 1) << 5); R = (st >> 1) * 16 + swz / 64; C = (st & 1) * 32 + (swz % 64) / 2; }
__host__ __device__ __forceinline__ int perm32(int rho) { const int n = rho >> 4, i = rho & 15; return 8 * (i >> 2) + 4 * n + (i & 3); }

struct Unit { int pm, pn; };
struct Gemm { const bf16_t* A; const bf16_t* Bt; int K; int lda; int wv; };

struct Order {
    int nM, nN, nwg, G, c, mode;
    __device__ __forceinline__ void init(int nM_, int nN_, int G_, int c_, int mode_) { nM = nM_; nN = nN_; nwg = nM * nN; G = G_; c = c_; mode = mode_; }
    __device__ __forceinline__ bool next(int i, Unit& u) const {
        const long L = (long)i * G + c; if (L >= nwg) return false;
        int wgid = (int)L; { const int q = nwg / NXCD, r = nwg % NXCD, xcd = wgid % NXCD, off = wgid / NXCD; wgid = (xcd < r ? xcd * (q + 1) : r * (q + 1) + (xcd - r) * q) + off; }
        const int nig = WGM * nN, gid = wgid / nig, fm = gid * WGM, gsz = (nM - fm) < WGM ? (nM - fm) : WGM;
        u.pm = fm + ((wgid % nig) % gsz); u.pn = (wgid % nig) / gsz; return true;
    }
    __device__ __forceinline__ long a_row(const Unit& u) const { return mode == 0 ? (long)u.pm * 256 : (long)(u.pm / 17) * 4096 + (long)(u.pm % 17) * 254 - 2; }
};

template <class Epi, class Sched>
__device__ __forceinline__ void gemm_phase(LAS unsigned char* lds, const Gemm g, const Sched& S, const Epi& E) {
    const int tid = tid_opaque(g.wv);
    const int wid = __builtin_amdgcn_readfirstlane(tid >> 6), lane = tid & 63, wr = wid >> 2, wc = wid & 3, fr = lane & 15, fq = lane >> 4;
    const int K = g.K, nt = K / BK, lda = g.lda;
    unsigned voffA[2], voffB[2];
#pragma unroll
    for (int i = 0; i < 2; ++i) { int R, C; stage_rc(tid * 16 + i * 8192, R, C); const int Rb = Epi::PERM ? ((R & ~31) + perm32(R & 31)) : R;
        voffA[i] = (unsigned)(R * lda + C) * 2u; voffB[i] = (unsigned)(Rb * K + C) * 2u; }
    const size_t kstep = (size_t)(BK * 2);
    const size_t hA = (size_t)HALF * lda * 2, hB = (size_t)HALF * K * 2;
    const size_t tB = 2 * hB;
    const unsigned ldsw = (unsigned)wid * 1024u;
    const int aoff = lds_byte(wr * 64 + fr, fq * 8), boff = lds_byte(wc * 32 + fr, fq * 8);
#define PG8_SA(b, h) (((b) * 2 + (h)) * HTB)
#define PG8_SB(b, h) ((4 + (b) * 2 + (h)) * HTB)
#define PG8_STAGE(bufoff, gbase, voff) do { _Pragma("unroll") for (int _i = 0; _i < 2; ++_i) \
        __builtin_amdgcn_global_load_lds((const unsigned*)((const char*)(gbase) + (voff)[_i]), (LAS unsigned*)(lds + (bufoff) + ldsw + _i * 8192), 16, 0, 0); } while (0)
#define PG8_LDA(dst, b, h) do { _Pragma("unroll") for (int m = 0; m < 4; ++m) _Pragma("unroll") for (int k = 0; k < 2; ++k) dst[m][k] = *(const LAS bf16x8*)(lds + PG8_SA(b, h) + aoff + m * 2048 + k * 1024); } while (0)
#define PG8_LDB(dst, b, h) do { _Pragma("unroll") for (int n = 0; n < 2; ++n) _Pragma("unroll") for (int k = 0; k < 2; ++k) dst[n][k] = *(const LAS bf16x8*)(lds + PG8_SB(b, h) + boff + n * 2048 + k * 1024); } while (0)
#define PG8_MMA(ai, bj, At, Bt) do { __builtin_amdgcn_s_setprio(1); _Pragma("unroll") for (int m = 0; m < 4; ++m) _Pragma("unroll") for (int n = 0; n < 2; ++n) _Pragma("unroll") for (int k = 0; k < 2; ++k) \
        acc[ai][bj][m][n] = __builtin_amdgcn_mfma_f32_16x16x32_bf16(Bt[n][k], At[m][k], acc[ai][bj][m][n], 0, 0, 0); __builtin_amdgcn_s_setprio(0); } while (0)
#define PG8_WAIT_V(n) asm volatile("s_waitcnt vmcnt(" #n ")" ::: "memory")
#define PG8_WAIT_L(n) asm volatile("s_waitcnt lgkmcnt(" #n ")" ::: "memory")
#define PG8_BAR __builtin_amdgcn_s_barrier()
#define PG8_SCHED __builtin_amdgcn_sched_barrier(0)
    Unit cur, nxt; int ui = 0;
    if (!S.next(0, cur)) return;
    f32x4 acc[2][2][4][2];
#pragma unroll
    for (int a = 0; a < 2; ++a)
#pragma unroll
        for (int b = 0; b < 2; ++b)
#pragma unroll
            for (int m = 0; m < 4; ++m)
#pragma unroll
                for (int n = 0; n < 2; ++n) acc[a][b][m][n] = (f32x4){0.f, 0.f, 0.f, 0.f};
    bf16x8 At[4][2], B0[2][2], B1[2][2];
    const char* cA = (const char*)g.A + S.a_row(cur) * (long)lda * 2; const char* cB = (const char*)g.Bt + (size_t)cur.pn * tB;
    PG8_STAGE(PG8_SB(0, 0), cB, voffB); PG8_STAGE(PG8_SB(0, 1), cB + hB, voffB); PG8_STAGE(PG8_SA(0, 0), cA, voffA); PG8_STAGE(PG8_SA(0, 1), cA + hA, voffA);
    if (wr == 1) PG8_BAR;
    PG8_WAIT_V(2); PG8_BAR;
    PG8_STAGE(PG8_SB(1, 0), cB + kstep, voffB); PG8_STAGE(PG8_SA(1, 0), cA + kstep, voffA); PG8_STAGE(PG8_SB(1, 1), cB + hB + kstep, voffB);
    PG8_WAIT_V(6); PG8_BAR;
    for (;;) {
        const bool has_next = S.next(ui + 1, nxt);
        const char* nA = has_next ? (const char*)g.A + S.a_row(nxt) * (long)lda * 2 : cA; const char* nB = has_next ? (const char*)g.Bt + (size_t)nxt.pn * tB : cB;
        for (int t = 0; t < nt; t += 2) {
            const bool last = (t == nt - 2);
            const char* a1 = cA + (size_t)(t + 1) * kstep;
            const char* a2 = last ? nA : cA + (size_t)(t + 2) * kstep; const char* b2 = last ? nB : cB + (size_t)(t + 2) * kstep;
            const char* a3 = a2 + kstep; const char* b3 = b2 + kstep;
            PG8_LDB(B0, 0, 0); PG8_LDB(B1, 0, 1); PG8_SCHED; PG8_LDA(At, 0, 0); PG8_STAGE(PG8_SA(1, 1), a1 + hA, voffA);
            PG8_WAIT_V(8); PG8_WAIT_L(0); PG8_BAR; PG8_MMA(0, 0, At, B0); PG8_MMA(0, 1, At, B1); PG8_BAR; PG8_SCHED;
            PG8_LDA(At, 0, 1); PG8_STAGE(PG8_SB(0, 0), b2, voffB); PG8_STAGE(PG8_SB(0, 1), b2 + hB, voffB); PG8_STAGE(PG8_SA(0, 0), a2, voffA);
            PG8_WAIT_V(8); PG8_WAIT_L(0); PG8_BAR; PG8_MMA(1, 0, At, B0); PG8_MMA(1, 1, At, B1); PG8_BAR; PG8_SCHED;
            PG8_LDB(B0, 1, 0); PG8_LDB(B1, 1, 1); PG8_SCHED; PG8_LDA(At, 1, 0); PG8_STAGE(PG8_SA(0, 1), a2 + hA, voffA);
            PG8_WAIT_V(8); PG8_WAIT_L(0); PG8_BAR; PG8_MMA(0, 0, At, B0); PG8_MMA(0, 1, At, B1); PG8_BAR; PG8_SCHED;
            PG8_LDA(At, 1, 1); PG8_STAGE(PG8_SB(1, 0), b3, voffB); PG8_STAGE(PG8_SB(1, 1), b3 + hB, voffB); PG8_STAGE(PG8_SA(1, 0), a3, voffA);
            PG8_WAIT_V(8); PG8_WAIT_L(0); PG8_BAR; PG8_MMA(1, 0, At, B0); PG8_MMA(1, 1, At, B1); PG8_BAR; PG8_SCHED;
        }
        if (wr == 0) PG8_BAR;
        { const int t2 = tid_opaque(g.wv), w2 = __builtin_amdgcn_readfirstlane(t2 >> 6), l2 = t2 & 63;
          E(acc, cur, S, w2 >> 2, w2 & 3, l2 & 15, l2 >> 4, lds, w2, l2); }
        if (!has_next) break;
#pragma unroll
        for (int a = 0; a < 2; ++a)
#pragma unroll
            for (int b = 0; b < 2; ++b)
#pragma unroll
                for (int m = 0; m < 4; ++m)
#pragma unroll
                    for (int n = 0; n < 2; ++n) acc[a][b][m][n] = (f32x4){0.f, 0.f, 0.f, 0.f};
        cur = nxt; cA = nA; cB = nB; ++ui;
        if (wr == 1) PG8_BAR;
    }
    PG8_WAIT_V(0);
    PG8_BAR;
#undef PG8_SA
#undef PG8_SB
#undef PG8_STAGE
#undef PG8_LDA
#undef PG8_LDB
#undef PG8_MMA
#undef PG8_WAIT_V
#undef PG8_WAIT_L
#undef PG8_BAR
#undef PG8_SCHED
}

typedef f32x4 Acc[2][2][4][2];

struct EpiProj {
    static constexpr bool PERM = true;
    bf16_t* O; float* dtraw; const unsigned long long* rowsq; const float* bias;
    __device__ __forceinline__ void operator()(Acc& acc, const Unit& u, const Order&, int wr, int wc, int fr, int fq, LAS unsigned char*, int, int) const {
        const int row0 = u.pm * BM + wr * 64 + fr, col0 = u.pn * BM + wc * 32 + 8 * fq;
        const float* bp = bias + (size_t)((u.pm * BM) / SEQ) * NPROJ + col0;
        f32x4 bv[2][2];
#pragma unroll
        for (int bj = 0; bj < 2; ++bj) { bv[bj][0] = *(const f32x4*)(bp + bj * HALF); bv[bj][1] = *(const f32x4*)(bp + bj * HALF + 4); }
        float r8[2][4];
#pragma unroll
        for (int ai = 0; ai < 2; ++ai)
#pragma unroll
            for (int m = 0; m < 4; ++m) r8[ai][m] = (float)rowsq[row0 + ai * HALF + m * 16] * (1.f / RSQ_SCALE);
#pragma unroll
        for (int ai = 0; ai < 2; ++ai)
#pragma unroll
            for (int m = 0; m < 4; ++m) { const int row = row0 + ai * HALF + m * 16; bf16_t* rowp = O + (size_t)row * NPROJ + col0;
                const float r = __builtin_amdgcn_rsqf(r8[ai][m] * (1.f / D) + EPS);
#pragma unroll
                for (int bj = 0; bj < 2; ++bj) { const f32x4 v0 = acc[ai][bj][m][0] * r + bv[bj][0], v1 = acc[ai][bj][m][1] * r + bv[bj][1];
                    u32x4 w; w.x = cvt_pk_bf16(v0[0], v0[1]); w.y = cvt_pk_bf16(v0[2], v0[3]); w.z = cvt_pk_bf16(v1[0], v1[1]); w.w = cvt_pk_bf16(v1[2], v1[3]);
                    *(u32x4*)(rowp + bj * HALF) = w;
                    if (bj == 1 && col0 + HALF == PC_DT) { *(f32x4*)(dtraw + (size_t)row * 8) = v0; *(f32x4*)(dtraw + (size_t)row * 8 + 4) = v1; } } }
    }
};
struct EpiRes {
    static constexpr bool PERM = false;
    const float* base; float* out; const float* gate;
    bf16_t* hb; const float* ng; const float* sc; unsigned long long* rowsq;
    __device__ __forceinline__ void operator()(Acc& acc, const Unit& u, const Order&, int wr, int wc, int fr, int fq, LAS unsigned char*, int, int lane) const {
        const int row0 = u.pm * BM + wr * 64 + fr, col0 = u.pn * BM + wc * 32 + 4 * fq, b = (u.pm * BM) / SEQ;
        const float* gp = gate + (size_t)b * 6144 + col0;
        f32x4 gv[2][2], gm[2][2];
        {
            f32x4 nv[2][2], sv[2][2];
#pragma unroll
            for (int bj = 0; bj < 2; ++bj)
#pragma unroll
                for (int n = 0; n < 2; ++n) { gv[bj][n] = *(const f32x4*)(gp + bj * HALF + n * 16);
                    nv[bj][n] = *(const f32x4*)(ng + col0 + bj * HALF + n * 16);
                    sv[bj][n] = *(const f32x4*)(sc + (size_t)b * 6144 + col0 + bj * HALF + n * 16); }
#pragma unroll
            for (int bj = 0; bj < 2; ++bj)
#pragma unroll
                for (int n = 0; n < 2; ++n) gm[bj][n] = nv[bj][n] * (sv[bj][n] + 1.f);
        }
        constexpr int EPI_PF = 2;
        f32x4 bsv[8][2][2];
#define RES_LOAD(k) do { const size_t off_ = (size_t)(row0 + ((k) >> 2) * HALF + ((k) & 3) * 16) * D + col0; \
            _Pragma("unroll") for (int bj = 0; bj < 2; ++bj) _Pragma("unroll") for (int n = 0; n < 2; ++n) bsv[k][bj][n] = *(const f32x4*)(base + off_ + bj * HALF + n * 16); } while (0)
#pragma unroll
        for (int k = 0; k < EPI_PF; ++k) RES_LOAD(k);
#pragma unroll
        for (int k = 0; k < 8; ++k) { const int ai = k >> 2, m = k & 3; const int row = row0 + ai * HALF + m * 16; const size_t off = (size_t)row * D + col0; float ss = 0.f;
            f32x4 v[2][2];
#pragma unroll
            for (int bj = 0; bj < 2; ++bj)
#pragma unroll
                for (int n = 0; n < 2; ++n) v[bj][n] = bsv[k][bj][n] + gv[bj][n] * acc[ai][bj][m][n];
            if (k + EPI_PF < 8) RES_LOAD(k + EPI_PF);
#pragma unroll
            for (int bj = 0; bj < 2; ++bj)
#pragma unroll
                for (int n = 0; n < 2; ++n) { const f32x4 vv = v[bj][n];
                    *(f32x4*)(out + off + bj * HALF + n * 16) = vv;
                    if (hb) { ss += (vv.x * vv.x + vv.y * vv.y) + (vv.z * vv.z + vv.w * vv.w); const f32x4 hv = vv * gm[bj][n];
                        u32x2 w; w.x = cvt_pk_bf16(hv.x, hv.y); w.y = cvt_pk_bf16(hv.z, hv.w); *(u32x2*)(hb + off + bj * HALF + n * 16) = w; } }
            if (hb) { ss += shx(ss, 16, lane); ss += shx(ss, 32, lane); if (fq == 0) atomicAdd(rowsq + row, (unsigned long long)(ss * RSQ_SCALE + 0.5f)); }
        }
#undef RES_LOAD
    }
};
struct EpiMla {
    static constexpr bool PERM = true;
    bf16_t* Q; bf16_t* KV; const float* rs; int isq_;
    __device__ __forceinline__ void operator()(Acc& acc, const Unit& u, const Order&, int wr, int wc, int fr, int fq, LAS unsigned char*, int, int) const {
        const bool isq = isq_ != 0;
        const int row0 = u.pm * BM + wr * 64 + fr, col0 = u.pn * BM + wc * 32 + 8 * fq;
        bf16_t* O = isq ? Q : KV; const int ldo = isq ? 384 : 512; const float* rsp = isq ? rs : rs + M; const float scale = isq ? MLA_QSCALE : 1.f;
        float r8[2][4];
#pragma unroll
        for (int ai = 0; ai < 2; ++ai)
#pragma unroll
            for (int m = 0; m < 4; ++m) r8[ai][m] = rsp[row0 + ai * HALF + m * 16];
#pragma unroll
        for (int ai = 0; ai < 2; ++ai)
#pragma unroll
            for (int m = 0; m < 4; ++m) { const int row = row0 + ai * HALF + m * 16; const float r = r8[ai][m] * scale;
#pragma unroll
                for (int bj = 0; bj < 2; ++bj) { const int c8 = col0 + bj * HALF; if (c8 < ldo) { const f32x4 v0 = acc[ai][bj][m][0] * r, v1 = acc[ai][bj][m][1] * r;
                    u32x4 w; w.x = cvt_pk_bf16(v0[0], v0[1]); w.y = cvt_pk_bf16(v0[2], v0[3]); w.z = cvt_pk_bf16(v1[0], v1[1]); w.w = cvt_pk_bf16(v1[2], v1[3]);
                    *(u32x4*)(O + (size_t)row * ldo + c8) = w; } } }
    }
};
#define DPPR(src, ctrl) __builtin_bit_cast(float, __builtin_amdgcn_update_dpp(0, __builtin_bit_cast(int, (float)(src)), (ctrl), 0xf, 0xf, true))
#define DPPF(old, src, ctrl) __builtin_bit_cast(float, __builtin_amdgcn_update_dpp(__builtin_bit_cast(int, (float)(old)), __builtin_bit_cast(int, (float)(src)), (ctrl), 0xf, 0xf, false))
struct EpiUp {
    static constexpr bool PERM = true;
    bf16_t* O; const float* cw; const float* cb;
    const unsigned long long* rowsq; const float* bias;
    __device__ __forceinline__ void operator()(Acc& acc, const Unit& u, const Order&, int wr, int wc, int fr, int fq, LAS unsigned char* lds, int, int) const {
        LAS float* bnd = (LAS float*)(lds + LDS_EXTRA);
        const int cl = wc * 32 + 8 * fq;
        {
            const int bq = u.pm / 17, tq0 = (u.pm % 17) * 254 - 2;
            const float* bp = bias + (size_t)bq * (2 * DFF) + u.pn * BM + cl;
            f32x4 bv[2][2];
#pragma unroll
            for (int bj = 0; bj < 2; ++bj) { bv[bj][0] = *(const f32x4*)(bp + bj * HALF); bv[bj][1] = *(const f32x4*)(bp + bj * HALF + 4); }
#pragma unroll
            for (int ai = 0; ai < 2; ++ai)
#pragma unroll
                for (int m = 0; m < 4; ++m) { int gr = bq * SEQ + tq0 + ai * HALF + wr * 64 + m * 16 + fr; gr = gr < 0 ? 0 : (gr > M - 1 ? M - 1 : gr);
                    const float r = __builtin_amdgcn_rsqf((float)rowsq[gr] * (1.f / RSQ_SCALE) * (1.f / D) + EPS);
#pragma unroll
                    for (int bj = 0; bj < 2; ++bj) { acc[ai][bj][m][0] = acc[ai][bj][m][0] * r + bv[bj][0]; acc[ai][bj][m][1] = acc[ai][bj][m][1] * r + bv[bj][1]; } }
        }
        if (fr >= 14) {
#pragma unroll
            for (int ai = 0; ai < 2; ++ai)
#pragma unroll
                for (int bj = 0; bj < 2; ++bj)
#pragma unroll
                    for (int n = 0; n < 2; ++n) *(LAS f32x4*)(bnd + ((ai * 2 + wr) * 2 + (fr - 14)) * 256 + bj * HALF + cl + 4 * n) = acc[ai][bj][3][n];
        }
        asm volatile("s_waitcnt lgkmcnt(0)" ::: "memory"); __builtin_amdgcn_s_barrier(); asm volatile("" ::: "memory");
        const int b = u.pm / 17, t0 = (u.pm % 17) * 254 - 2;
        const int ch0 = u.pn * HALF + cl;
#pragma unroll
        for (int ai = 0; ai < 2; ++ai) {
        u32x2 stash[4];
#pragma unroll
        for (int n = 0; n < 2; ++n) {
            f32x4 w0[2], w1[2], w2[2], bb[2];
#pragma unroll
            for (int bj = 0; bj < 2; ++bj) { const int cc = bj * DFF + ch0 + 4 * n;
                w0[bj] = *(const f32x4*)(cw + cc); w1[bj] = *(const f32x4*)(cw + 2 * DFF + cc); w2[bj] = *(const f32x4*)(cw + 4 * DFF + cc); bb[bj] = *(const f32x4*)(cb + cc); }
#pragma unroll
                for (int m = 0; m < 4; ++m) {
                    f32x4 uu[2];
#pragma unroll
                    for (int bj = 0; bj < 2; ++bj) {
                        const f32x4 v = acc[ai][bj][m][n];
                        f32x4 pv;
                        if (m > 0) pv = acc[ai][bj][m - 1][n];
                        else if (wr == 1 || ai == 1) { const int src = (wr == 1) ? (ai * 2 + 0) : (0 * 2 + 1); pv = *(const LAS f32x4*)(bnd + (src * 2 + ((fr - 14) & 1)) * 256 + bj * HALF + cl + 4 * n); }
                        else pv = (f32x4){0.f, 0.f, 0.f, 0.f};
                        f32x4 p1, p2;
#pragma unroll
                        for (int j = 0; j < 4; ++j) { const float c1 = (fr == 15) ? pv[j] : v[j], c2 = (fr >= 14) ? pv[j] : v[j];
                            p1[j] = DPPR(c1, 0x121); p2[j] = DPPR(c2, 0x122); }
                        if (ai == 0 && m == 0 && wr == 0 && t0 < 0) { const int tq = t0 + fr; if (tq < 1) p1 = (f32x4){0.f, 0.f, 0.f, 0.f}; if (tq < 2) p2 = (f32x4){0.f, 0.f, 0.f, 0.f}; }
                        uu[bj] = bb[bj] + w2[bj] * v + w1[bj] * p1 + w0[bj] * p2;
                    }
                    const int r = ai * HALF + wr * 64 + m * 16 + fr, t = t0 + r;
                    f32x4 o;
#pragma unroll
                    for (int j = 0; j < 4; ++j) o[j] = silu_f(uu[0][j]) * uu[1][j];
                    if (n == 0) { stash[m].x = cvt_pk_bf16(o[0], o[1]); stash[m].y = cvt_pk_bf16(o[2], o[3]); }
                    else if (r >= 2 && t < SEQ) { u32x4 w; w.x = stash[m].x; w.y = stash[m].y; w.z = cvt_pk_bf16(o[0], o[1]); w.w = cvt_pk_bf16(o[2], o[3]);
                        *(u32x4*)(O + ((size_t)b * SEQ + t) * DFF + ch0) = w; }
                    asm volatile("" ::: "memory");
                }
        }
        }
    }
};
}

struct Args {
    const float* x; const float* c; const int* pos;
    const float* ada_w; const float* ada_b; const float* n1g; const float* n2g; const float* w_in;
    const float* sconv_w; const float* sconv_b; const float* dt_bias; const float* a_log; const float* ssd_d; const float* ssd_ng;
    const float* qng; const float* w_uq; const float* kvng; const float* w_ukv; const float* sinks; const float* w_out;
    const float* w_up; const float* fconv_w; const float* fconv_b; const float* w_dn; const float* fng;
    float* out; unsigned char* ws; int ph_lo, ph_hi, wv, pad2;
};

__device__ __forceinline__ void phase_mod(const Args& a, LAS unsigned char* lds, int G) {
    LAS float* cact = (LAS float*)lds;
    LAS float* red = (LAS float*)(lds + 32768);
    const int tid = tid_opaque(a.wv), lane = tid & 63, wave = __builtin_amdgcn_readfirstlane(tid >> 6);
    for (int i = tid; i < 8 * 1024; i += 512) cact[i] = silu_f(a.c[i]);
    __syncthreads();
    float* mod = (float*)(a.ws + WS_MOD);
    for (int item = blockIdx.x; item < 4 * 96; item += G) {
        const int l = item / 96, col = (item % 96) * 64 + lane;
        const float* W = a.ada_w + (size_t)l * 1024 * 6144 + col;
        float s[8];
#pragma unroll
        for (int b = 0; b < 8; ++b) s[b] = 0.f;
        for (int k0 = wave * 128; k0 < wave * 128 + 128; k0 += 16) { float wv16[16];
#pragma unroll
            for (int q = 0; q < 16; ++q) wv16[q] = W[(size_t)(k0 + q) * 6144];
#pragma unroll
            for (int q = 0; q < 16; ++q)
#pragma unroll
                for (int b = 0; b < 8; ++b) s[b] += cact[b * 1024 + k0 + q] * wv16[q]; }
#pragma unroll
        for (int b = 0; b < 8; ++b) red[(wave * 8 + b) * 64 + lane] = s[b];
        __syncthreads();
        float t = 0.f;
#pragma unroll
        for (int w = 0; w < 8; ++w) t += red[(w * 8 + wave) * 64 + lane];
        mod[((size_t)l * 8 + wave) * 6144 + col] = t + a.ada_b[(size_t)l * 6144 + col];
        __syncthreads();
    }
}
__device__ __forceinline__ void phase_rope(const Args& a, int G) {
    float* rope = (float*)(a.ws + WS_ROPE);
    for (int idx = blockIdx.x * 512 + tid_opaque(a.wv); idx < M * 16; idx += G * 512) {
        const int row = idx >> 4, i = idx & 15;
        float inv = 1.778279402e-04f;
        inv = (i == 14) ? 3.162277571e-04f : inv;
        inv = (i == 13) ? 5.623413017e-04f : inv;
        inv = (i == 12) ? 1.000000047e-03f : inv;
        inv = (i == 11) ? 1.778279431e-03f : inv;
        inv = (i == 10) ? 3.162277630e-03f : inv;
        inv = (i == 9) ? 5.623413250e-03f : inv;
        inv = (i == 8) ? 9.999999776e-03f : inv;
        inv = (i == 7) ? 1.778279431e-02f : inv;
        inv = (i == 6) ? 3.162277490e-02f : inv;
        inv = (i == 5) ? 5.623413250e-02f : inv;
        inv = (i == 4) ? 1.000000015e-01f : inv;
        inv = (i == 3) ? 1.778279394e-01f : inv;
        inv = (i == 2) ? 3.162277639e-01f : inv;
        inv = (i == 1) ? 5.623413324e-01f : inv;
        inv = (i == 0) ? 1.000000000e+00f : inv;
        const float ang = (float)a.pos[row] * inv;
        const double rev = (double)ang * 0.15915494309189535;
        const float fr = (float)(rev - (double)(int)rev);
        rope[(size_t)row * 32 + i] = __builtin_amdgcn_cosf(fr);
        rope[(size_t)row * 32 + 16 + i] = __builtin_amdgcn_sinf(fr);
    }
}
enum { MAP_ID = 0, MAP_IN = 1, MAP_UP = 2, MAP_UQ = 3, MAP_ZERO = 4 };
__device__ __forceinline__ int map_col(int kind, int n) {
    if (kind == MAP_ID) return n;
    if (kind == MAP_ZERO) return -1;
    if (kind == MAP_IN) {
        if (n < 1536) return n;
        if (n < 1920) return n + 8;
        if (n < 1952) { const int e = n - 1920; return 1928 + 16 * (e & 1) + (e >> 1); }
        if (n < 2464) return n + 8;
        if (n < 2472) return n - 2464 + 1536;
        return -1;
    }
    if (kind == MAP_UP) { const int pn = n >> 8, cl = n & 255; return cl < 128 ? pn * 128 + cl : DFF + pn * 128 + (cl - 128); }
    if (n >= 384) return -1;
    { const int h = n / 96, d = n % 96; if (d < 64) return h * 96 + d; const int e = d - 64; return h * 96 + 64 + 16 * (e & 1) + (e >> 1); }
}
__device__ __forceinline__ void tr_item(const float* W, int N, int ks0, bf16_t* WT, int Kd, int kd0, int n0, int kind, const float* ksc, LAS float* scr, int lane) {
    const int src = map_col(kind, n0 + (lane & 31));
    const int srcc = src < 0 ? 0 : src; const float msk = src < 0 ? 0.f : 1.f;
    float vals[32];
#pragma unroll
    for (int i = 0; i < 32; ++i) vals[i] = W[(size_t)(ks0 + 2 * i + (lane >> 5)) * N + srcc];
    if (ksc) {
#pragma unroll
        for (int i = 0; i < 32; ++i) vals[i] *= ksc[ks0 + 2 * i + (lane >> 5)];
    }
#pragma unroll
    for (int i = 0; i < 32; ++i) scr[(2 * i + (lane >> 5)) * 33 + (lane & 31)] = vals[i] * msk;
    asm volatile("s_waitcnt lgkmcnt(0)" ::: "memory");
    const int c = lane & 7;
#pragma unroll
    for (int j = 0; j < 4; ++j) { const int n = (lane >> 3) + 8 * j; const LAS float* s = scr + (8 * c) * 33 + n;
        u32x4 o; o.x = pk2(s[0 * 33], s[1 * 33]); o.y = pk2(s[2 * 33], s[3 * 33]); o.z = pk2(s[4 * 33], s[5 * 33]); o.w = pk2(s[6 * 33], s[7 * 33]);
        *(u32x4*)(WT + (size_t)(n0 + n) * Kd + kd0 + 8 * c) = o; }
    asm volatile("s_waitcnt lgkmcnt(0)" ::: "memory");
}
__device__ __forceinline__ void phase_weights(const Args& a, int l, unsigned char* wb, LAS unsigned char* lds, int G) {
    const int tid_ = tid_opaque(a.wv), lane = tid_ & 63, wave = tid_ >> 6;
    LAS float* scr = (LAS float*)(lds + wave * 16384);
    constexpr int I_IN = 16 * 80, I_OUT = 16 * 32, I_UP = 16 * 176, I_DN = 44 * 32, I_QKV = 4 * 16 + 2 * 16;
    constexpr int NIT = I_IN + I_OUT + I_UP + I_DN + I_QKV;
    for (int it = blockIdx.x * 8 + wave; it < NIT; it += G * 8) {
        int r = it;
        if (r < I_IN) { tr_item(a.w_in + (size_t)l * D * DIN, DIN, 64 * (r / 80), (bf16_t*)(wb + WO_IN), D, 64 * (r / 80), 32 * (r % 80), MAP_IN, nullptr, scr, lane); continue; } r -= I_IN;
        if (r < I_OUT) { tr_item(a.w_out + (size_t)l * D * D, D, 64 * (r / 32), (bf16_t*)(wb + WO_OUT), D, 64 * (r / 32), 32 * (r % 32), MAP_ID, nullptr, scr, lane); continue; } r -= I_OUT;
        if (r < I_UP) { tr_item(a.w_up + (size_t)l * D * 2 * DFF, 2 * DFF, 64 * (r / 176), (bf16_t*)(wb + WO_UP), D, 64 * (r / 176), 32 * (r % 176), MAP_UP, nullptr, scr, lane); continue; } r -= I_UP;
        if (r < I_DN) { tr_item(a.w_dn + (size_t)l * DFF * D, D, 64 * (r / 32), (bf16_t*)(wb + WO_DN), DFF, 64 * (r / 32), 32 * (r % 32), MAP_ID, nullptr, scr, lane); continue; } r -= I_DN;
        { if (r < 4 * 16) tr_item(a.w_uq + (size_t)l * 256 * 384, 384, 64 * (r / 16), (bf16_t*)(wb + WO_UQ), 256, 64 * (r / 16), 32 * (r % 16), MAP_UQ, a.qng + l * 256, scr, lane);
          else { r -= 64; tr_item(a.w_ukv + (size_t)l * 128 * 512, 512, 64 * (r / 16), (bf16_t*)(wb + WO_UKV), 128, 64 * (r / 16), 32 * (r % 16), MAP_ID, a.kvng + l * 128, scr, lane); } }
    }
}

__device__ __forceinline__ void phase_bias(const Args& a, int l, float* bias, LAS unsigned char* lds, int G) {
    LAS float* shv = (LAS float*)lds;
    LAS float* red = (LAS float*)(lds + 65536);
    const int tid = tid_opaque(a.wv), lane = tid & 63, wave = __builtin_amdgcn_readfirstlane(tid >> 6);
    const float* ml = (const float*)(a.ws + WS_MOD) + (size_t)l * 8 * 6144;
    __syncthreads();
    for (int i = tid; i < 2 * 8 * 1024; i += 512) { const int which = i >> 13, b = (i >> 10) & 7, k = i & 1023; shv[i] = ml[(size_t)b * 6144 + (which ? 3072 : 0) + k]; }
    __syncthreads();
    for (int item = blockIdx.x; item < 80 + 176; item += G) {
        const bool up = item >= 80; const int n = (up ? item - 80 : item) * 32 + (lane & 31), N = up ? 2 * DFF : DIN;
        const int src = map_col(up ? MAP_UP : MAP_IN, n);
        const float* W = (up ? a.w_up + (size_t)l * D * 2 * DFF : a.w_in + (size_t)l * D * DIN) + (src < 0 ? 0 : src);
        const LAS float* sv = shv + (up ? 8192 : 0);
        float s8[8];
#pragma unroll
        for (int b = 0; b < 8; ++b) s8[b] = 0.f;
        const int kb = wave * 128 + (lane >> 5) * 64;
        for (int k0 = kb; k0 < kb + 64; k0 += 16) { float wv16[16];
#pragma unroll
            for (int q = 0; q < 16; ++q) wv16[q] = W[(size_t)(k0 + q) * N];
#pragma unroll
            for (int q = 0; q < 16; ++q)
#pragma unroll
                for (int b = 0; b < 8; ++b) s8[b] += sv[b * 1024 + k0 + q] * wv16[q]; }
#pragma unroll
        for (int b = 0; b < 8; ++b) { s8[b] += shx(s8[b], 32, lane); red[(wave * 8 + b) * 64 + lane] = s8[b]; }
        __syncthreads();
        if (lane < 32) { float t = 0.f;
#pragma unroll
            for (int w = 0; w < 8; ++w) t += red[(w * 8 + wave) * 64 + lane];
            (up ? bias + 8 * NPROJ : bias)[(size_t)wave * (up ? 2 * DFF : NPROJ) + n] = src < 0 ? 0.f : t; }
        __syncthreads();
    }
}
__device__ __forceinline__ void phase_norm0(const float* xin, const float* g, const float* sc, bf16_t* hout, unsigned long long* rowsq, int G, int wv) {
    const int tid_ = tid_opaque(wv), lane = tid_ & 63, wave = tid_ >> 6;
    for (int row = blockIdx.x * 8 + wave; row < M; row += G * 8) {
        const int b = row / SEQ;
        const f32x4* xr = (const f32x4*)(xin + (size_t)row * D) + lane;
        f32x4 v[4]; float s = 0.f;
#pragma unroll
        for (int j = 0; j < 4; ++j) { v[j] = xr[64 * j]; s += (v[j].x * v[j].x + v[j].y * v[j].y) + (v[j].z * v[j].z + v[j].w * v[j].w); }
        s = wave_sum(s, lane);
        if (lane == 0) rowsq[row] = (unsigned long long)(s * RSQ_SCALE + 0.5f);
        u32x2* o8 = (u32x2*)(hout + (size_t)row * D) + lane;
#pragma unroll
        for (int j = 0; j < 4; ++j) { const int col = 4 * lane + 256 * j;
            const f32x4 y = v[j] * *(const f32x4*)(g + col) * (*(const f32x4*)(sc + (size_t)b * 6144 + col) + 1.f);
            u32x2 w; w.x = cvt_pk_bf16(y.x, y.y); w.y = cvt_pk_bf16(y.z, y.w); o8[64 * j] = w; }
    }
}
__device__ __forceinline__ void phase_final(float* x, const float* g, int G, int wv) {
    const int tid_ = tid_opaque(wv), lane = tid_ & 63, wave = tid_ >> 6;
    for (int row = blockIdx.x * 8 + wave; row < M; row += G * 8) {
        f32x4* xr = (f32x4*)(x + (size_t)row * D) + lane;
        f32x4 v[4]; float s = 0.f;
#pragma unroll
        for (int j = 0; j < 4; ++j) { v[j] = xr[64 * j]; s += (v[j].x * v[j].x + v[j].y * v[j].y) + (v[j].z * v[j].z + v[j].w * v[j].w); }
        const float r = 1.f / sqrtf(wave_sum(s, lane) * (1.f / D) + EPS);
#pragma unroll
        for (int j = 0; j < 4; ++j) { const f32x4 gg = *(const f32x4*)(g + 4 * lane + 256 * j); xr[64 * j] = v[j] * r * gg; }
    }
}
__device__ __forceinline__ void phase_prep(const Args& a, int l, int G) {
    const int tid_ = tid_opaque(a.wv), lane = tid_ & 63, wave = tid_ >> 6;
    const bf16_t* proj = (const bf16_t*)(a.ws + WS_PROJ);
    bf16_t* xbc = (bf16_t*)(a.ws + WS_H);
    const float* cw = a.sconv_w + (size_t)l * 4 * 1024; const float* cb = a.sconv_b + (size_t)l * 1024;
    const float* dtraw = (const float*)(a.ws + WS_DTRAW); float* dtsp = (float*)(a.ws + WS_DTSP);
    float* rq = (float*)(a.ws + WS_RS); float* rkv = rq + M; unsigned long long* rsq = (unsigned long long*)(a.ws + WS_RSQ);
    const float* rope = (const float*)(a.ws + WS_ROPE); bf16_t* kr = (bf16_t*)(a.ws + WS_KR);
    f32x4 wk[2][4][2], bk[2][2];
#pragma unroll
    for (int j = 0; j < 2; ++j) { const int ch = 8 * lane + 512 * j; bk[j][0] = *(const f32x4*)(cb + ch); bk[j][1] = *(const f32x4*)(cb + ch + 4);
#pragma unroll
        for (int k = 0; k < 4; ++k) { wk[j][k][0] = *(const f32x4*)(cw + k * 1024 + ch); wk[j][k][1] = *(const f32x4*)(cw + k * 1024 + ch + 4); } }
    const float dtb = lane < 8 ? a.dt_bias[l * 8 + lane] : 0.f;
    for (int run = blockIdx.x * 8 + wave; run < M / 16; run += G * 8) {
        const int rowb = run * 16, tb = rowb % SEQ;
        u32x4 win[2][3];
#pragma unroll
        for (int j = 0; j < 2; ++j)
#pragma unroll
            for (int k = 0; k < 3; ++k) { win[j][k] = (u32x4){0u, 0u, 0u, 0u}; if (tb - 3 + k >= 0) win[j][k] = *(const u32x4*)(proj + (size_t)(rowb - 3 + k) * NPROJ + PC_X + 8 * lane + 512 * j); }
        for (int r4 = 0; r4 < 16; r4 += 4) {
            u32x4 curv[4][2], cqv[4]; float dtr[4], rcs[4], rsn[4]; unsigned krv[4];
#pragma unroll
            for (int q = 0; q < 4; ++q) { const size_t row = (size_t)(rowb + r4 + q);
                curv[q][0] = *(const u32x4*)(proj + row * NPROJ + PC_X + 8 * lane); curv[q][1] = *(const u32x4*)(proj + row * NPROJ + PC_X + 8 * lane + 512);
                cqv[q] = (u32x4){0u, 0u, 0u, 0u}; if (lane < 48) cqv[q] = *(const u32x4*)(proj + row * NPROJ + PC_CQ + 8 * lane);
                dtr[q] = lane < 8 ? dtraw[row * 8 + lane] : 0.f;
                krv[q] = 0u; rcs[q] = 0.f; rsn[q] = 0.f;
                if (lane < 16) { krv[q] = *(const unsigned*)(proj + row * NPROJ + PC_KR + 2 * lane); rcs[q] = rope[row * 32 + lane]; rsn[q] = rope[row * 32 + 16 + lane]; } }
#pragma unroll
            for (int q = 0; q < 4; ++q) { const int row = rowb + r4 + q;
#pragma unroll
                for (int j = 0; j < 2; ++j) { const int ch = 8 * lane + 512 * j;
                    const u32x4 cur = curv[q][j];
                    f32x4 a0 = bk[j][0], a1 = bk[j][1];
#pragma unroll
                    for (int k = 0; k < 4; ++k) { const u32x4 pv = k < 3 ? win[j][k] : cur;
                        a0 += wk[j][k][0] * (f32x4){bflo(pv.x), bfhi(pv.x), bflo(pv.y), bfhi(pv.y)}; a1 += wk[j][k][1] * (f32x4){bflo(pv.z), bfhi(pv.z), bflo(pv.w), bfhi(pv.w)}; }
                    win[j][0] = win[j][1]; win[j][1] = win[j][2]; win[j][2] = cur;
                    u32x4 o; o.x = cvt_pk_bf16(silu_f(a0.x), silu_f(a0.y)); o.y = cvt_pk_bf16(silu_f(a0.z), silu_f(a0.w)); o.z = cvt_pk_bf16(silu_f(a1.x), silu_f(a1.y)); o.w = cvt_pk_bf16(silu_f(a1.z), silu_f(a1.w));
                    *(u32x4*)(xbc + (size_t)row * 1024 + ch) = o; }
                if (lane == 0) { rsq[row] = 0ull; rsq[M + row] = 0ull; }
                if (lane < 8) { const float v = dtr[q] + dtb; dtsp[(size_t)row * 8 + lane] = v > 15.f ? v : __logf(1.f + __expf(v)); }
                { const u32x4 pv = cqv[q];
                  const float f0 = bflo(pv.x), f1 = bfhi(pv.x), f2 = bflo(pv.y), f3 = bfhi(pv.y), f4 = bflo(pv.z), f5 = bfhi(pv.z), f6 = bflo(pv.w), f7 = bfhi(pv.w);
                  const float s = (f0 * f0 + f1 * f1) + (f2 * f2 + f3 * f3) + (f4 * f4 + f5 * f5) + (f6 * f6 + f7 * f7);
                  float sq = lane < 32 ? s : 0.f, sk = (lane >= 32 && lane < 48) ? s : 0.f;
                  sq = wave_sum(sq, lane); sk = wave_sum(sk, lane);
                  if (lane == 0) { rq[row] = __builtin_amdgcn_rsqf(sq * (1.f / 256.f) + EPS); rkv[row] = __builtin_amdgcn_rsqf(sk * (1.f / 128.f) + EPS); } }
                if (lane < 16) { const float x1 = bflo(krv[q]), x2 = bfhi(krv[q]);
                    *(unsigned*)(kr + (size_t)row * 32 + 2 * lane) = cvt_pk_bf16(x1 * rcs[q] - x2 * rsn[q], x1 * rsn[q] + x2 * rcs[q]); }
            }
        }
    }
}
__device__ __forceinline__ void phase_ssd_naive(const Args& a, int l, int G) {
    const int tid = tid_opaque(a.wv), pl = tid >> 5, nq = tid & 31, lane = tid & 63;
    const bf16_t* xbc = (const bf16_t*)(a.ws + WS_H);
    const bf16_t* proj = (const bf16_t*)(a.ws + WS_PROJ);
    const float* dtsp = (const float*)(a.ws + WS_DTSP);
    float* ytmp = (float*)(a.ws + WS_YS);
    for (int unit = blockIdx.x; unit < 256; unit += G) {
        const int b = unit >> 5, h = (unit >> 2) & 7, pq = unit & 3, g = h >> 2, p = pq * 16 + pl;
        const float av = -__expf(a.a_log[l * 8 + h]), dsk = a.ssd_d[l * 8 + h];
        float s0 = 0.f, s1 = 0.f, s2 = 0.f, s3 = 0.f;
        for (int t = 0; t < SEQ; ++t) {
            const size_t row = (size_t)b * SEQ + t;
            const float dt = dtsp[row * 8 + h];
            const float x = bf2f(xbc[row * 1024 + h * 64 + p]);
            const u32x2 bv = *(const u32x2*)(xbc + row * 1024 + 512 + g * 128 + 4 * nq);
            const u32x2 cv = *(const u32x2*)(xbc + row * 1024 + 768 + g * 128 + 4 * nq);
            const float dA = __expf(dt * av), xd = dt * x;
            s0 = s0 * dA + xd * bflo(bv.x); s1 = s1 * dA + xd * bfhi(bv.x); s2 = s2 * dA + xd * bflo(bv.y); s3 = s3 * dA + xd * bfhi(bv.y);
            float y = (s0 * bflo(cv.x) + s1 * bfhi(cv.x)) + (s2 * bflo(cv.y) + s3 * bfhi(cv.y));
            y += shx(y, 16, lane); y += shx(y, 8, lane); y += shx(y, 4, lane); y += shx(y, 2, lane); y += shx(y, 1, lane);
            if (nq == 0) { const float z = bf2f(proj[row * NPROJ + PC_Z + h * 64 + p]); ytmp[row * 512 + h * 64 + p] = (y + dsk * x) * silu_f(z); }
        }
    }
}
__device__ __forceinline__ void phase_ssd_norm(const Args& a, int l, int G) {
    const int tid_ = tid_opaque(a.wv), lane = tid_ & 63, wave = tid_ >> 6;
    const float* ytmp = (const float*)(a.ws + WS_YS); bf16_t* ycat = (bf16_t*)(a.ws + WS_YCAT);
    const float* ng = a.ssd_ng + l * 512;
    for (int row = blockIdx.x * 8 + wave; row < M; row += G * 8) {
        const f32x4 v0 = *(const f32x4*)(ytmp + (size_t)row * 512 + 8 * lane), v1 = *(const f32x4*)(ytmp + (size_t)row * 512 + 8 * lane + 4);
        float s = (v0.x * v0.x + v0.y * v0.y) + (v0.z * v0.z + v0.w * v0.w) + (v1.x * v1.x + v1.y * v1.y) + (v1.z * v1.z + v1.w * v1.w);
        s += shx(s, 16, lane); s += shx(s, 8, lane); s += shx(s, 4, lane); s += shx(s, 2, lane); s += shx(s, 1, lane);
        const float r = 1.f / sqrtf(s * (1.f / 256.f) + EPS);
        const f32x4 g0 = *(const f32x4*)(ng + 8 * lane), g1 = *(const f32x4*)(ng + 8 * lane + 4);
        u32x4 o; o.x = cvt_pk_bf16(v0.x * r * g0.x, v0.y * r * g0.y); o.y = cvt_pk_bf16(v0.z * r * g0.z, v0.w * r * g0.w); o.z = cvt_pk_bf16(v1.x * r * g1.x, v1.y * r * g1.y); o.w = cvt_pk_bf16(v1.z * r * g1.z, v1.w * r * g1.w);
        *(u32x4*)(ycat + (size_t)row * 1024 + 8 * lane) = o;
    }
}

constexpr size_t WS_CDEC = 399 * MiB;
__device__ __forceinline__ void phase_ssd_states(const Args& a, int l, int G) {
    const int tid = tid_opaque(a.wv), p = tid >> 3, no = tid & 7;
    const bf16_t* xbc = (const bf16_t*)(a.ws + WS_H); const float* dtsp = (const float*)(a.ws + WS_DTSP);
    float* states = (float*)(a.ws + WS_YS); float* cdec = (float*)(a.ws + WS_CDEC);
    for (int u = blockIdx.x; u < 2048; u += G) {
        const int b = u >> 8, c = (u >> 3) & 31, h = u & 7, g = h >> 2;
        const float av = -__expf(a.a_log[l * 8 + h]);
        float st[16];
#pragma unroll
        for (int j = 0; j < 16; ++j) st[j] = 0.f;
        float asum = 0.f;
        const size_t row0 = (size_t)b * SEQ + c * 128;
#pragma unroll 2
        for (int s2 = 0; s2 < 128; ++s2) { const size_t row = row0 + s2;
            const float dt = dtsp[row * 8 + h], da = dt * av, dA = __expf(da), xd = dt * bf2f(xbc[row * 1024 + h * 64 + p]);
            const u32x4 b0 = *(const u32x4*)(xbc + row * 1024 + 512 + g * 128 + 16 * no), b1 = *(const u32x4*)(xbc + row * 1024 + 512 + g * 128 + 16 * no + 8);
            asum += da;
            st[0] = st[0] * dA + xd * bflo(b0.x); st[1] = st[1] * dA + xd * bfhi(b0.x); st[2] = st[2] * dA + xd * bflo(b0.y); st[3] = st[3] * dA + xd * bfhi(b0.y);
            st[4] = st[4] * dA + xd * bflo(b0.z); st[5] = st[5] * dA + xd * bfhi(b0.z); st[6] = st[6] * dA + xd * bflo(b0.w); st[7] = st[7] * dA + xd * bfhi(b0.w);
            st[8] = st[8] * dA + xd * bflo(b1.x); st[9] = st[9] * dA + xd * bfhi(b1.x); st[10] = st[10] * dA + xd * bflo(b1.y); st[11] = st[11] * dA + xd * bfhi(b1.y);
            st[12] = st[12] * dA + xd * bflo(b1.z); st[13] = st[13] * dA + xd * bfhi(b1.z); st[14] = st[14] * dA + xd * bflo(b1.w); st[15] = st[15] * dA + xd * bfhi(b1.w); }
        float* sp = states + (size_t)u * 8192 + p * 128 + 16 * no;
#pragma unroll
        for (int j = 0; j < 4; ++j) *(f32x4*)(sp + 4 * j) = (f32x4){st[4 * j], st[4 * j + 1], st[4 * j + 2], st[4 * j + 3]};
        if (tid == 0) cdec[u] = __expf(asum);
    }
}
__device__ __forceinline__ void phase_ssd_scan(const Args& a, int G) {
    bf16_t* states = (bf16_t*)(a.ws + WS_YS); const float* cdec = (const float*)(a.ws + WS_CDEC);
    for (int e = blockIdx.x * 512 + tid_opaque(a.wv); e < 8 * 8 * 2048; e += G * 512) {
        const int b = e >> 14, h = (e >> 11) & 7, pn = e & 2047;
        f32x4 hc = (f32x4){0.f, 0.f, 0.f, 0.f};
#pragma unroll 8
        for (int c = 0; c < 32; ++c) { const int u = (b * 32 + c) * 8 + h; u32x2* sp = (u32x2*)(states + (size_t)u * 8192) + pn;
            const u32x2 v = *sp; u32x2 w; w.x = cvt_pk_bf16(hc.x, hc.y); w.y = cvt_pk_bf16(hc.z, hc.w); *sp = w;
            hc = hc * cdec[u] + (f32x4){bflo(v.x), bfhi(v.x), bflo(v.y), bfhi(v.y)}; }
    }
}
__device__ __forceinline__ void phase_ssd_out(const Args& a, int l, LAS unsigned char* lds, int G) {
    const int tid = tid_opaque(a.wv), p = tid >> 3, no = tid & 7, lane = tid & 63, wave = tid >> 6;
    const bf16_t* xbc = (const bf16_t*)(a.ws + WS_H); const bf16_t* proj = (const bf16_t*)(a.ws + WS_PROJ); const float* dtsp = (const float*)(a.ws + WS_DTSP);
    const float* states = (const float*)(a.ws + WS_YS); bf16_t* ycat = (bf16_t*)(a.ws + WS_YCAT);
    LAS float* yb = (LAS float*)lds;
    for (int u = blockIdx.x; u < 512; u += G) {
        const int b = u >> 6, c = (u >> 1) & 31, g = u & 1;
        const size_t row0 = (size_t)b * SEQ + c * 128;
        for (int hg = 0; hg < 4; ++hg) { const int h = g * 4 + hg;
            const float av = -__expf(a.a_log[l * 8 + h]), dsk = a.ssd_d[l * 8 + h];
            float st[16];
            { const float* sp = states + (size_t)((b * 32 + c) * 8 + h) * 8192 + p * 128 + 16 * no;
#pragma unroll
              for (int j = 0; j < 4; ++j) { const f32x4 v = *(const f32x4*)(sp + 4 * j); st[4 * j] = v.x; st[4 * j + 1] = v.y; st[4 * j + 2] = v.z; st[4 * j + 3] = v.w; } }
#pragma unroll 2
            for (int s2 = 0; s2 < 128; ++s2) { const size_t row = row0 + s2;
                const float dt = dtsp[row * 8 + h], dA = __expf(dt * av), x = bf2f(xbc[row * 1024 + h * 64 + p]), xd = dt * x;
                const bf16_t* bp = xbc + row * 1024 + 512 + g * 128 + 16 * no;
                const u32x4 b0 = *(const u32x4*)bp, b1 = *(const u32x4*)(bp + 8), c0 = *(const u32x4*)(bp + 256), c1 = *(const u32x4*)(bp + 264);
                st[0] = st[0] * dA + xd * bflo(b0.x); st[1] = st[1] * dA + xd * bfhi(b0.x); st[2] = st[2] * dA + xd * bflo(b0.y); st[3] = st[3] * dA + xd * bfhi(b0.y);
                st[4] = st[4] * dA + xd * bflo(b0.z); st[5] = st[5] * dA + xd * bfhi(b0.z); st[6] = st[6] * dA + xd * bflo(b0.w); st[7] = st[7] * dA + xd * bfhi(b0.w);
                st[8] = st[8] * dA + xd * bflo(b1.x); st[9] = st[9] * dA + xd * bfhi(b1.x); st[10] = st[10] * dA + xd * bflo(b1.y); st[11] = st[11] * dA + xd * bfhi(b1.y);
                st[12] = st[12] * dA + xd * bflo(b1.z); st[13] = st[13] * dA + xd * bfhi(b1.z); st[14] = st[14] * dA + xd * bflo(b1.w); st[15] = st[15] * dA + xd * bfhi(b1.w);
                float y = ((st[0] * bflo(c0.x) + st[1] * bfhi(c0.x)) + (st[2] * bflo(c0.y) + st[3] * bfhi(c0.y))) + ((st[4] * bflo(c0.z) + st[5] * bfhi(c0.z)) + (st[6] * bflo(c0.w) + st[7] * bfhi(c0.w)))
                        + ((st[8] * bflo(c1.x) + st[9] * bfhi(c1.x)) + (st[10] * bflo(c1.y) + st[11] * bfhi(c1.y))) + ((st[12] * bflo(c1.z) + st[13] * bfhi(c1.z)) + (st[14] * bflo(c1.w) + st[15] * bfhi(c1.w)));
                y += shx(y, 4, lane); y += shx(y, 2, lane); y += shx(y, 1, lane);
                if (no == 0) { const float z = bf2f(proj[row * NPROJ + PC_Z + h * 64 + p]); yb[s2 * 256 + hg * 64 + p] = (y + dsk * x) * silu_f(z); }
            }
        }
        __syncthreads();
        const float* ng = a.ssd_ng + l * 512 + g * 256;
        const f32x4 gg = *(const f32x4*)(ng + 4 * lane);
        for (int tk = wave; tk < 128; tk += 8) {
            const f32x4 v = *(const LAS f32x4*)(yb + tk * 256 + 4 * lane);
            const float sq = wave_sum((v.x * v.x + v.y * v.y) + (v.z * v.z + v.w * v.w), lane);
            const float r = 1.f / sqrtf(sq * (1.f / 256.f) + EPS);
            u32x2 w; w.x = cvt_pk_bf16(v.x * r * gg.x, v.y * r * gg.y); w.y = cvt_pk_bf16(v.z * r * gg.z, v.w * r * gg.w);
            *(u32x2*)(ycat + (row0 + tk) * 1024 + g * 256 + 4 * lane) = w;
        }
        __syncthreads();
    }
}

__device__ __forceinline__ void phase_mla_naive(const Args& a, int G) {
    const int tid_ = tid_opaque(a.wv), lane = tid_ & 63, wave = tid_ >> 6;
    const bf16_t* qb = (const bf16_t*)(a.ws + WS_Q); const bf16_t* kv = (const bf16_t*)(a.ws + WS_KV); const bf16_t* kr = (const bf16_t*)(a.ws + WS_KR);
    bf16_t* ycat = (bf16_t*)(a.ws + WS_YCAT);
    for (int blk = blockIdx.x; blk < 256; blk += G) {
        const int bh = blk >> 3, s = blk & 7, b = bh >> 2, h = bh & 3;
        const int c = (wave & 1) ? (16 * (wave >> 1) + 15 - s) : (16 * (wave >> 1) + s);
        const int t = c * 64 + lane; const size_t row = (size_t)b * SEQ + t;
        u32x4 qw[12];
#pragma unroll
        for (int i = 0; i < 12; ++i) qw[i] = *(const u32x4*)(qb + row * 384 + h * 96 + 8 * i);
        { const float* rp = (const float*)(a.ws + WS_ROPE) + row * 32;
#pragma unroll
          for (int i = 0; i < 4; ++i) { const f32x4 cs = *(const f32x4*)(rp + 4 * i), sn = *(const f32x4*)(rp + 16 + 4 * i); u32x4 w = qw[8 + i];
              w.x = cvt_pk_bf16(bflo(w.x) * cs.x - bfhi(w.x) * sn.x, bflo(w.x) * sn.x + bfhi(w.x) * cs.x); w.y = cvt_pk_bf16(bflo(w.y) * cs.y - bfhi(w.y) * sn.y, bflo(w.y) * sn.y + bfhi(w.y) * cs.y);
              w.z = cvt_pk_bf16(bflo(w.z) * cs.z - bfhi(w.z) * sn.z, bflo(w.z) * sn.z + bfhi(w.z) * cs.z); w.w = cvt_pk_bf16(bflo(w.w) * cs.w - bfhi(w.w) * sn.w, bflo(w.w) * sn.w + bfhi(w.w) * cs.w);
              qw[8 + i] = w; } }
        float o[64];
#pragma unroll
        for (int i = 0; i < 64; ++i) o[i] = 0.f;
        float mx = -1e30f, ls = 0.f;
        const int jend = c * 64 + 63;
        for (int j = 0; j <= jend; ++j) {
            const size_t rj = (size_t)b * SEQ + j;
            const bf16_t* kp = kv + rj * 512 + h * 128; const bf16_t* krp = kr + rj * 32;
            float sc = 0.f;
#pragma unroll
            for (int i = 0; i < 8; ++i) { const u32x4 w = *(const u32x4*)(kp + 8 * i); const u32x4 qq = qw[i];
                sc += bflo(qq.x) * bflo(w.x) + bfhi(qq.x) * bfhi(w.x) + bflo(qq.y) * bflo(w.y) + bfhi(qq.y) * bfhi(w.y) + bflo(qq.z) * bflo(w.z) + bfhi(qq.z) * bfhi(w.z) + bflo(qq.w) * bflo(w.w) + bfhi(qq.w) * bfhi(w.w); }
#pragma unroll
            for (int i = 0; i < 4; ++i) { const u32x4 w = *(const u32x4*)(krp + 8 * i); const u32x4 qq = qw[8 + i];
                sc += bflo(qq.x) * bflo(w.x) + bfhi(qq.x) * bfhi(w.x) + bflo(qq.y) * bflo(w.y) + bfhi(qq.y) * bfhi(w.y) + bflo(qq.z) * bflo(w.z) + bfhi(qq.z) * bfhi(w.z) + bflo(qq.w) * bflo(w.w) + bfhi(qq.w) * bfhi(w.w); }
            if (j <= t) {
                const float mn = fmaxf(mx, sc), f = exp2f(mx - mn), p = exp2f(sc - mn);
                ls = ls * f + p; mx = mn;
#pragma unroll
                for (int i = 0; i < 8; ++i) { const u32x4 w = *(const u32x4*)(kp + 64 + 8 * i);
                    o[8 * i] = o[8 * i] * f + p * bflo(w.x); o[8 * i + 1] = o[8 * i + 1] * f + p * bfhi(w.x); o[8 * i + 2] = o[8 * i + 2] * f + p * bflo(w.y); o[8 * i + 3] = o[8 * i + 3] * f + p * bfhi(w.y);
                    o[8 * i + 4] = o[8 * i + 4] * f + p * bflo(w.z); o[8 * i + 5] = o[8 * i + 5] * f + p * bfhi(w.z); o[8 * i + 6] = o[8 * i + 6] * f + p * bflo(w.w); o[8 * i + 7] = o[8 * i + 7] * f + p * bfhi(w.w); }
            }
        }
        const float il = 1.f / ls;
#pragma unroll
        for (int i = 0; i < 8; ++i) { u32x4 w; w.x = cvt_pk_bf16(o[8 * i] * il, o[8 * i + 1] * il); w.y = cvt_pk_bf16(o[8 * i + 2] * il, o[8 * i + 3] * il); w.z = cvt_pk_bf16(o[8 * i + 4] * il, o[8 * i + 5] * il); w.w = cvt_pk_bf16(o[8 * i + 6] * il, o[8 * i + 7] * il);
            *(u32x4*)(ycat + row * 1024 + 512 + h * 64 + 8 * i) = w; }
    }
}
__device__ __forceinline__ void phase_swa_naive(const Args& a, int l, int G) {
    const int tid_ = tid_opaque(a.wv), lane = tid_ & 63, wave = tid_ >> 6;
    const bf16_t* proj = (const bf16_t*)(a.ws + WS_PROJ); bf16_t* ycat = (bf16_t*)(a.ws + WS_YCAT);
    for (int blk = blockIdx.x; blk < 256; blk += G) {
        const int bh = blk >> 3, b = bh >> 2, h = bh & 3, c = (blk & 7) * 8 + wave, hk = h >> 1;
        const int t = c * 64 + lane; const size_t row = (size_t)b * SEQ + t;
        u32x4 qw[8];
#pragma unroll
        for (int i = 0; i < 8; ++i) qw[i] = *(const u32x4*)(proj + row * NPROJ + PC_SQ + h * 64 + 8 * i);
        float o[64];
#pragma unroll
        for (int i = 0; i < 64; ++i) o[i] = 0.f;
        float mx = a.sinks[l * 4 + h] * LOG2E, ls = 1.f;
        const int j0 = (c * 64 - 127) > 0 ? (c * 64 - 127) : 0, jend = c * 64 + 63;
        for (int j = j0; j <= jend; ++j) {
            const size_t rj = (size_t)b * SEQ + j;
            const bf16_t* kp = proj + rj * NPROJ + PC_SK + hk * 64; const bf16_t* vp = proj + rj * NPROJ + PC_SV + hk * 64;
            float sc = 0.f;
#pragma unroll
            for (int i = 0; i < 8; ++i) { const u32x4 w = *(const u32x4*)(kp + 8 * i); const u32x4 qq = qw[i];
                sc += bflo(qq.x) * bflo(w.x) + bfhi(qq.x) * bfhi(w.x) + bflo(qq.y) * bflo(w.y) + bfhi(qq.y) * bfhi(w.y) + bflo(qq.z) * bflo(w.z) + bfhi(qq.z) * bfhi(w.z) + bflo(qq.w) * bflo(w.w) + bfhi(qq.w) * bfhi(w.w); }
            sc *= SWA_QSCALE;
            if (j <= t && t - j < 128) {
                const float mn = fmaxf(mx, sc), f = exp2f(mx - mn), p = exp2f(sc - mn);
                ls = ls * f + p; mx = mn;
#pragma unroll
                for (int i = 0; i < 8; ++i) { const u32x4 w = *(const u32x4*)(vp + 8 * i);
                    o[8 * i] = o[8 * i] * f + p * bflo(w.x); o[8 * i + 1] = o[8 * i + 1] * f + p * bfhi(w.x); o[8 * i + 2] = o[8 * i + 2] * f + p * bflo(w.y); o[8 * i + 3] = o[8 * i + 3] * f + p * bfhi(w.y);
                    o[8 * i + 4] = o[8 * i + 4] * f + p * bflo(w.z); o[8 * i + 5] = o[8 * i + 5] * f + p * bfhi(w.z); o[8 * i + 6] = o[8 * i + 6] * f + p * bflo(w.w); o[8 * i + 7] = o[8 * i + 7] * f + p * bfhi(w.w); }
            }
        }
        const float il = 1.f / ls;
#pragma unroll
        for (int i = 0; i < 8; ++i) { u32x4 w; w.x = cvt_pk_bf16(o[8 * i] * il, o[8 * i + 1] * il); w.y = cvt_pk_bf16(o[8 * i + 2] * il, o[8 * i + 3] * il); w.z = cvt_pk_bf16(o[8 * i + 4] * il, o[8 * i + 5] * il); w.w = cvt_pk_bf16(o[8 * i + 6] * il, o[8 * i + 7] * il);
            *(u32x4*)(ycat + row * 1024 + 768 + h * 64 + 8 * i) = w; }
    }
}


typedef float f32x16 __attribute__((ext_vector_type(16)));
typedef short s16x4 __attribute__((ext_vector_type(4)));
__device__ __forceinline__ s16x4 lds_tr16(LAS unsigned char* p) { return __builtin_bit_cast(s16x4, __builtin_amdgcn_ds_read_tr16_b64_v4i16((LAS s16x4*)p)); }
template <bool MLA>
__device__ __forceinline__ void attn_unit(const Args& a, int l, LAS unsigned char* lds, int b, int hd, int qb) {
    constexpr int KS = MLA ? 6 : 4, KROW = MLA ? 208 : 144, KBUF = 128 * KROW, VBUF = 16384, VOFF = 2 * KBUF;
    const int tid = tid_opaque(a.wv), lane = tid & 63, wave = __builtin_amdgcn_readfirstlane(tid >> 6), r = lane & 31, h = lane >> 5;
    const bf16_t* proj = (const bf16_t*)(a.ws + WS_PROJ);
    const bf16_t* Kp; const bf16_t* Vp; int ldk;
    if (MLA) { Kp = (const bf16_t*)(a.ws + WS_KV) + (size_t)b * SEQ * 512 + hd * 128; Vp = Kp + 64; ldk = 512; }
    else { Kp = proj + (size_t)b * SEQ * NPROJ + PC_SK + (hd >> 1) * 64; Vp = proj + (size_t)b * SEQ * NPROJ + PC_SV + (hd >> 1) * 64; ldk = NPROJ; }
    const bf16_t* Krp = (const bf16_t*)(a.ws + WS_KR) + (size_t)b * SEQ * 32;
    const int q0 = qb * 256, Q0 = q0 + wave * 32, qpos = Q0 + r;
    const size_t qrow = (size_t)b * SEQ + qpos;
    bf16x8 qr[KS];
    {
        u32x4 qw[KS]; f32x4 rcs[2], rsn[2];
        const bf16_t* qp = MLA ? (const bf16_t*)(a.ws + WS_Q) + qrow * 384 + hd * 96 + 8 * h : proj + qrow * NPROJ + PC_SQ + hd * 64 + 8 * h;
#pragma unroll
        for (int ks = 0; ks < KS; ++ks) qw[ks] = *(const u32x4*)(qp + 16 * ks);
        if (MLA) {
#pragma unroll
            for (int k2 = 0; k2 < 2; ++k2) { const float* rp = (const float*)(a.ws + WS_ROPE) + qrow * 32 + 8 * k2 + 4 * h; rcs[k2] = *(const f32x4*)rp; rsn[k2] = *(const f32x4*)(rp + 16); }
        }
#pragma unroll
        for (int ks = 0; ks < KS; ++ks) { u32x4 w = qw[ks];
            if (MLA) { if (ks >= 4) { const f32x4 cs = rcs[ks - 4 < 0 ? 0 : ks - 4], sn = rsn[ks - 4 < 0 ? 0 : ks - 4];
                w.x = cvt_pk_bf16(bflo(w.x) * cs.x - bfhi(w.x) * sn.x, bflo(w.x) * sn.x + bfhi(w.x) * cs.x); w.y = cvt_pk_bf16(bflo(w.y) * cs.y - bfhi(w.y) * sn.y, bflo(w.y) * sn.y + bfhi(w.y) * cs.y);
                w.z = cvt_pk_bf16(bflo(w.z) * cs.z - bfhi(w.z) * sn.z, bflo(w.z) * sn.z + bfhi(w.z) * cs.z); w.w = cvt_pk_bf16(bflo(w.w) * cs.w - bfhi(w.w) * sn.w, bflo(w.w) * sn.w + bfhi(w.w) * cs.w); } }
            else {
                w.x = cvt_pk_bf16(bflo(w.x) * SWA_QSCALE, bfhi(w.x) * SWA_QSCALE); w.y = cvt_pk_bf16(bflo(w.y) * SWA_QSCALE, bfhi(w.y) * SWA_QSCALE);
                w.z = cvt_pk_bf16(bflo(w.z) * SWA_QSCALE, bfhi(w.z) * SWA_QSCALE); w.w = cvt_pk_bf16(bflo(w.w) * SWA_QSCALE, bfhi(w.w) * SWA_QSCALE); }
            qr[ks] = __builtin_bit_cast(bf16x8, w); }
    }
    const int T_lo = MLA ? 0 : (qb == 0 ? 0 : 2 * qb - 1), T_hi = 2 * qb + 1;
    const int skey = tid >> 3, sch = tid & 7, rkey = tid >> 2, rch = tid & 3;
    u32x4 kreg[2], vreg[2], k2reg[2];
    auto gload = [&](int T) {
#pragma unroll
        for (int sub = 0; sub < 2; ++sub) { const int t = 2 * T + sub;
            kreg[sub] = *(const u32x4*)(Kp + (size_t)(64 * t + skey) * ldk + 8 * sch);
            vreg[sub] = *(const u32x4*)(Vp + (size_t)(64 * t + skey) * ldk + 8 * sch);
            if (MLA && tid < 256) k2reg[sub] = *(const u32x4*)(Krp + (size_t)(64 * t + rkey) * 32 + 8 * rch); }
    };
    auto lstore = [&](int buf) {
#pragma unroll
        for (int sub = 0; sub < 2; ++sub) {
            *(LAS u32x4*)(lds + buf * KBUF + (64 * sub + skey) * KROW + 16 * sch) = kreg[sub];
            *(LAS u32x4*)(lds + VOFF + buf * VBUF + sub * 8192 + (sch >> 2) * 4096 + skey * 64 + (sch & 3) * 16) = vreg[sub];
            if (MLA && tid < 256) *(LAS u32x4*)(lds + buf * KBUF + (64 * sub + rkey) * KROW + 128 + 16 * rch) = k2reg[sub]; }
    };
    f32x16 o0, o1;
#pragma unroll
    for (int i = 0; i < 16; ++i) { o0[i] = 0.f; o1[i] = 0.f; }
    float mx = MLA ? 0.f : a.sinks[l * 4 + hd] * LOG2E, ls = (MLA || h == 1) ? 0.f : 1.f;
    f32x16 negm;
#pragma unroll
    for (int i = 0; i < 16; ++i) negm[i] = -mx;
    gload(T_lo); lstore(0);
    __syncthreads();
    const int trb = (4 * h + ((lane & 15) >> 2)) * 64 + ((lane >> 4) & 1) * 32 + (lane & 3) * 8;
    for (int T = T_lo; T <= T_hi; ++T) {
        const int buf = (T - T_lo) & 1;
        if (T < T_hi) gload(T + 1);
#pragma unroll
        for (int sub = 0; sub < 2; ++sub) {
        const int t = 2 * T + sub;
        const bool active = (64 * t <= Q0 + 31) && (MLA || 64 * t + 63 >= Q0 - 127);
        if (active) {
            LAS unsigned char* Kb = lds + buf * KBUF + (64 * sub + r) * KROW + 16 * h;
            f32x16 p0 = negm, p1 = negm;
#pragma unroll
            for (int ks = 0; ks < KS; ++ks) {
                const bf16x8 k0 = *(const LAS bf16x8*)(Kb + 32 * ks), k1 = *(const LAS bf16x8*)(Kb + 32 * KROW + 32 * ks);
                p0 = __builtin_amdgcn_mfma_f32_32x32x16_bf16(k0, qr[ks], p0, 0, 0, 0);
                p1 = __builtin_amdgcn_mfma_f32_32x32x16_bf16(k1, qr[ks], p1, 0, 0, 0);
            }
            const bool need_mask = (64 * t + 63 > Q0) || (!MLA && 64 * t < Q0 + 31 - 127);
            if (need_mask) {
#pragma unroll
                for (int i = 0; i < 16; ++i) { const int kp = 64 * t + (i & 3) + 8 * (i >> 2) + 4 * h;
                    if (kp > qpos || (!MLA && qpos - kp >= 128)) p0[i] = -1e30f;
                    if (kp + 32 > qpos || (!MLA && qpos - kp - 32 >= 128)) p1[i] = -1e30f; } }
            float mt = fmaxf(p0[0], p1[0]);
#pragma unroll
            for (int i = 1; i < 16; ++i) mt = fmaxf(mt, fmaxf(p0[i], p1[i]));
            mt = fmaxf(mt, shx(mt, 32, lane));
            const bool first = MLA && (t == 0);
            if (first || __builtin_amdgcn_ballot_w64(mt > 0.f) != 0ull) {
                const float dl = first ? mt : fmaxf(mt, 0.f), f = first ? 1.f : __builtin_amdgcn_exp2f(-dl);
                mx += dl; ls *= f;
#pragma unroll
                for (int i = 0; i < 16; ++i) { p0[i] -= dl; p1[i] -= dl; o0[i] *= f; o1[i] *= f; negm[i] = -mx; }
            }
            float sum = 0.f;
#pragma unroll
            for (int i = 0; i < 16; ++i) { p0[i] = __builtin_amdgcn_exp2f(p0[i]); p1[i] = __builtin_amdgcn_exp2f(p1[i]); sum += p0[i] + p1[i]; }
            ls += sum;
            bf16x8 pw[2][2];
#pragma unroll
            for (int s2 = 0; s2 < 2; ++s2) {
                u32x4 w0, w1;
                w0.x = cvt_pk_bf16(p0[8 * s2], p0[8 * s2 + 1]); w0.y = cvt_pk_bf16(p0[8 * s2 + 2], p0[8 * s2 + 3]); w0.z = cvt_pk_bf16(p0[8 * s2 + 4], p0[8 * s2 + 5]); w0.w = cvt_pk_bf16(p0[8 * s2 + 6], p0[8 * s2 + 7]);
                w1.x = cvt_pk_bf16(p1[8 * s2], p1[8 * s2 + 1]); w1.y = cvt_pk_bf16(p1[8 * s2 + 2], p1[8 * s2 + 3]); w1.z = cvt_pk_bf16(p1[8 * s2 + 4], p1[8 * s2 + 5]); w1.w = cvt_pk_bf16(p1[8 * s2 + 6], p1[8 * s2 + 7]);
                pw[0][s2] = __builtin_bit_cast(bf16x8, w0); pw[1][s2] = __builtin_bit_cast(bf16x8, w1);
            }
            LAS unsigned char* Vb = lds + VOFF + buf * VBUF + sub * 8192 + trb;
#pragma unroll
            for (int kb = 0; kb < 2; ++kb)
#pragma unroll
                for (int s2 = 0; s2 < 2; ++s2) {
                    const int ko = (32 * kb + 16 * s2) * 64;
                    const s16x4 a0l = lds_tr16(Vb + ko), a0h = lds_tr16(Vb + ko + 512), a1l = lds_tr16(Vb + 4096 + ko), a1h = lds_tr16(Vb + 4096 + ko + 512);
                    const bf16x8 A0 = {a0l[0], a0l[1], a0l[2], a0l[3], a0h[0], a0h[1], a0h[2], a0h[3]}, A1 = {a1l[0], a1l[1], a1l[2], a1l[3], a1h[0], a1h[1], a1h[2], a1h[3]};
                    o0 = __builtin_amdgcn_mfma_f32_32x32x16_bf16(A0, pw[kb][s2], o0, 0, 0, 0);
                    o1 = __builtin_amdgcn_mfma_f32_32x32x16_bf16(A1, pw[kb][s2], o1, 0, 0, 0);
                }
        }
        }
        if (T < T_hi) lstore(buf ^ 1);
        __syncthreads();
    }
    ls += shx(ls, 32, lane);
    const float il = 1.f / ls;
    bf16_t* op = (bf16_t*)(a.ws + WS_YCAT) + qrow * 1024 + (MLA ? 512 : 768) + hd * 64 + 4 * h;
#pragma unroll
    for (int g4 = 0; g4 < 4; ++g4) {
        u32x2 w; w.x = cvt_pk_bf16(o0[4 * g4] * il, o0[4 * g4 + 1] * il); w.y = cvt_pk_bf16(o0[4 * g4 + 2] * il, o0[4 * g4 + 3] * il); *(u32x2*)(op + 8 * g4) = w;
        w.x = cvt_pk_bf16(o1[4 * g4] * il, o1[4 * g4 + 1] * il); w.y = cvt_pk_bf16(o1[4 * g4 + 2] * il, o1[4 * g4 + 3] * il); *(u32x2*)(op + 32 + 8 * g4) = w;
    }
}
__device__ __forceinline__ int xcd_vid(int blk, int G) { return (G % 8 == 0) ? (blk % 8) * (G / 8) + blk / 8 : blk; }
__device__ __forceinline__ void phase_mla(const Args& a, int l, LAS unsigned char* lds, int G) {
    for (int v0 = blockIdx.x; v0 < 256; v0 += G) { const int v = (G == 256) ? xcd_vid(v0, G) : v0; const int bh = v >> 3, s = v & 7;
        attn_unit<true>(a, l, lds, bh >> 2, bh & 3, s); attn_unit<true>(a, l, lds, bh >> 2, bh & 3, 15 - s); }
}
__device__ __forceinline__ void phase_swa(const Args& a, int l, LAS unsigned char* lds, int G) {
    for (int v0 = blockIdx.x; v0 < 512; v0 += G) { const int v = (G == 256) ? 2 * xcd_vid(v0 & 255, G) + (v0 >> 8) : v0; const int bh = v >> 4; attn_unit<false>(a, l, lds, bh >> 2, bh & 3, v & 15); }
}
__device__ __forceinline__ int crow16(int i, int h2) { return (i & 3) + 8 * (i >> 2) + 4 * h2; }
__device__ __forceinline__ void ssd_tables(const Args& a, int l, LAS float* dts, LAS float* acs, size_t row0, int g, int tid) {
    const int hg = tid >> 7, s = tid & 127, h = 4 * g + hg;
    const float av = -__expf(a.a_log[l * 8 + h]);
    const float dt = ((const float*)(a.ws + WS_DTSP))[(row0 + s) * 8 + h];
    dts[hg * 128 + s] = dt;
    const int lane = tid & 63;
    float v = dt * av;
#pragma unroll
    for (int d = 1; d < 64; d <<= 1) { const float o = __builtin_bit_cast(float, __builtin_amdgcn_ds_bpermute(((lane - d) & 63) << 2, __builtin_bit_cast(int, v))); v += (lane >= d) ? o : 0.f; }
    if ((tid & 127) == 63) acs[hg * 128] = v;
    __syncthreads();
    const float add = (tid & 64) ? acs[hg * 128] : 0.f;
    __syncthreads();
    acs[hg * 128 + s] = v + add;
    __syncthreads();
}
template <bool SCALED>
__device__ __forceinline__ void ssd_stage_x(const bf16_t* xbc, size_t row0, int g, LAS unsigned char* Xi, const LAS float* dts, const LAS float* acs, int tid) {
    u32x4 vv[8];
#pragma unroll
    for (int i = 0; i < 8; ++i) { const int ch = tid + 512 * i, hg = ch >> 10, s = (ch >> 3) & 127, c8 = ch & 7;
        vv[i] = *(const u32x4*)(xbc + (row0 + s) * 1024 + (4 * g + hg) * 64 + 8 * c8); }
#pragma unroll
    for (int i = 0; i < 8; ++i) { const int ch = tid + 512 * i, hg = ch >> 10, s = (ch >> 3) & 127, c8 = ch & 7;
        u32x4 v = vv[i];
        if (SCALED) { const float w = dts[hg * 128 + s] * __expf(acs[hg * 128 + 127] - acs[hg * 128 + s]);
            v.x = cvt_pk_bf16(bflo(v.x) * w, bfhi(v.x) * w); v.y = cvt_pk_bf16(bflo(v.y) * w, bfhi(v.y) * w); v.z = cvt_pk_bf16(bflo(v.z) * w, bfhi(v.z) * w); v.w = cvt_pk_bf16(bflo(v.w) * w, bfhi(v.w) * w); }
        *(LAS u32x4*)(Xi + hg * 16384 + (c8 >> 2) * 8192 + s * 64 + (c8 & 3) * 16) = v; }
}
__device__ __forceinline__ bf16x8 tr_frag(LAS unsigned char* p, int hi_off) {
    const s16x4 lo = lds_tr16(p), hi = lds_tr16(p + hi_off);
    return (bf16x8){lo[0], lo[1], lo[2], lo[3], hi[0], hi[1], hi[2], hi[3]};
}
__device__ __forceinline__ void phase_ssd_states_mfma(const Args& a, int l, LAS unsigned char* lds, int G) {
    const int tid = tid_opaque(a.wv), lane = tid & 63, wave = __builtin_amdgcn_readfirstlane(tid >> 6), r = lane & 31, h2 = lane >> 5;
    const bf16_t* xbc = (const bf16_t*)(a.ws + WS_H);
    bf16_t* states = (bf16_t*)(a.ws + WS_YS); float* cdec = (float*)(a.ws + WS_CDEC);
    LAS unsigned char* Bi = lds; LAS unsigned char* Xi = lds + 32768; LAS float* dts = (LAS float*)(lds + 98304); LAS float* acs = dts + 512;
    const int trb2 = (8 * h2 + ((lane & 15) >> 2)) * 64 + ((lane >> 4) & 1) * 32 + (lane & 3) * 8;
    for (int u = blockIdx.x; u < 512; u += G) {
        const int b = u >> 6, c = (u >> 1) & 31, g = u & 1; const size_t row0 = (size_t)b * SEQ + c * 128;
        ssd_tables(a, l, dts, acs, row0, g, tid);
#pragma unroll
        for (int i = 0; i < 4; ++i) { const int ch = tid + 512 * i, s = ch >> 4, c16 = ch & 15;
            *(LAS u32x4*)(Bi + (c16 >> 2) * 8192 + s * 64 + (c16 & 3) * 16) = *(const u32x4*)(xbc + (row0 + s) * 1024 + 512 + g * 128 + 8 * c16); }
        ssd_stage_x<true>(xbc, row0, g, Xi, dts, acs, tid);
        __syncthreads();
        const int hg = wave >> 1, nbh = wave & 1;
        f32x16 d00, d01, d10, d11;
#pragma unroll
        for (int i = 0; i < 16; ++i) { d00[i] = 0.f; d01[i] = 0.f; d10[i] = 0.f; d11[i] = 0.f; }
        LAS unsigned char* xa = Xi + hg * 16384 + trb2; LAS unsigned char* ba = Bi + (2 * nbh) * 8192 + trb2;
#pragma unroll
        for (int ks = 0; ks < 8; ++ks) {
            const bf16x8 A0 = tr_frag(xa + ks * 1024, 256), A1 = tr_frag(xa + 8192 + ks * 1024, 256), B0 = tr_frag(ba + ks * 1024, 256), B1 = tr_frag(ba + 8192 + ks * 1024, 256);
            d00 = __builtin_amdgcn_mfma_f32_32x32x16_bf16(B0, A0, d00, 0, 0, 0); d01 = __builtin_amdgcn_mfma_f32_32x32x16_bf16(B0, A1, d01, 0, 0, 0);
            d10 = __builtin_amdgcn_mfma_f32_32x32x16_bf16(B1, A0, d10, 0, 0, 0); d11 = __builtin_amdgcn_mfma_f32_32x32x16_bf16(B1, A1, d11, 0, 0, 0);
        }
        asm volatile("s_nop 15\n\ts_nop 7" : "+v"(d00), "+v"(d01), "+v"(d10), "+v"(d11));
        bf16_t* sp = states + (size_t)((b * 32 + c) * 8 + 4 * g + hg) * 8192 + (size_t)r * 128 + 64 * nbh + 4 * h2;
#pragma unroll
        for (int g4 = 0; g4 < 4; ++g4) { u32x2 w;
            w.x = cvt_pk_bf16(d00[4 * g4], d00[4 * g4 + 1]); w.y = cvt_pk_bf16(d00[4 * g4 + 2], d00[4 * g4 + 3]); *(u32x2*)(sp + 8 * g4) = w;
            w.x = cvt_pk_bf16(d01[4 * g4], d01[4 * g4 + 1]); w.y = cvt_pk_bf16(d01[4 * g4 + 2], d01[4 * g4 + 3]); *(u32x2*)(sp + 32 * 128 + 8 * g4) = w;
            w.x = cvt_pk_bf16(d10[4 * g4], d10[4 * g4 + 1]); w.y = cvt_pk_bf16(d10[4 * g4 + 2], d10[4 * g4 + 3]); *(u32x2*)(sp + 32 + 8 * g4) = w;
            w.x = cvt_pk_bf16(d11[4 * g4], d11[4 * g4 + 1]); w.y = cvt_pk_bf16(d11[4 * g4 + 2], d11[4 * g4 + 3]); *(u32x2*)(sp + 32 * 128 + 32 + 8 * g4) = w; }
        if (tid < 4) cdec[(b * 32 + c) * 8 + 4 * g + tid] = __expf(acs[tid * 128 + 127]);
        __syncthreads();
    }
}
__device__ __forceinline__ void phase_ssd_out_mfma(const Args& a, int l, LAS unsigned char* lds, int G) {
    constexpr int RW = 272;
    const int tid = tid_opaque(a.wv), lane = tid & 63, wave = __builtin_amdgcn_readfirstlane(tid >> 6), r = lane & 31, h2 = lane >> 5;
    const bf16_t* xbc = (const bf16_t*)(a.ws + WS_H); const bf16_t* proj = (const bf16_t*)(a.ws + WS_PROJ);
    const bf16_t* states = (const bf16_t*)(a.ws + WS_YS); bf16_t* ycat = (bf16_t*)(a.ws + WS_YCAT);
    LAS unsigned char* Cr = lds; LAS unsigned char* Br = lds + 34816; LAS unsigned char* Xi = lds + 69632;
    LAS float* dts = (LAS float*)(lds + 135168); LAS float* acs = dts + 512; LAS float* sq = dts + 1024;
    const int trb = (4 * h2 + ((lane & 15) >> 2)) * 64 + ((lane >> 4) & 1) * 32 + (lane & 3) * 8;
    for (int u = blockIdx.x; u < 512; u += G) {
        const int b = u >> 6, c = (u >> 1) & 31, g = u & 1; const size_t row0 = (size_t)b * SEQ + c * 128;
        const int hg = wave >> 1, lh = wave & 1, h = 4 * g + hg;
        const float dsk = a.ssd_d[l * 8 + h];
        bf16x8 hf[2][8];
        { const bf16_t* hp = states + (size_t)((b * 32 + c) * 8 + h) * 8192 + (size_t)r * 128 + 8 * h2;
#pragma unroll
          for (int pb = 0; pb < 2; ++pb)
#pragma unroll
              for (int ks = 0; ks < 8; ++ks) hf[pb][ks] = *(const bf16x8*)(hp + pb * 4096 + 16 * ks); }
        ssd_tables(a, l, dts, acs, row0, g, tid);
#pragma unroll
        for (int i = 0; i < 4; ++i) { const int ch = tid + 512 * i, s = ch >> 4, c16 = ch & 15; const bf16_t* src = xbc + (row0 + s) * 1024 + 512 + g * 128 + 8 * c16;
            *(LAS u32x4*)(Br + s * RW + 16 * c16) = *(const u32x4*)src; *(LAS u32x4*)(Cr + s * RW + 16 * c16) = *(const u32x4*)(src + 256); }
        ssd_stage_x<false>(xbc, row0, g, Xi, dts, acs, tid);
        __syncthreads();
        f32x16 yv[2][2];
#pragma unroll
        for (int lb = 0; lb < 2; ++lb) {
            const int Lb = lb == 0 ? lh : 3 - lh, L0 = 32 * Lb, lq = L0 + r;
            bf16x8 cf[8];
#pragma unroll
            for (int ks = 0; ks < 8; ++ks) cf[ks] = *(const LAS bf16x8*)(Cr + lq * RW + 32 * ks + 16 * h2);
            f32x16 o0, o1;
#pragma unroll
            for (int i = 0; i < 16; ++i) { o0[i] = 0.f; o1[i] = 0.f; }
#pragma unroll
            for (int ks = 0; ks < 8; ++ks) {
                o0 = __builtin_amdgcn_mfma_f32_32x32x16_bf16(hf[0][ks], cf[ks], o0, 0, 0, 0);
                o1 = __builtin_amdgcn_mfma_f32_32x32x16_bf16(hf[1][ks], cf[ks], o1, 0, 0, 0);
            }
            const float Al = acs[hg * 128 + lq], eAl = __expf(Al);
#pragma unroll
            for (int i = 0; i < 16; ++i) { o0[i] *= eAl; o1[i] *= eAl; }
            for (int sb = 0; sb <= Lb; ++sb) {
                f32x16 X;
#pragma unroll
                for (int i = 0; i < 16; ++i) X[i] = 0.f;
#pragma unroll
                for (int ks = 0; ks < 8; ++ks) X = __builtin_amdgcn_mfma_f32_32x32x16_bf16(*(const LAS bf16x8*)(Br + (32 * sb + r) * RW + 32 * ks + 16 * h2), cf[ks], X, 0, 0, 0);
#pragma unroll
                for (int i = 0; i < 16; ++i) { const int s = 32 * sb + crow16(i, h2); X[i] = (s <= lq) ? X[i] * __expf(Al - acs[hg * 128 + s]) * dts[hg * 128 + s] : 0.f; }
                u32x4 w0, w1;
                w0.x = cvt_pk_bf16(X[0], X[1]); w0.y = cvt_pk_bf16(X[2], X[3]); w0.z = cvt_pk_bf16(X[4], X[5]); w0.w = cvt_pk_bf16(X[6], X[7]);
                w1.x = cvt_pk_bf16(X[8], X[9]); w1.y = cvt_pk_bf16(X[10], X[11]); w1.z = cvt_pk_bf16(X[12], X[13]); w1.w = cvt_pk_bf16(X[14], X[15]);
                LAS unsigned char* xa = Xi + hg * 16384 + trb + (32 * sb) * 64;
                o0 = __builtin_amdgcn_mfma_f32_32x32x16_bf16(tr_frag(xa, 512), __builtin_bit_cast(bf16x8, w0), o0, 0, 0, 0);
                o1 = __builtin_amdgcn_mfma_f32_32x32x16_bf16(tr_frag(xa + 8192, 512), __builtin_bit_cast(bf16x8, w0), o1, 0, 0, 0);
                o0 = __builtin_amdgcn_mfma_f32_32x32x16_bf16(tr_frag(xa + 1024, 512), __builtin_bit_cast(bf16x8, w1), o0, 0, 0, 0);
                o1 = __builtin_amdgcn_mfma_f32_32x32x16_bf16(tr_frag(xa + 8192 + 1024, 512), __builtin_bit_cast(bf16x8, w1), o1, 0, 0, 0);
            }
            float ssq = 0.f;
            const bf16_t* zp = proj + (row0 + lq) * NPROJ + PC_Z + h * 64 + 4 * h2;
#pragma unroll
            for (int g4 = 0; g4 < 4; ++g4) {
                const u32x2 x0 = *(const LAS u32x2*)(Xi + hg * 16384 + lq * 64 + (8 * g4 + 4 * h2) * 2), x1 = *(const LAS u32x2*)(Xi + hg * 16384 + 8192 + lq * 64 + (8 * g4 + 4 * h2) * 2);
                const u32x2 z0 = *(const u32x2*)(zp + 8 * g4), z1 = *(const u32x2*)(zp + 32 + 8 * g4);
                float v;
                v = (o0[4 * g4] + dsk * bflo(x0.x)) * silu_f(bflo(z0.x)); o0[4 * g4] = v; ssq += v * v;
                v = (o0[4 * g4 + 1] + dsk * bfhi(x0.x)) * silu_f(bfhi(z0.x)); o0[4 * g4 + 1] = v; ssq += v * v;
                v = (o0[4 * g4 + 2] + dsk * bflo(x0.y)) * silu_f(bflo(z0.y)); o0[4 * g4 + 2] = v; ssq += v * v;
                v = (o0[4 * g4 + 3] + dsk * bfhi(x0.y)) * silu_f(bfhi(z0.y)); o0[4 * g4 + 3] = v; ssq += v * v;
                v = (o1[4 * g4] + dsk * bflo(x1.x)) * silu_f(bflo(z1.x)); o1[4 * g4] = v; ssq += v * v;
                v = (o1[4 * g4 + 1] + dsk * bfhi(x1.x)) * silu_f(bfhi(z1.x)); o1[4 * g4 + 1] = v; ssq += v * v;
                v = (o1[4 * g4 + 2] + dsk * bflo(x1.y)) * silu_f(bflo(z1.y)); o1[4 * g4 + 2] = v; ssq += v * v;
                v = (o1[4 * g4 + 3] + dsk * bfhi(x1.y)) * silu_f(bfhi(z1.y)); o1[4 * g4 + 3] = v; ssq += v * v;
            }
            ssq += shx(ssq, 32, lane);
            if (h2 == 0) sq[lq * 4 + hg] = ssq;
            yv[lb][0] = o0; yv[lb][1] = o1;
        }
        f32x4 ngv[4][2];
        { const float* ngp = a.ssd_ng + l * 512 + g * 256 + hg * 64 + 4 * h2;
#pragma unroll
          for (int g4 = 0; g4 < 4; ++g4)
#pragma unroll
              for (int pb = 0; pb < 2; ++pb) ngv[g4][pb] = *(const f32x4*)(ngp + 32 * pb + 8 * g4); }
        __syncthreads();
#pragma unroll
        for (int lb = 0; lb < 2; ++lb) {
            const int Lb = lb == 0 ? lh : 3 - lh, lq = 32 * Lb + r;
            const f32x4 t4 = *(const LAS f32x4*)(sq + lq * 4);
            const float rinv = __builtin_amdgcn_rsqf(((t4.x + t4.y) + (t4.z + t4.w)) * (1.f / 256.f) + EPS);
            bf16_t* op = ycat + (row0 + lq) * 1024 + g * 256 + hg * 64 + 4 * h2;
#pragma unroll
            for (int g4 = 0; g4 < 4; ++g4)
#pragma unroll
                for (int pb = 0; pb < 2; ++pb) { const f32x4 gg = ngv[g4][pb];
                    u32x2 w; w.x = cvt_pk_bf16(yv[lb][pb][4 * g4] * rinv * gg.x, yv[lb][pb][4 * g4 + 1] * rinv * gg.y); w.y = cvt_pk_bf16(yv[lb][pb][4 * g4 + 2] * rinv * gg.z, yv[lb][pb][4 * g4 + 3] * rinv * gg.w);
                    *(u32x2*)(op + 32 * pb + 8 * g4) = w; }
        }
        __syncthreads();
    }
}


#define XB_TMO      128
#define XB_XCNT(j)  (256  + 64 * (j))
#define XB_XSUB(j)  (1280 + 64 * (j))
#define XB_XGEN(j)  (2304 + 64 * (j))
#define XB_TOP      3328
#define XB_TOPGEN   3392
#define XCD_BAR_WORDS 3456
#define XB_SPIN_CAP (1u << 18)
__device__ __forceinline__ unsigned xb_ld(unsigned* p)              { return __hip_atomic_load(p, __ATOMIC_RELAXED, __HIP_MEMORY_SCOPE_AGENT); }
__device__ __forceinline__ unsigned xb_add(unsigned* p, unsigned v) { return __hip_atomic_fetch_add(p, v, __ATOMIC_RELAXED, __HIP_MEMORY_SCOPE_AGENT); }
__device__ __forceinline__ unsigned xb_xcc_id() { return (unsigned)__builtin_amdgcn_s_getreg((3 << 11) | 20) & 0xFu; }
#define XB_SPIN(cond, bar) do { unsigned _sp = 0; while (cond) { __builtin_amdgcn_s_sleep(1); \
    if ((++_sp & 255u) == 0u) { if (xb_ld(&(bar)[XB_TMO])) break; if (_sp > XB_SPIN_CAP) { atomicAdd(&(bar)[XB_TMO], 1u); break; } } } } while (0)
struct XcdBarrier { unsigned* bar; unsigned x; volatile LAS unsigned* st; };
__device__ __forceinline__ XcdBarrier xcd_barrier_post(unsigned* bar, volatile LAS unsigned* st) {
    XcdBarrier b; b.bar = bar; b.x = xb_xcc_id(); b.st = st;
    if (threadIdx.x == 0) (void)xb_add(&bar[XB_XCNT(b.x)], 1u);
    return b;
}
__device__ __forceinline__ void xcd_barrier_complete(unsigned* bar, unsigned x, unsigned& nloc, unsigned& nx) {
    const unsigned G = gridDim.x * gridDim.y * gridDim.z;
    unsigned sum, cnt, mine, sp = 0u;
    for (;;) {
        sum = 0u; cnt = 0u; mine = 0u;
#pragma unroll
        for (unsigned j = 0; j < 16; ++j) { const unsigned c = xb_ld(&bar[XB_XCNT(j)]); sum += c; cnt += (c > 0u) ? 1u : 0u; mine = (j == x) ? c : mine; }
        if (sum == G) break;
        __builtin_amdgcn_s_sleep(1);
        if ((++sp & 255u) == 0u) { if (xb_ld(&bar[XB_TMO])) break; if (sp > XB_SPIN_CAP) { atomicAdd(&bar[XB_TMO], 1u); break; } }
    }
    nloc = mine > 0u ? mine : 1u; nx = cnt > 0u ? cnt : 1u;
}
__device__ __forceinline__ void xcd_barrier(const XcdBarrier& b) {
    asm volatile("s_waitcnt vmcnt(0)" ::: "memory");
    __syncthreads();
    if (threadIdx.x == 0) {
        unsigned* bar = b.bar;
        __builtin_amdgcn_s_waitcnt(0);
        unsigned nloc = b.st[0], nx = b.st[1];
        if (nloc == 0u) { xcd_barrier_complete(bar, b.x, nloc, nx); b.st[0] = nloc; b.st[1] = nx; }
        const unsigned old = xb_add(&bar[XB_XSUB(b.x)], 1u);
        const unsigned gen = old / nloc;
        if (old + 1u == (gen + 1u) * nloc) {
            __builtin_amdgcn_fence(__ATOMIC_RELEASE, "agent");
            asm volatile("s_waitcnt vmcnt(0)" ::: "memory");
            const unsigned og = xb_add(&bar[XB_TOP], 1u);
            const unsigned tg = og / nx;
            if (og + 1u == (tg + 1u) * nx) xb_add(&bar[XB_TOPGEN], 1u);
            else XB_SPIN(xb_ld(&bar[XB_TOPGEN]) == tg, bar);
            __builtin_amdgcn_fence(__ATOMIC_ACQUIRE, "agent");
            xb_add(&bar[XB_XGEN(b.x)], 1u);
            asm volatile("s_waitcnt vmcnt(0)" ::: "memory");
        } else {
            XB_SPIN(xb_ld(&bar[XB_XGEN(b.x)]) == gen, bar);
            __builtin_amdgcn_fence(__ATOMIC_ACQUIRE, "agent");
            asm volatile("s_waitcnt vmcnt(0)" ::: "memory");
        }
    }
    __syncthreads();
}

constexpr int PH_PER_LAYER = 8, N_PHASES = 2 + DEPTH * PH_PER_LAYER + 1;
__global__ void __launch_bounds__(512, 2) fwd_kernel(Args a0) {
    extern __shared__ __attribute__((aligned(16))) unsigned char lds_raw[];
    LAS unsigned char* lds = (LAS unsigned char*)lds_raw;
    const int G = gridDim.x;
    const int wave_s = __builtin_amdgcn_readfirstlane((int)threadIdx.x >> 6);
#if MK_PER_PHASE
#define SEAM() do {} while (0)
#else
    cg::grid_group grid = cg::this_grid();
    volatile LAS unsigned* bst = (volatile LAS unsigned*)(lds + LDS_BYTES - 64);
    if (threadIdx.x < 2) bst[threadIdx.x] = 0u;
    __syncthreads();
    const XcdBarrier xbar = xcd_barrier_post((unsigned*)a0.ws, bst);
#define SEAM() do { if (ph + 1 < a.ph_hi) { if (ph == 0) grid.sync(); else xcd_barrier(xbar); if (PROBE_MASK & 256) xcd_barrier(xbar); } } while (0)
#endif
    for (int ph = a0.ph_lo; ph < a0.ph_hi; ++ph) {
        unsigned long long wsi_ = (unsigned long long)a0.ws, oi_ = (unsigned long long)a0.out; asm volatile("" : "+s"(wsi_), "+s"(oi_));
        unsigned char* ws = (unsigned char*)(__attribute__((address_space(1))) unsigned char*)wsi_;
        Args a = a0; a.ws = ws; a.wv = wave_s;
        a.out = (float*)(__attribute__((address_space(1))) float*)oi_;
        const float* mod = (const float*)(ws + WS_MOD);
        bf16_t* hbuf = (bf16_t*)(ws + WS_H);
        unsigned long long* rowsq1 = (unsigned long long*)(ws + WS_RSQ); unsigned long long* rowsq2 = rowsq1 + M;
        if (ph == 0) { RUN(16, phase_mod(a, lds, G)); phase_rope(a, G); __syncthreads(); phase_weights(a, 0, ws + WS_W, lds, G); SEAM(); continue; }
        if (ph == 1) { phase_norm0(a.x, a.n1g, mod + 1024, hbuf, rowsq1, G, a.wv); phase_bias(a, 0, (float*)(ws + WS_BIAS), lds, G); SEAM(); continue; }
        if (ph == N_PHASES - 1) { phase_final(a.out, a.fng, G, a.wv); continue; }
        const int l = (ph - 2) / PH_PER_LAYER, sp = (ph - 2) % PH_PER_LAYER;
        const float* ml = mod + (size_t)l * 8 * 6144;
        const float* xcur = (l == 0) ? a.x : a.out;
        const unsigned char* Wb = ws + ((l & 1) ? WS_W2 : WS_W);
        const float* biasb = (const float*)(ws + WS_BIAS + (size_t)(l & 1) * 262144);
        if (sp == 0) {
            pg8::Gemm g{hbuf, (const bf16_t*)(Wb + WO_IN), D, D, a.wv}; pg8::Order S; S.init(M / 256, NPROJ / 256, G, (int)blockIdx.x, 0);
            pg8::EpiProj E{(bf16_t*)(ws + WS_PROJ), (float*)(ws + WS_DTRAW), rowsq1, biasb};
            RUN(32, pg8::gemm_phase(lds, g, S, E));
        } else if (sp == 1) {
            RUN(8, phase_prep(a, l, G));
        } else if (sp == 2) {
            { pg8::Gemm g{(const bf16_t*)(ws + WS_PROJ) + PC_CQ, (const bf16_t*)(Wb + WO_UQ), 256, NPROJ, a.wv}; pg8::Order S; S.init(M / 256, 2, G, (int)blockIdx.x, 0);
              pg8::EpiMla E{(bf16_t*)(ws + WS_Q), (bf16_t*)(ws + WS_KV), (const float*)(ws + WS_RS), 1};
              pg8::gemm_phase(lds, g, S, E); }
            { pg8::Gemm g{(const bf16_t*)(ws + WS_PROJ) + PC_CKV, (const bf16_t*)(Wb + WO_UKV), 128, NPROJ, a.wv}; pg8::Order S; S.init(M / 256, 2, G, (int)blockIdx.x, 0);
              pg8::EpiMla E{(bf16_t*)(ws + WS_Q), (bf16_t*)(ws + WS_KV), (const float*)(ws + WS_RS), 0};
              pg8::gemm_phase(lds, g, S, E); }
            RUN(4, phase_ssd_states_mfma(a, l, lds, G));
            RUN(2, phase_swa(a, l, lds, G));
        } else if (sp == 3) {
            phase_ssd_scan(a, G);
            RUN(2, phase_mla(a, l, lds, G));
            if (l + 1 < DEPTH) { __syncthreads(); RUN(1024, phase_weights(a, l + 1, ws + (((l + 1) & 1) ? WS_W2 : WS_W), lds, G)); RUN(512, phase_bias(a, l + 1, (float*)(ws + WS_BIAS + (size_t)((l + 1) & 1) * 262144), lds, G)); }
        } else if (sp == 4) {
            RUN(2048, phase_ssd_out_mfma(a, l, lds, G));
        } else if (sp == 5) {
            pg8::Gemm g{(const bf16_t*)(ws + WS_YCAT), (const bf16_t*)(Wb + WO_OUT), D, D, a.wv}; pg8::Order S; S.init(M / 256, D / 256, G, (int)blockIdx.x, 0);
            pg8::EpiRes E{xcur, a.out, ml + 2048, hbuf, a.n2g + l * D, ml + 4096, rowsq2};
            pg8::gemm_phase(lds, g, S, E);
        } else if (sp == 6) {
            pg8::Gemm g{hbuf, (const bf16_t*)(Wb + WO_UP), D, D, a.wv}; pg8::Order S; S.init(NB * 17, DFF / 128, G, (int)blockIdx.x, 1);
            pg8::EpiUp E{(bf16_t*)(ws + WS_PROJ), a.fconv_w + (size_t)l * 3 * 2 * DFF, a.fconv_b + (size_t)l * 2 * DFF, rowsq2, biasb + 8 * NPROJ};
            RUN(128, pg8::gemm_phase(lds, g, S, E));
        } else {
            pg8::Gemm g{(const bf16_t*)(ws + WS_PROJ), (const bf16_t*)(Wb + WO_DN), DFF, DFF, a.wv}; pg8::Order S; S.init(M / 256, D / 256, G, (int)blockIdx.x, 0);
            const bool nxt = l + 1 < DEPTH;
            pg8::EpiRes E{a.out, a.out, ml + 5120, nxt ? hbuf : nullptr, a.n1g + (nxt ? l + 1 : l) * D, ml + (nxt ? 8 * 6144 : 0) + 1024, rowsq1};
            pg8::gemm_phase(lds, g, S, E);
        }
        SEAM();
    }
}

extern "C" void kernel_launch(void* const* d_in, const int* in_sizes, int n_in, void* d_out, int out_size, void* d_ws, size_t ws_size, hipStream_t stream) {
    static int grid = 0;
    if (grid == 0) {
        if (n_in != 25 || ws_size < WS_END) { fprintf(stderr, "kernel_launch: unexpected n_in %d / ws %zu\n", n_in, ws_size); grid = -1; return; }
        int dev = 0, cus = 0, per_cu = 0;
        hipGetDevice(&dev); hipDeviceGetAttribute(&cus, hipDeviceAttributeMultiprocessorCount, dev);
        if (hipFuncSetAttribute((const void*)fwd_kernel, hipFuncAttributeMaxDynamicSharedMemorySize, LDS_BYTES) != hipSuccess) { fprintf(stderr, "hipFuncSetAttribute failed\n"); }
        hipOccupancyMaxActiveBlocksPerMultiprocessor(&per_cu, (const void*)fwd_kernel, 512, LDS_BYTES);
        (void)hipGetLastError();
        if (per_cu < 1) { fprintf(stderr, "occupancy query says %d blocks/CU\n", per_cu); per_cu = 1; }
        grid = cus;
    }
    if (grid < 0) return;
    if (hipMemsetAsync(d_ws, 0, 16384, stream) != hipSuccess) { fprintf(stderr, "kernel_launch: memset of the barrier words failed\n"); return; }
    Args a{};
    a.x = (const float*)d_in[0]; a.c = (const float*)d_in[1]; a.pos = (const int*)d_in[2];
    a.ada_w = (const float*)d_in[3]; a.ada_b = (const float*)d_in[4]; a.n1g = (const float*)d_in[5]; a.n2g = (const float*)d_in[6]; a.w_in = (const float*)d_in[7];
    a.sconv_w = (const float*)d_in[8]; a.sconv_b = (const float*)d_in[9]; a.dt_bias = (const float*)d_in[10]; a.a_log = (const float*)d_in[11]; a.ssd_d = (const float*)d_in[12]; a.ssd_ng = (const float*)d_in[13];
    a.qng = (const float*)d_in[14]; a.w_uq = (const float*)d_in[15]; a.kvng = (const float*)d_in[16]; a.w_ukv = (const float*)d_in[17]; a.sinks = (const float*)d_in[18]; a.w_out = (const float*)d_in[19];
    a.w_up = (const float*)d_in[20]; a.fconv_w = (const float*)d_in[21]; a.fconv_b = (const float*)d_in[22]; a.w_dn = (const float*)d_in[23]; a.fng = (const float*)d_in[24];
    a.out = (float*)d_out; a.ws = (unsigned char*)d_ws;
#if MK_PER_PHASE
    for (int ph = 0; ph < N_PHASES; ++ph) { a.ph_lo = ph; a.ph_hi = ph + 1; hipLaunchKernelGGL(fwd_kernel, dim3(grid), dim3(512), LDS_BYTES, stream, a); }
#else
    a.ph_lo = 0; a.ph_hi = N_PHASES;
    void* args[] = {&a};
    hipError_t e = hipLaunchCooperativeKernel((const void*)fwd_kernel, dim3(grid), dim3(512), args, LDS_BYTES, stream);
    if (e != hipSuccess) fprintf(stderr, "cooperative launch failed: %s (grid %d)\n", hipGetErrorString(e), grid);
#endif
}
```

```cpp
#include <hip/hip_runtime.h>
#include <hip/hip_cooperative_groups.h>
#include <cstdio>
#include <cstdint>
namespace cg = cooperative_groups;

#define LAS __attribute__((address_space(3)))
typedef unsigned short bf16_t;
typedef short bf16x8 __attribute__((ext_vector_type(8)));
typedef float f32x4 __attribute__((ext_vector_type(4)));
typedef float f32x2 __attribute__((ext_vector_type(2)));
typedef unsigned u32x4 __attribute__((ext_vector_type(4)));
typedef unsigned u32x2 __attribute__((ext_vector_type(2)));

#ifndef PROBE_MASK
#define PROBE_MASK 0
#endif
#define RUN(bit, call) do { call; if (PROBE_MASK & (bit)) { call; } } while (0)
#ifndef MK_PER_PHASE
#define MK_PER_PHASE 0
#endif

constexpr int D = 1024, NB = 8, SEQ = 4096, M = NB * SEQ, DEPTH = 4, DFF = 2816, DIN = 2472, NPROJ = 2560;
constexpr float EPS = 1e-6f;
constexpr int PC_Z = 0, PC_X = 512, PC_CQ = 1536, PC_CKV = 1792, PC_KR = 1920, PC_SQ = 1952, PC_SK = 2208, PC_SV = 2336, PC_DT = 2464;
constexpr float LOG2E = 1.4426950408889634f;
constexpr float RSQ_SCALE = 16777216.f;
constexpr float MLA_QSCALE = 0.10206207261596577f * LOG2E;
constexpr float SWA_QSCALE = 0.125f * LOG2E;

constexpr size_t MiB = 1u << 20;
constexpr size_t WS_MOD = 1 * MiB;
constexpr size_t WS_ROPE = 2 * MiB;
constexpr size_t WS_W = 6 * MiB;
constexpr size_t WO_IN = 0, WO_OUT = 5 * MiB, WO_UP = 7 * MiB, WO_DN = 18 * MiB, WO_UQ = 23 * MiB + 512 * 1024, WO_UKV = 23 * MiB + 768 * 1024;
constexpr size_t WS_H = 32 * MiB;
constexpr size_t WS_PROJ = 96 * MiB;
constexpr size_t WS_YCAT = 272 * MiB;
constexpr size_t WS_Q = 336 * MiB;
constexpr size_t WS_KV = 360 * MiB;
constexpr size_t WS_KR = 392 * MiB;
constexpr size_t WS_DTRAW = 394 * MiB;
constexpr size_t WS_DTSP = 395 * MiB;
constexpr size_t WS_RS = 396 * MiB;
constexpr size_t WS_YS = 400 * MiB;
constexpr size_t WS_RSQ = 396 * MiB + 256 * 1024;
constexpr size_t WS_BIAS = 397 * MiB;
constexpr size_t WS_W2 = 464 * MiB;
constexpr size_t WS_END = 490 * MiB;

constexpr int LDS_BYTES = 147456;
constexpr int LDS_EXTRA = 131072;

__device__ __forceinline__ unsigned f2bf(float f) { unsigned u = __builtin_bit_cast(unsigned, f); return (u + 0x7fffu + ((u >> 16) & 1u)) >> 16; }
__device__ __forceinline__ unsigned pk2(float lo, float hi) { return f2bf(lo) | (f2bf(hi) << 16); }
__device__ __forceinline__ float bflo(unsigned w) { return __builtin_bit_cast(float, w << 16); }
__device__ __forceinline__ float bfhi(unsigned w) { return __builtin_bit_cast(float, w & 0xffff0000u); }
__device__ __forceinline__ float bf2f(bf16_t h) { return __builtin_bit_cast(float, (unsigned)h << 16); }
__device__ __forceinline__ unsigned cvt_pk_bf16(float lo, float hi) { unsigned r; asm volatile("v_cvt_pk_bf16_f32 %0, %1, %2" : "=v"(r) : "v"(lo), "v"(hi)); return r; }
__device__ __forceinline__ float shx(float v, int o, int lane) { return __builtin_bit_cast(float, __builtin_amdgcn_ds_bpermute((lane ^ o) << 2, __builtin_bit_cast(int, v))); }
__device__ __forceinline__ float wave_sum(float v, int lane) {
#pragma unroll
    for (int o = 1; o < 64; o <<= 1) v += shx(v, o, lane);
    return v;
}
__device__ __forceinline__ int tid_opaque(int wv) { unsigned m = ~0u; asm volatile("" : "+s"(m), "+s"(wv)); int t = (wv << 6) | (int)__builtin_amdgcn_mbcnt_hi(m, __builtin_amdgcn_mbcnt_lo(m, 0u)); asm volatile("" : "+v"(t)); return t; }
__device__ __forceinline__ float silu_f(float v) { return v * __builtin_amdgcn_rcpf(1.f + __builtin_amdgcn_exp2f(v * -1.4426950408889634f)); }

namespace pg8 {
constexpr int BM = 256, BK = 64, HALF = 128, HTB = HALF * BK * 2, STAGE_BYTES = 8 * HTB, NXCD = 8, WGM = 8;
__host__ __device__ __forceinline__ int lds_byte(int r, int c) { const int st = (r >> 4) * 2 + (c >> 5), rr = r & 15, cc = c & 31, ob = rr * 64 + cc * 2; return st * 1024 + (ob ^ (((ob >> 9) & 1) << 5)); }
__host__ __device__ __forceinline__ void stage_rc(int b, int& R, int& C) { const int st = b / 1024, sb = b % 1024, swz = sb ^ (((sb >> 9) & 1) << 5); R = (st >> 1) * 16 + swz / 64; C = (st & 1) * 32 + (swz % 64) / 2; }
__host__ __device__ __forceinline__ int perm32(int rho) { const int n = rho >> 4, i = rho & 15; return 8 * (i >> 2) + 4 * n + (i & 3); }

struct Unit { int pm, pn; };
struct Gemm { const bf16_t* A; const bf16_t* Bt; int K; int lda; int wv; };

struct Order {
    int nM, nN, nwg, G, c, mode;
    __device__ __forceinline__ void init(int nM_, int nN_, int G_, int c_, int mode_) { nM = nM_; nN = nN_; nwg = nM * nN; G = G_; c = c_; mode = mode_; }
    __device__ __forceinline__ bool next(int i, Unit& u) const {
        const long L = (long)i * G + c; if (L >= nwg) return false;
        int wgid = (int)L; { const int q = nwg / NXCD, r = nwg % NXCD, xcd = wgid % NXCD, off = wgid / NXCD; wgid = (xcd < r ? xcd * (q + 1) : r * (q + 1) + (xcd - r) * q) + off; }
        const int nig = WGM * nN, gid = wgid / nig, fm = gid * WGM, gsz = (nM - fm) < WGM ? (nM - fm) : WGM;
        u.pm = fm + ((wgid % nig) % gsz); u.pn = (wgid % nig) / gsz; return true;
    }
    __device__ __forceinline__ long a_row(const Unit& u) const { return mode == 0 ? (long)u.pm * 256 : (long)(u.pm / 17) * 4096 + (long)(u.pm % 17) * 254 - 2; }
};

template <class Epi, class Sched>
__device__ __forceinline__ void gemm_phase(LAS unsigned char* lds, const Gemm g, const Sched& S, const Epi& E) {
    const int tid = tid_opaque(g.wv);
    const int wid = __builtin_amdgcn_readfirstlane(tid >> 6), lane = tid & 63, wr = wid >> 2, wc = wid & 3, fr = lane & 15, fq = lane >> 4;
    const int K = g.K, nt = K / BK, lda = g.lda;
    unsigned voffA[2], voffB[2];
#pragma unroll
    for (int i = 0; i < 2; ++i) { int R, C; stage_rc(tid * 16 + i * 8192, R, C); const int Rb = Epi::PERM ? ((R & ~31) + perm32(R & 31)) : R;
        voffA[i] = (unsigned)(R * lda + C) * 2u; voffB[i] = (unsigned)(Rb * K + C) * 2u; }
    const size_t kstep = (size_t)(BK * 2);
    const size_t hA = (size_t)HALF * lda * 2, hB = (size_t)HALF * K * 2;
    const size_t tB = 2 * hB;
    const unsigned ldsw = (unsigned)wid * 1024u;
    const int aoff = lds_byte(wr * 64 + fr, fq * 8), boff = lds_byte(wc * 32 + fr, fq * 8);
#define PG8_SA(b, h) (((b) * 2 + (h)) * HTB)
#define PG8_SB(b, h) ((4 + (b) * 2 + (h)) * HTB)
#define PG8_STAGE(bufoff, gbase, voff) do { _Pragma("unroll") for (int _i = 0; _i < 2; ++_i) \
        __builtin_amdgcn_global_load_lds((const unsigned*)((const char*)(gbase) + (voff)[_i]), (LAS unsigned*)(lds + (bufoff) + ldsw + _i * 8192), 16, 0, 0); } while (0)
#define PG8_LDA(dst, b, h) do { _Pragma("unroll") for (int m = 0; m < 4; ++m) _Pragma("unroll") for (int k = 0; k < 2; ++k) dst[m][k] = *(const LAS bf16x8*)(lds + PG8_SA(b, h) + aoff + m * 2048 + k * 1024); } while (0)
#define PG8_LDB(dst, b, h) do { _Pragma("unroll") for (int n = 0; n < 2; ++n) _Pragma("unroll") for (int k = 0; k < 2; ++k) dst[n][k] = *(const LAS bf16x8*)(lds + PG8_SB(b, h) + boff + n * 2048 + k * 1024); } while (0)
#define PG8_MMA(ai, bj, At, Bt) do { __builtin_amdgcn_s_setprio(1); _Pragma("unroll") for (int m = 0; m < 4; ++m) _Pragma("unroll") for (int n = 0; n < 2; ++n) _Pragma("unroll") for (int k = 0; k < 2; ++k) \
        acc[ai][bj][m][n] = __builtin_amdgcn_mfma_f32_16x16x32_bf16(Bt[n][k], At[m][k], acc[ai][bj][m][n], 0, 0, 0); __builtin_amdgcn_s_setprio(0); } while (0)
#define PG8_WAIT_V(n) asm volatile("s_waitcnt vmcnt(" #n ")" ::: "memory")
#define PG8_WAIT_L(n) asm volatile("s_waitcnt lgkmcnt(" #n ")" ::: "memory")
#define PG8_BAR __builtin_amdgcn_s_barrier()
#define PG8_SCHED __builtin_amdgcn_sched_barrier(0)
    Unit cur, nxt; int ui = 0;
    if (!S.next(0, cur)) return;
    f32x4 acc[2][2][4][2];
#pragma unroll
    for (int a = 0; a < 2; ++a)
#pragma unroll
        for (int b = 0; b < 2; ++b)
#pragma unroll
            for (int m = 0; m < 4; ++m)
#pragma unroll
                for (int n = 0; n < 2; ++n) acc[a][b][m][n] = (f32x4){0.f, 0.f, 0.f, 0.f};
    bf16x8 At[4][2], B0[2][2], B1[2][2];
    const char* cA = (const char*)g.A + S.a_row(cur) * (long)lda * 2; const char* cB = (const char*)g.Bt + (size_t)cur.pn * tB;
    PG8_STAGE(PG8_SB(0, 0), cB, voffB); PG8_STAGE(PG8_SB(0, 1), cB + hB, voffB); PG8_STAGE(PG8_SA(0, 0), cA, voffA); PG8_STAGE(PG8_SA(0, 1), cA + hA, voffA);
    if (wr == 1) PG8_BAR;
    PG8_WAIT_V(2); PG8_BAR;
    PG8_STAGE(PG8_SB(1, 0), cB + kstep, voffB); PG8_STAGE(PG8_SA(1, 0), cA + kstep, voffA); PG8_STAGE(PG8_SB(1, 1), cB + hB + kstep, voffB);
    PG8_WAIT_V(6); PG8_BAR;
    for (;;) {
        const bool has_next = S.next(ui + 1, nxt);
        const char* nA = has_next ? (const char*)g.A + S.a_row(nxt) * (long)lda * 2 : cA; const char* nB = has_next ? (const char*)g.Bt + (size_t)nxt.pn * tB : cB;
        for (int t = 0; t < nt; t += 2) {
            const bool last = (t == nt - 2);
            const char* a1 = cA + (size_t)(t + 1) * kstep;
            const char* a2 = last ? nA : cA + (size_t)(t + 2) * kstep; const char* b2 = last ? nB : cB + (size_t)(t + 2) * kstep;
            const char* a3 = a2 + kstep; const char* b3 = b2 + kstep;
            PG8_LDB(B0, 0, 0); PG8_LDB(B1, 0, 1); PG8_SCHED; PG8_LDA(At, 0, 0); PG8_STAGE(PG8_SA(1, 1), a1 + hA, voffA);
            PG8_WAIT_V(8); PG8_WAIT_L(0); PG8_BAR; PG8_MMA(0, 0, At, B0); PG8_MMA(0, 1, At, B1); PG8_BAR; PG8_SCHED;
            PG8_LDA(At, 0, 1); PG8_STAGE(PG8_SB(0, 0), b2, voffB); PG8_STAGE(PG8_SB(0, 1), b2 + hB, voffB); PG8_STAGE(PG8_SA(0, 0), a2, voffA);
            PG8_WAIT_V(8); PG8_WAIT_L(0); PG8_BAR; PG8_MMA(1, 0, At, B0); PG8_MMA(1, 1, At, B1); PG8_BAR; PG8_SCHED;
            PG8_LDB(B0, 1, 0); PG8_LDB(B1, 1, 1); PG8_SCHED; PG8_LDA(At, 1, 0); PG8_STAGE(PG8_SA(0, 1), a2 + hA, voffA);
            PG8_WAIT_V(8); PG8_WAIT_L(0); PG8_BAR; PG8_MMA(0, 0, At, B0); PG8_MMA(0, 1, At, B1); PG8_BAR; PG8_SCHED;
            PG8_LDA(At, 1, 1); PG8_STAGE(PG8_SB(1, 0), b3, voffB); PG8_STAGE(PG8_SB(1, 1), b3 + hB, voffB); PG8_STAGE(PG8_SA(1, 0), a3, voffA);
            PG8_WAIT_V(8); PG8_WAIT_L(0); PG8_BAR; PG8_MMA(1, 0, At, B0); PG8_MMA(1, 1, At, B1); PG8_BAR; PG8_SCHED;
        }
        if (wr == 0) PG8_BAR;
        { const int t2 = tid_opaque(g.wv), w2 = __builtin_amdgcn_readfirstlane(t2 >> 6), l2 = t2 & 63;
          E(acc, cur, S, w2 >> 2, w2 & 3, l2 & 15, l2 >> 4, lds, w2, l2); }
        if (!has_next) break;
#pragma unroll
        for (int a = 0; a < 2; ++a)
#pragma unroll
            for (int b = 0; b < 2; ++b)
#pragma unroll
                for (int m = 0; m < 4; ++m)
#pragma unroll
                    for (int n = 0; n < 2; ++n) acc[a][b][m][n] = (f32x4){0.f, 0.f, 0.f, 0.f};
        cur = nxt; cA = nA; cB = nB; ++ui;
        if (wr == 1) PG8_BAR;
    }
    PG8_WAIT_V(0);
    PG8_BAR;
#undef PG8_SA
#undef PG8_SB
#undef PG8_STAGE
#undef PG8_LDA
#undef PG8_LDB
#undef PG8_MMA
#undef PG8_WAIT_V
#undef PG8_WAIT_L
#undef PG8_BAR
#undef PG8_SCHED
}

typedef f32x4 Acc[2][2][4][2];

struct EpiProj {
    static constexpr bool PERM = true;
    bf16_t* O; float* dtraw; const unsigned long long* rowsq; const float* bias;
    __device__ __forceinline__ void operator()(Acc& acc, const Unit& u, const Order&, int wr, int wc, int fr, int fq, LAS unsigned char*, int, int) const {
        const int row0 = u.pm * BM + wr * 64 + fr, col0 = u.pn * BM + wc * 32 + 8 * fq;
        const float* bp = bias + (size_t)((u.pm * BM) / SEQ) * NPROJ + col0;
        f32x4 bv[2][2];
#pragma unroll
        for (int bj = 0; bj < 2; ++bj) { bv[bj][0] = *(const f32x4*)(bp + bj * HALF); bv[bj][1] = *(const f32x4*)(bp + bj * HALF + 4); }
        float r8[2][4];
#pragma unroll
        for (int ai = 0; ai < 2; ++ai)
#pragma unroll
            for (int m = 0; m < 4; ++m) r8[ai][m] = (float)rowsq[row0 + ai * HALF + m * 16] * (1.f / RSQ_SCALE);
#pragma unroll
        for (int ai = 0; ai < 2; ++ai)
#pragma unroll
            for (int m = 0; m < 4; ++m) { const int row = row0 + ai * HALF + m * 16; bf16_t* rowp = O + (size_t)row * NPROJ + col0;
                const float r = __builtin_amdgcn_rsqf(r8[ai][m] * (1.f / D) + EPS);
#pragma unroll
                for (int bj = 0; bj < 2; ++bj) { const f32x4 v0 = acc[ai][bj][m][0] * r + bv[bj][0], v1 = acc[ai][bj][m][1] * r + bv[bj][1];
                    u32x4 w; w.x = cvt_pk_bf16(v0[0], v0[1]); w.y = cvt_pk_bf16(v0[2], v0[3]); w.z = cvt_pk_bf16(v1[0], v1[1]); w.w = cvt_pk_bf16(v1[2], v1[3]);
                    *(u32x4*)(rowp + bj * HALF) = w;
                    if (bj == 1 && col0 + HALF == PC_DT) { *(f32x4*)(dtraw + (size_t)row * 8) = v0; *(f32x4*)(dtraw + (size_t)row * 8 + 4) = v1; } } }
    }
};
struct EpiRes {
    static constexpr bool PERM = false;
    const float* base; float* out; const float* gate;
    bf16_t* hb; const float* ng; const float* sc; unsigned long long* rowsq;
    __device__ __forceinline__ void operator()(Acc& acc, const Unit& u, const Order&, int wr, int wc, int fr, int fq, LAS unsigned char*, int, int lane) const {
        const int row0 = u.pm * BM + wr * 64 + fr, col0 = u.pn * BM + wc * 32 + 4 * fq, b = (u.pm * BM) / SEQ;
        const float* gp = gate + (size_t)b * 6144 + col0;
        f32x4 gv[2][2], gm[2][2];
        {
            f32x4 nv[2][2], sv[2][2];
#pragma unroll
            for (int bj = 0; bj < 2; ++bj)
#pragma unroll
                for (int n = 0; n < 2; ++n) { gv[bj][n] = *(const f32x4*)(gp + bj * HALF + n * 16);
                    nv[bj][n] = *(const f32x4*)(ng + col0 + bj * HALF + n * 16);
                    sv[bj][n] = *(const f32x4*)(sc + (size_t)b * 6144 + col0 + bj * HALF + n * 16); }
#pragma unroll
            for (int bj = 0; bj < 2; ++bj)
#pragma unroll
                for (int n = 0; n < 2; ++n) gm[bj][n] = nv[bj][n] * (sv[bj][n] + 1.f);
        }
        constexpr int EPI_PF = 2;
        f32x4 bsv[8][2][2];
#define RES_LOAD(k) do { const size_t off_ = (size_t)(row0 + ((k) >> 2) * HALF + ((k) & 3) * 16) * D + col0; \
            _Pragma("unroll") for (int bj = 0; bj < 2; ++bj) _Pragma("unroll") for (int n = 0; n < 2; ++n) bsv[k][bj][n] = *(const f32x4*)(base + off_ + bj * HALF + n * 16); } while (0)
#pragma unroll
        for (int k = 0; k < EPI_PF; ++k) RES_LOAD(k);
#pragma unroll
        for (int k = 0; k < 8; ++k) { const int ai = k >> 2, m = k & 3; const int row = row0 + ai * HALF + m * 16; const size_t off = (size_t)row * D + col0; float ss = 0.f;
            f32x4 v[2][2];
#pragma unroll
            for (int bj = 0; bj < 2; ++bj)
#pragma unroll
                for (int n = 0; n < 2; ++n) v[bj][n] = bsv[k][bj][n] + gv[bj][n] * acc[ai][bj][m][n];
            if (k + EPI_PF < 8) RES_LOAD(k + EPI_PF);
#pragma unroll
            for (int bj = 0; bj < 2; ++bj)
#pragma unroll
                for (int n = 0; n < 2; ++n) { const f32x4 vv = v[bj][n];
                    *(f32x4*)(out + off + bj * HALF + n * 16) = vv;
                    if (hb) { ss += (vv.x * vv.x + vv.y * vv.y) + (vv.z * vv.z + vv.w * vv.w); const f32x4 hv = vv * gm[bj][n];
                        u32x2 w; w.x = cvt_pk_bf16(hv.x, hv.y); w.y = cvt_pk_bf16(hv.z, hv.w); *(u32x2*)(hb + off + bj * HALF + n * 16) = w; } }
            if (hb) { ss += shx(ss, 16, lane); ss += shx(ss, 32, lane); if (fq == 0) atomicAdd(rowsq + row, (unsigned long long)(ss * RSQ_SCALE + 0.5f)); }
        }
#undef RES_LOAD
    }
};
struct EpiMla {
    static constexpr bool PERM = true;
    bf16_t* Q; bf16_t* KV; const float* rs; int isq_;
    __device__ __forceinline__ void operator()(Acc& acc, const Unit& u, const Order&, int wr, int wc, int fr, int fq, LAS unsigned char*, int, int) const {
        const bool isq = isq_ != 0;
        const int row0 = u.pm * BM + wr * 64 + fr, col0 = u.pn * BM + wc * 32 + 8 * fq;
        bf16_t* O = isq ? Q : KV; const int ldo = isq ? 384 : 512; const float* rsp = isq ? rs : rs + M; const float scale = isq ? MLA_QSCALE : 1.f;
        float r8[2][4];
#pragma unroll
        for (int ai = 0; ai < 2; ++ai)
#pragma unroll
            for (int m = 0; m < 4; ++m) r8[ai][m] = rsp[row0 + ai * HALF + m * 16];
#pragma unroll
        for (int ai = 0; ai < 2; ++ai)
#pragma unroll
            for (int m = 0; m < 4; ++m) { const int row = row0 + ai * HALF + m * 16; const float r = r8[ai][m] * scale;
#pragma unroll
                for (int bj = 0; bj < 2; ++bj) { const int c8 = col0 + bj * HALF; if (c8 < ldo) { const f32x4 v0 = acc[ai][bj][m][0] * r, v1 = acc[ai][bj][m][1] * r;
                    u32x4 w; w.x = cvt_pk_bf16(v0[0], v0[1]); w.y = cvt_pk_bf16(v0[2], v0[3]); w.z = cvt_pk_bf16(v1[0], v1[1]); w.w = cvt_pk_bf16(v1[2], v1[3]);
                    *(u32x4*)(O + (size_t)row * ldo + c8) = w; } } }
    }
};
#define DPPR(src, ctrl) __builtin_bit_cast(float, __builtin_amdgcn_update_dpp(0, __builtin_bit_cast(int, (float)(src)), (ctrl), 0xf, 0xf, true))
#define DPPF(old, src, ctrl) __builtin_bit_cast(float, __builtin_amdgcn_update_dpp(__builtin_bit_cast(int, (float)(old)), __builtin_bit_cast(int, (float)(src)), (ctrl), 0xf, 0xf, false))
struct EpiUp {
    static constexpr bool PERM = true;
    bf16_t* O; const float* cw; const float* cb;
    const unsigned long long* rowsq; const float* bias;
    __device__ __forceinline__ void operator()(Acc& acc, const Unit& u, const Order&, int wr, int wc, int fr, int fq, LAS unsigned char* lds, int, int) const {
        LAS float* bnd = (LAS float*)(lds + LDS_EXTRA);
        const int cl = wc * 32 + 8 * fq;
        {
            const int bq = u.pm / 17, tq0 = (u.pm % 17) * 254 - 2;
            const float* bp = bias + (size_t)bq * (2 * DFF) + u.pn * BM + cl;
            f32x4 bv[2][2];
#pragma unroll
            for (int bj = 0; bj < 2; ++bj) { bv[bj][0] = *(const f32x4*)(bp + bj * HALF); bv[bj][1] = *(const f32x4*)(bp + bj * HALF + 4); }
#pragma unroll
            for (int ai = 0; ai < 2; ++ai)
#pragma unroll
                for (int m = 0; m < 4; ++m) { int gr = bq * SEQ + tq0 + ai * HALF + wr * 64 + m * 16 + fr; gr = gr < 0 ? 0 : (gr > M - 1 ? M - 1 : gr);
                    const float r = __builtin_amdgcn_rsqf((float)rowsq[gr] * (1.f / RSQ_SCALE) * (1.f / D) + EPS);
#pragma unroll
                    for (int bj = 0; bj < 2; ++bj) { acc[ai][bj][m][0] = acc[ai][bj][m][0] * r + bv[bj][0]; acc[ai][bj][m][1] = acc[ai][bj][m][1] * r + bv[bj][1]; } }
        }
        if (fr >= 14) {
#pragma unroll
            for (int ai = 0; ai < 2; ++ai)
#pragma unroll
                for (int bj = 0; bj < 2; ++bj)
#pragma unroll
                    for (int n = 0; n < 2; ++n) *(LAS f32x4*)(bnd + ((ai * 2 + wr) * 2 + (fr - 14)) * 256 + bj * HALF + cl + 4 * n) = acc[ai][bj][3][n];
        }
        asm volatile("s_waitcnt lgkmcnt(0)" ::: "memory"); __builtin_amdgcn_s_barrier(); asm volatile("" ::: "memory");
        const int b = u.pm / 17, t0 = (u.pm % 17) * 254 - 2;
        const int ch0 = u.pn * HALF + cl;
#pragma unroll
        for (int ai = 0; ai < 2; ++ai) {
        u32x2 stash[4];
#pragma unroll
        for (int n = 0; n < 2; ++n) {
            f32x4 w0[2], w1[2], w2[2], bb[2];
#pragma unroll
            for (int bj = 0; bj < 2; ++bj) { const int cc = bj * DFF + ch0 + 4 * n;
                w0[bj] = *(const f32x4*)(cw + cc); w1[bj] = *(const f32x4*)(cw + 2 * DFF + cc); w2[bj] = *(const f32x4*)(cw + 4 * DFF + cc); bb[bj] = *(const f32x4*)(cb + cc); }
#pragma unroll
                for (int m = 0; m < 4; ++m) {
                    f32x4 uu[2];
#pragma unroll
                    for (int bj = 0; bj < 2; ++bj) {
                        const f32x4 v = acc[ai][bj][m][n];
                        f32x4 pv;
                        if (m > 0) pv = acc[ai][bj][m - 1][n];
                        else if (wr == 1 || ai == 1) { const int src = (wr == 1) ? (ai * 2 + 0) : (0 * 2 + 1); pv = *(const LAS f32x4*)(bnd + (src * 2 + ((fr - 14) & 1)) * 256 + bj * HALF + cl + 4 * n); }
                        else pv = (f32x4){0.f, 0.f, 0.f, 0.f};
                        f32x4 p1, p2;
#pragma unroll
                        for (int j = 0; j < 4; ++j) { const float c1 = (fr == 15) ? pv[j] : v[j], c2 = (fr >= 14) ? pv[j] : v[j];
                            p1[j] = DPPR(c1, 0x121); p2[j] = DPPR(c2, 0x122); }
                        if (ai == 0 && m == 0 && wr == 0 && t0 < 0) { const int tq = t0 + fr; if (tq < 1) p1 = (f32x4){0.f, 0.f, 0.f, 0.f}; if (tq < 2) p2 = (f32x4){0.f, 0.f, 0.f, 0.f}; }
                        uu[bj] = bb[bj] + w2[bj] * v + w1[bj] * p1 + w0[bj] * p2;
                    }
                    const int r = ai * HALF + wr * 64 + m * 16 + fr, t = t0 + r;
                    f32x4 o;
#pragma unroll
                    for (int j = 0; j < 4; ++j) o[j] = silu_f(uu[0][j]) * uu[1][j];
                    if (n == 0) { stash[m].x = cvt_pk_bf16(o[0], o[1]); stash[m].y = cvt_pk_bf16(o[2], o[3]); }
                    else if (r >= 2 && t < SEQ) { u32x4 w; w.x = stash[m].x; w.y = stash[m].y; w.z = cvt_pk_bf16(o[0], o[1]); w.w = cvt_pk_bf16(o[2], o[3]);
                        *(u32x4*)(O + ((size_t)b * SEQ + t) * DFF + ch0) = w; }
                    asm volatile("" ::: "memory");
                }
        }
        }
    }
};
}

struct Args {
    const float* x; const float* c; const int* pos;
    const float* ada_w; const float* ada_b; const float* n1g; const float* n2g; const float* w_in;
    const float* sconv_w; const float* sconv_b; const float* dt_bias; const float* a_log; const float* ssd_d; const float* ssd_ng;
    const float* qng; const float* w_uq; const float* kvng; const float* w_ukv; const float* sinks; const float* w_out;
    const float* w_up; const float* fconv_w; const float* fconv_b; const float* w_dn; const float* fng;
    float* out; unsigned char* ws; int ph_lo, ph_hi, wv, pad2;
};

__device__ __forceinline__ void phase_mod(const Args& a, LAS unsigned char* lds, int G) {
    LAS float* cact = (LAS float*)lds;
    LAS float* red = (LAS float*)(lds + 32768);
    const int tid = tid_opaque(a.wv), lane = tid & 63, wave = __builtin_amdgcn_readfirstlane(tid >> 6);
    for (int i = tid; i < 8 * 1024; i += 512) cact[i] = silu_f(a.c[i]);
    __syncthreads();
    float* mod = (float*)(a.ws + WS_MOD);
    for (int item = blockIdx.x; item < 4 * 96; item += G) {
        const int l = item / 96, col = (item % 96) * 64 + lane;
        const float* W = a.ada_w + (size_t)l * 1024 * 6144 + col;
        float s[8];
#pragma unroll
        for (int b = 0; b < 8; ++b) s[b] = 0.f;
        for (int k0 = wave * 128; k0 < wave * 128 + 128; k0 += 16) { float wv16[16];
#pragma unroll
            for (int q = 0; q < 16; ++q) wv16[q] = W[(size_t)(k0 + q) * 6144];
#pragma unroll
            for (int q = 0; q < 16; ++q)
#pragma unroll
                for (int b = 0; b < 8; ++b) s[b] += cact[b * 1024 + k0 + q] * wv16[q]; }
#pragma unroll
        for (int b = 0; b < 8; ++b) red[(wave * 8 + b) * 64 + lane] = s[b];
        __syncthreads();
        float t = 0.f;
#pragma unroll
        for (int w = 0; w < 8; ++w) t += red[(w * 8 + wave) * 64 + lane];
        mod[((size_t)l * 8 + wave) * 6144 + col] = t + a.ada_b[(size_t)l * 6144 + col];
        __syncthreads();
    }
}
__device__ __forceinline__ void phase_rope(const Args& a, int G) {
    float* rope = (float*)(a.ws + WS_ROPE);
    for (int idx = blockIdx.x * 512 + tid_opaque(a.wv); idx < M * 16; idx += G * 512) {
        const int row = idx >> 4, i = idx & 15;
        float inv = 1.778279402e-04f;
        inv = (i == 14) ? 3.162277571e-04f : inv;
        inv = (i == 13) ? 5.623413017e-04f : inv;
        inv = (i == 12) ? 1.000000047e-03f : inv;
        inv = (i == 11) ? 1.778279431e-03f : inv;
        inv = (i == 10) ? 3.162277630e-03f : inv;
        inv = (i == 9) ? 5.623413250e-03f : inv;
        inv = (i == 8) ? 9.999999776e-03f : inv;
        inv = (i == 7) ? 1.778279431e-02f : inv;
        inv = (i == 6) ? 3.162277490e-02f : inv;
        inv = (i == 5) ? 5.623413250e-02f : inv;
        inv = (i == 4) ? 1.000000015e-01f : inv;
        inv = (i == 3) ? 1.778279394e-01f : inv;
        inv = (i == 2) ? 3.162277639e-01f : inv;
        inv = (i == 1) ? 5.623413324e-01f : inv;
        inv = (i == 0) ? 1.000000000e+00f : inv;
        const float ang = (float)a.pos[row] * inv;
        const double rev = (double)ang * 0.15915494309189535;
        const float fr = (float)(rev - (double)(int)rev);
        rope[(size_t)row * 32 + i] = __builtin_amdgcn_cosf(fr);
        rope[(size_t)row * 32 + 16 + i] = __builtin_amdgcn_sinf(fr);
    }
}
enum { MAP_ID = 0, MAP_IN = 1, MAP_UP = 2, MAP_UQ = 3, MAP_ZERO = 4 };
__device__ __forceinline__ int map_col(int kind, int n) {
    if (kind == MAP_ID) return n;
    if (kind == MAP_ZERO) return -1;
    if (kind == MAP_IN) {
        if (n < 1536) return n;
        if (n < 1920) return n + 8;
        if (n < 1952) { const int e = n - 1920; return 1928 + 16 * (e & 1) + (e >> 1); }
        if (n < 2464) return n + 8;
        if (n < 2472) return n - 2464 + 1536;
        return -1;
    }
    if (kind == MAP_UP) { const int pn = n >> 8, cl = n & 255; return cl < 128 ? pn * 128 + cl : DFF + pn * 128 + (cl - 128); }
    if (n >= 384) return -1;
    { const int h = n / 96, d = n % 96; if (d < 64) return h * 96 + d; const int e = d - 64; return h * 96 + 64 + 16 * (e & 1) + (e >> 1); }
}
__device__ __forceinline__ void tr_item(const float* W, int N, int ks0, bf16_t* WT, int Kd, int kd0, int n0, int kind, const float* ksc, LAS float* scr, int lane) {
    const int src = map_col(kind, n0 + (lane & 31));
    const int srcc = src < 0 ? 0 : src; const float msk = src < 0 ? 0.f : 1.f;
    float vals[32];
#pragma unroll
    for (int i = 0; i < 32; ++i) vals[i] = W[(size_t)(ks0 + 2 * i + (lane >> 5)) * N + srcc];
    if (ksc) {
#pragma unroll
        for (int i = 0; i < 32; ++i) vals[i] *= ksc[ks0 + 2 * i + (lane >> 5)];
    }
#pragma unroll
    for (int i = 0; i < 32; ++i) scr[(2 * i + (lane >> 5)) * 33 + (lane & 31)] = vals[i] * msk;
    asm volatile("s_waitcnt lgkmcnt(0)" ::: "memory");
    const int c = lane & 7;
#pragma unroll
    for (int j = 0; j < 4; ++j) { const int n = (lane >> 3) + 8 * j; const LAS float* s = scr + (8 * c) * 33 + n;
        u32x4 o; o.x = pk2(s[0 * 33], s[1 * 33]); o.y = pk2(s[2 * 33], s[3 * 33]); o.z = pk2(s[4 * 33], s[5 * 33]); o.w = pk2(s[6 * 33], s[7 * 33]);
        *(u32x4*)(WT + (size_t)(n0 + n) * Kd + kd0 + 8 * c) = o; }
    asm volatile("s_waitcnt lgkmcnt(0)" ::: "memory");
}
__device__ __forceinline__ void phase_weights(const Args& a, int l, unsigned char* wb, LAS unsigned char* lds, int G) {
    const int tid_ = tid_opaque(a.wv), lane = tid_ & 63, wave = tid_ >> 6;
    LAS float* scr = (LAS float*)(lds + wave * 16384);
    constexpr int I_IN = 16 * 80, I_OUT = 16 * 32, I_UP = 16 * 176, I_DN = 44 * 32, I_QKV = 4 * 16 + 2 * 16;
    constexpr int NIT = I_IN + I_OUT + I_UP + I_DN + I_QKV;
    for (int it = blockIdx.x * 8 + wave; it < NIT; it += G * 8) {
        int r = it;
        if (r < I_IN) { tr_item(a.w_in + (size_t)l * D * DIN, DIN, 64 * (r / 80), (bf16_t*)(wb + WO_IN), D, 64 * (r / 80), 32 * (r % 80), MAP_IN, nullptr, scr, lane); continue; } r -= I_IN;
        if (r < I_OUT) { tr_item(a.w_out + (size_t)l * D * D, D, 64 * (r / 32), (bf16_t*)(wb + WO_OUT), D, 64 * (r / 32), 32 * (r % 32), MAP_ID, nullptr, scr, lane); continue; } r -= I_OUT;
        if (r < I_UP) { tr_item(a.w_up + (size_t)l * D * 2 * DFF, 2 * DFF, 64 * (r / 176), (bf16_t*)(wb + WO_UP), D, 64 * (r / 176), 32 * (r % 176), MAP_UP, nullptr, scr, lane); continue; } r -= I_UP;
        if (r < I_DN) { tr_item(a.w_dn + (size_t)l * DFF * D, D, 64 * (r / 32), (bf16_t*)(wb + WO_DN), DFF, 64 * (r / 32), 32 * (r % 32), MAP_ID, nullptr, scr, lane); continue; } r -= I_DN;
        { if (r < 4 * 16) tr_item(a.w_uq + (size_t)l * 256 * 384, 384, 64 * (r / 16), (bf16_t*)(wb + WO_UQ), 256, 64 * (r / 16), 32 * (r % 16), MAP_UQ, a.qng + l * 256, scr, lane);
          else { r -= 64; tr_item(a.w_ukv + (size_t)l * 128 * 512, 512, 64 * (r / 16), (bf16_t*)(wb + WO_UKV), 128, 64 * (r / 16), 32 * (r % 16), MAP_ID, a.kvng + l * 128, scr, lane); } }
    }
}

__device__ __forceinline__ void phase_bias(const Args& a, int l, float* bias, LAS unsigned char* lds, int G) {
    LAS float* shv = (LAS float*)lds;
    LAS float* red = (LAS float*)(lds + 65536);
    const int tid = tid_opaque(a.wv), lane = tid & 63, wave = __builtin_amdgcn_readfirstlane(tid >> 6);
    const float* ml = (const float*)(a.ws + WS_MOD) + (size_t)l * 8 * 6144;
    __syncthreads();
    for (int i = tid; i < 2 * 8 * 1024; i += 512) { const int which = i >> 13, b = (i >> 10) & 7, k = i & 1023; shv[i] = ml[(size_t)b * 6144 + (which ? 3072 : 0) + k]; }
    __syncthreads();
    for (int item = blockIdx.x; item < 80 + 176; item += G) {
        const bool up = item >= 80; const int n = (up ? item - 80 : item) * 32 + (lane & 31), N = up ? 2 * DFF : DIN;
        const int src = map_col(up ? MAP_UP : MAP_IN, n);
        const float* W = (up ? a.w_up + (size_t)l * D * 2 * DFF : a.w_in + (size_t)l * D * DIN) + (src < 0 ? 0 : src);
        const LAS float* sv = shv + (up ? 8192 : 0);
        float s8[8];
#pragma unroll
        for (int b = 0; b < 8; ++b) s8[b] = 0.f;
        const int kb = wave * 128 + (lane >> 5) * 64;
        for (int k0 = kb; k0 < kb + 64; k0 += 16) { float wv16[16];
#pragma unroll
            for (int q = 0; q < 16; ++q) wv16[q] = W[(size_t)(k0 + q) * N];
#pragma unroll
            for (int q = 0; q < 16; ++q)
#pragma unroll
                for (int b = 0; b < 8; ++b) s8[b] += sv[b * 1024 + k0 + q] * wv16[q]; }
#pragma unroll
        for (int b = 0; b < 8; ++b) { s8[b] += shx(s8[b], 32, lane); red[(wave * 8 + b) * 64 + lane] = s8[b]; }
        __syncthreads();
        if (lane < 32) { float t = 0.f;
#pragma unroll
            for (int w = 0; w < 8; ++w) t += red[(w * 8 + wave) * 64 + lane];
            (up ? bias + 8 * NPROJ : bias)[(size_t)wave * (up ? 2 * DFF : NPROJ) + n] = src < 0 ? 0.f : t; }
        __syncthreads();
    }
}
__device__ __forceinline__ void phase_norm0(const float* xin, const float* g, const float* sc, bf16_t* hout, unsigned long long* rowsq, int G, int wv) {
    const int tid_ = tid_opaque(wv), lane = tid_ & 63, wave = tid_ >> 6;
    for (int row = blockIdx.x * 8 + wave; row < M; row += G * 8) {
        const int b = row / SEQ;
        const f32x4* xr = (const f32x4*)(xin + (size_t)row * D) + lane;
        f32x4 v[4]; float s = 0.f;
#pragma unroll
        for (int j = 0; j < 4; ++j) { v[j] = xr[64 * j]; s += (v[j].x * v[j].x + v[j].y * v[j].y) + (v[j].z * v[j].z + v[j].w * v[j].w); }
        s = wave_sum(s, lane);
        if (lane == 0) rowsq[row] = (unsigned long long)(s * RSQ_SCALE + 0.5f);
        u32x2* o8 = (u32x2*)(hout + (size_t)row * D) + lane;
#pragma unroll
        for (int j = 0; j < 4; ++j) { const int col = 4 * lane + 256 * j;
            const f32x4 y = v[j] * *(const f32x4*)(g + col) * (*(const f32x4*)(sc + (size_t)b * 6144 + col) + 1.f);
            u32x2 w; w.x = cvt_pk_bf16(y.x, y.y); w.y = cvt_pk_bf16(y.z, y.w); o8[64 * j] = w; }
    }
}
__device__ __forceinline__ void phase_final(float* x, const float* g, int G, int wv) {
    const int tid_ = tid_opaque(wv), lane = tid_ & 63, wave = tid_ >> 6;
    for (int row = blockIdx.x * 8 + wave; row < M; row += G * 8) {
        f32x4* xr = (f32x4*)(x + (size_t)row * D) + lane;
        f32x4 v[4]; float s = 0.f;
#pragma unroll
        for (int j = 0; j < 4; ++j) { v[j] = xr[64 * j]; s += (v[j].x * v[j].x + v[j].y * v[j].y) + (v[j].z * v[j].z + v[j].w * v[j].w); }
        const float r = 1.f / sqrtf(wave_sum(s, lane) * (1.f / D) + EPS);
#pragma unroll
        for (int j = 0; j < 4; ++j) { const f32x4 gg = *(const f32x4*)(g + 4 * lane + 256 * j); xr[64 * j] = v[j] * r * gg; }
    }
}
__device__ __forceinline__ void phase_prep(const Args& a, int l, int G) {
    const int tid_ = tid_opaque(a.wv), lane = tid_ & 63, wave = tid_ >> 6;
    const bf16_t* proj = (const bf16_t*)(a.ws + WS_PROJ);
    bf16_t* xbc = (bf16_t*)(a.ws + WS_H);
    const float* cw = a.sconv_w + (size_t)l * 4 * 1024; const float* cb = a.sconv_b + (size_t)l * 1024;
    const float* dtraw = (const float*)(a.ws + WS_DTRAW); float* dtsp = (float*)(a.ws + WS_DTSP);
    float* rq = (float*)(a.ws + WS_RS); float* rkv = rq + M; unsigned long long* rsq = (unsigned long long*)(a.ws + WS_RSQ);
    const float* rope = (const float*)(a.ws + WS_ROPE); bf16_t* kr = (bf16_t*)(a.ws + WS_KR);
    f32x4 wk[2][4][2], bk[2][2];
#pragma unroll
    for (int j = 0; j < 2; ++j) { const int ch = 8 * lane + 512 * j; bk[j][0] = *(const f32x4*)(cb + ch); bk[j][1] = *(const f32x4*)(cb + ch + 4);
#pragma unroll
        for (int k = 0; k < 4; ++k) { wk[j][k][0] = *(const f32x4*)(cw + k * 1024 + ch); wk[j][k][1] = *(const f32x4*)(cw + k * 1024 + ch + 4); } }
    const float dtb = lane < 8 ? a.dt_bias[l * 8 + lane] : 0.f;
    for (int run = blockIdx.x * 8 + wave; run < M / 16; run += G * 8) {
        const int rowb = run * 16, tb = rowb % SEQ;
        u32x4 win[2][3];
#pragma unroll
        for (int j = 0; j < 2; ++j)
#pragma unroll
            for (int k = 0; k < 3; ++k) { win[j][k] = (u32x4){0u, 0u, 0u, 0u}; if (tb - 3 + k >= 0) win[j][k] = *(const u32x4*)(proj + (size_t)(rowb - 3 + k) * NPROJ + PC_X + 8 * lane + 512 * j); }
        for (int r4 = 0; r4 < 16; r4 += 4) {
            u32x4 curv[4][2], cqv[4]; float dtr[4], rcs[4], rsn[4]; unsigned krv[4];
#pragma unroll
            for (int q = 0; q < 4; ++q) { const size_t row = (size_t)(rowb + r4 + q);
                curv[q][0] = *(const u32x4*)(proj + row * NPROJ + PC_X + 8 * lane); curv[q][1] = *(const u32x4*)(proj + row * NPROJ + PC_X + 8 * lane + 512);
                cqv[q] = (u32x4){0u, 0u, 0u, 0u}; if (lane < 48) cqv[q] = *(const u32x4*)(proj + row * NPROJ + PC_CQ + 8 * lane);
                dtr[q] = lane < 8 ? dtraw[row * 8 + lane] : 0.f;
                krv[q] = 0u; rcs[q] = 0.f; rsn[q] = 0.f;
                if (lane < 16) { krv[q] = *(const unsigned*)(proj + row * NPROJ + PC_KR + 2 * lane); rcs[q] = rope[row * 32 + lane]; rsn[q] = rope[row * 32 + 16 + lane]; } }
#pragma unroll
            for (int q = 0; q < 4; ++q) { const int row = rowb + r4 + q;
#pragma unroll
                for (int j = 0; j < 2; ++j) { const int ch = 8 * lane + 512 * j;
                    const u32x4 cur = curv[q][j];
                    f32x4 a0 = bk[j][0], a1 = bk[j][1];
#pragma unroll
                    for (int k = 0; k < 4; ++k) { const u32x4 pv = k < 3 ? win[j][k] : cur;
                        a0 += wk[j][k][0] * (f32x4){bflo(pv.x), bfhi(pv.x), bflo(pv.y), bfhi(pv.y)}; a1 += wk[j][k][1] * (f32x4){bflo(pv.z), bfhi(pv.z), bflo(pv.w), bfhi(pv.w)}; }
                    win[j][0] = win[j][1]; win[j][1] = win[j][2]; win[j][2] = cur;
                    u32x4 o; o.x = cvt_pk_bf16(silu_f(a0.x), silu_f(a0.y)); o.y = cvt_pk_bf16(silu_f(a0.z), silu_f(a0.w)); o.z = cvt_pk_bf16(silu_f(a1.x), silu_f(a1.y)); o.w = cvt_pk_bf16(silu_f(a1.z), silu_f(a1.w));
                    *(u32x4*)(xbc + (size_t)row * 1024 + ch) = o; }
                if (lane == 0) { rsq[row] = 0ull; rsq[M + row] = 0ull; }
                if (lane < 8) { const float v = dtr[q] + dtb; dtsp[(size_t)row * 8 + lane] = v > 15.f ? v : __logf(1.f + __expf(v)); }
                { const u32x4 pv = cqv[q];
                  const float f0 = bflo(pv.x), f1 = bfhi(pv.x), f2 = bflo(pv.y), f3 = bfhi(pv.y), f4 = bflo(pv.z), f5 = bfhi(pv.z), f6 = bflo(pv.w), f7 = bfhi(pv.w);
                  const float s = (f0 * f0 + f1 * f1) + (f2 * f2 + f3 * f3) + (f4 * f4 + f5 * f5) + (f6 * f6 + f7 * f7);
                  float sq = lane < 32 ? s : 0.f, sk = (lane >= 32 && lane < 48) ? s : 0.f;
                  sq = wave_sum(sq, lane); sk = wave_sum(sk, lane);
                  if (lane == 0) { rq[row] = __builtin_amdgcn_rsqf(sq * (1.f / 256.f) + EPS); rkv[row] = __builtin_amdgcn_rsqf(sk * (1.f / 128.f) + EPS); } }
                if (lane < 16) { const float x1 = bflo(krv[q]), x2 = bfhi(krv[q]);
                    *(unsigned*)(kr + (size_t)row * 32 + 2 * lane) = cvt_pk_bf16(x1 * rcs[q] - x2 * rsn[q], x1 * rsn[q] + x2 * rcs[q]); }
            }
        }
    }
}
__device__ __forceinline__ void phase_ssd_naive(const Args& a, int l, int G) {
    const int tid = tid_opaque(a.wv), pl = tid >> 5, nq = tid & 31, lane = tid & 63;
    const bf16_t* xbc = (const bf16_t*)(a.ws + WS_H);
    const bf16_t* proj = (const bf16_t*)(a.ws + WS_PROJ);
    const float* dtsp = (const float*)(a.ws + WS_DTSP);
    float* ytmp = (float*)(a.ws + WS_YS);
    for (int unit = blockIdx.x; unit < 256; unit += G) {
        const int b = unit >> 5, h = (unit >> 2) & 7, pq = unit & 3, g = h >> 2, p = pq * 16 + pl;
        const float av = -__expf(a.a_log[l * 8 + h]), dsk = a.ssd_d[l * 8 + h];
        float s0 = 0.f, s1 = 0.f, s2 = 0.f, s3 = 0.f;
        for (int t = 0; t < SEQ; ++t) {
            const size_t row = (size_t)b * SEQ + t;
            const float dt = dtsp[row * 8 + h];
            const float x = bf2f(xbc[row * 1024 + h * 64 + p]);
            const u32x2 bv = *(const u32x2*)(xbc + row * 1024 + 512 + g * 128 + 4 * nq);
            const u32x2 cv = *(const u32x2*)(xbc + row * 1024 + 768 + g * 128 + 4 * nq);
            const float dA = __expf(dt * av), xd = dt * x;
            s0 = s0 * dA + xd * bflo(bv.x); s1 = s1 * dA + xd * bfhi(bv.x); s2 = s2 * dA + xd * bflo(bv.y); s3 = s3 * dA + xd * bfhi(bv.y);
            float y = (s0 * bflo(cv.x) + s1 * bfhi(cv.x)) + (s2 * bflo(cv.y) + s3 * bfhi(cv.y));
            y += shx(y, 16, lane); y += shx(y, 8, lane); y += shx(y, 4, lane); y += shx(y, 2, lane); y += shx(y, 1, lane);
            if (nq == 0) { const float z = bf2f(proj[row * NPROJ + PC_Z + h * 64 + p]); ytmp[row * 512 + h * 64 + p] = (y + dsk * x) * silu_f(z); }
        }
    }
}
__device__ __forceinline__ void phase_ssd_norm(const Args& a, int l, int G) {
    const int tid_ = tid_opaque(a.wv), lane = tid_ & 63, wave = tid_ >> 6;
    const float* ytmp = (const float*)(a.ws + WS_YS); bf16_t* ycat = (bf16_t*)(a.ws + WS_YCAT);
    const float* ng = a.ssd_ng + l * 512;
    for (int row = blockIdx.x * 8 + wave; row < M; row += G * 8) {
        const f32x4 v0 = *(const f32x4*)(ytmp + (size_t)row * 512 + 8 * lane), v1 = *(const f32x4*)(ytmp + (size_t)row * 512 + 8 * lane + 4);
        float s = (v0.x * v0.x + v0.y * v0.y) + (v0.z * v0.z + v0.w * v0.w) + (v1.x * v1.x + v1.y * v1.y) + (v1.z * v1.z + v1.w * v1.w);
        s += shx(s, 16, lane); s += shx(s, 8, lane); s += shx(s, 4, lane); s += shx(s, 2, lane); s += shx(s, 1, lane);
        const float r = 1.f / sqrtf(s * (1.f / 256.f) + EPS);
        const f32x4 g0 = *(const f32x4*)(ng + 8 * lane), g1 = *(const f32x4*)(ng + 8 * lane + 4);
        u32x4 o; o.x = cvt_pk_bf16(v0.x * r * g0.x, v0.y * r * g0.y); o.y = cvt_pk_bf16(v0.z * r * g0.z, v0.w * r * g0.w); o.z = cvt_pk_bf16(v1.x * r * g1.x, v1.y * r * g1.y); o.w = cvt_pk_bf16(v1.z * r * g1.z, v1.w * r * g1.w);
        *(u32x4*)(ycat + (size_t)row * 1024 + 8 * lane) = o;
    }
}

constexpr size_t WS_CDEC = 399 * MiB;
__device__ __forceinline__ void phase_ssd_states(const Args& a, int l, int G) {
    const int tid = tid_opaque(a.wv), p = tid >> 3, no = tid & 7;
    const bf16_t* xbc = (const bf16_t*)(a.ws + WS_H); const float* dtsp = (const float*)(a.ws + WS_DTSP);
    float* states = (float*)(a.ws + WS_YS); float* cdec = (float*)(a.ws + WS_CDEC);
    for (int u = blockIdx.x; u < 2048; u += G) {
        const int b = u >> 8, c = (u >> 3) & 31, h = u & 7, g = h >> 2;
        const float av = -__expf(a.a_log[l * 8 + h]);
        float st[16];
#pragma unroll
        for (int j = 0; j < 16; ++j) st[j] = 0.f;
        float asum = 0.f;
        const size_t row0 = (size_t)b * SEQ + c * 128;
#pragma unroll 2
        for (int s2 = 0; s2 < 128; ++s2) { const size_t row = row0 + s2;
            const float dt = dtsp[row * 8 + h], da = dt * av, dA = __expf(da), xd = dt * bf2f(xbc[row * 1024 + h * 64 + p]);
            const u32x4 b0 = *(const u32x4*)(xbc + row * 1024 + 512 + g * 128 + 16 * no), b1 = *(const u32x4*)(xbc + row * 1024 + 512 + g * 128 + 16 * no + 8);
            asum += da;
            st[0] = st[0] * dA + xd * bflo(b0.x); st[1] = st[1] * dA + xd * bfhi(b0.x); st[2] = st[2] * dA + xd * bflo(b0.y); st[3] = st[3] * dA + xd * bfhi(b0.y);
            st[4] = st[4] * dA + xd * bflo(b0.z); st[5] = st[5] * dA + xd * bfhi(b0.z); st[6] = st[6] * dA + xd * bflo(b0.w); st[7] = st[7] * dA + xd * bfhi(b0.w);
            st[8] = st[8] * dA + xd * bflo(b1.x); st[9] = st[9] * dA + xd * bfhi(b1.x); st[10] = st[10] * dA + xd * bflo(b1.y); st[11] = st[11] * dA + xd * bfhi(b1.y);
            st[12] = st[12] * dA + xd * bflo(b1.z); st[13] = st[13] * dA + xd * bfhi(b1.z); st[14] = st[14] * dA + xd * bflo(b1.w); st[15] = st[15] * dA + xd * bfhi(b1.w); }
        float* sp = states + (size_t)u * 8192 + p * 128 + 16 * no;
#pragma unroll
        for (int j = 0; j < 4; ++j) *(f32x4*)(sp + 4 * j) = (f32x4){st[4 * j], st[4 * j + 1], st[4 * j + 2], st[4 * j + 3]};
        if (tid == 0) cdec[u] = __expf(asum);
    }
}
__device__ __forceinline__ void phase_ssd_scan(const Args& a, int G) {
    bf16_t* states = (bf16_t*)(a.ws + WS_YS); const float* cdec = (const float*)(a.ws + WS_CDEC);
    for (int e = blockIdx.x * 512 + tid_opaque(a.wv); e < 8 * 8 * 2048; e += G * 512) {
        const int b = e >> 14, h = (e >> 11) & 7, pn = e & 2047;
        f32x4 hc = (f32x4){0.f, 0.f, 0.f, 0.f};
#pragma unroll 8
        for (int c = 0; c < 32; ++c) { const int u = (b * 32 + c) * 8 + h; u32x2* sp = (u32x2*)(states + (size_t)u * 8192) + pn;
            const u32x2 v = *sp; u32x2 w; w.x = cvt_pk_bf16(hc.x, hc.y); w.y = cvt_pk_bf16(hc.z, hc.w); *sp = w;
            hc = hc * cdec[u] + (f32x4){bflo(v.x), bfhi(v.x), bflo(v.y), bfhi(v.y)}; }
    }
}
__device__ __forceinline__ void phase_ssd_out(const Args& a, int l, LAS unsigned char* lds, int G) {
    const int tid = tid_opaque(a.wv), p = tid >> 3, no = tid & 7, lane = tid & 63, wave = tid >> 6;
    const bf16_t* xbc = (const bf16_t*)(a.ws + WS_H); const bf16_t* proj = (const bf16_t*)(a.ws + WS_PROJ); const float* dtsp = (const float*)(a.ws + WS_DTSP);
    const float* states = (const float*)(a.ws + WS_YS); bf16_t* ycat = (bf16_t*)(a.ws + WS_YCAT);
    LAS float* yb = (LAS float*)lds;
    for (int u = blockIdx.x; u < 512; u += G) {
        const int b = u >> 6, c = (u >> 1) & 31, g = u & 1;
        const size_t row0 = (size_t)b * SEQ + c * 128;
        for (int hg = 0; hg < 4; ++hg) { const int h = g * 4 + hg;
            const float av = -__expf(a.a_log[l * 8 + h]), dsk = a.ssd_d[l * 8 + h];
            float st[16];
            { const float* sp = states + (size_t)((b * 32 + c) * 8 + h) * 8192 + p * 128 + 16 * no;
#pragma unroll
              for (int j = 0; j < 4; ++j) { const f32x4 v = *(const f32x4*)(sp + 4 * j); st[4 * j] = v.x; st[4 * j + 1] = v.y; st[4 * j + 2] = v.z; st[4 * j + 3] = v.w; } }
#pragma unroll 2
            for (int s2 = 0; s2 < 128; ++s2) { const size_t row = row0 + s2;
                const float dt = dtsp[row * 8 + h], dA = __expf(dt * av), x = bf2f(xbc[row * 1024 + h * 64 + p]), xd = dt * x;
                const bf16_t* bp = xbc + row * 1024 + 512 + g * 128 + 16 * no;
                const u32x4 b0 = *(const u32x4*)bp, b1 = *(const u32x4*)(bp + 8), c0 = *(const u32x4*)(bp + 256), c1 = *(const u32x4*)(bp + 264);
                st[0] = st[0] * dA + xd * bflo(b0.x); st[1] = st[1] * dA + xd * bfhi(b0.x); st[2] = st[2] * dA + xd * bflo(b0.y); st[3] = st[3] * dA + xd * bfhi(b0.y);
                st[4] = st[4] * dA + xd * bflo(b0.z); st[5] = st[5] * dA + xd * bfhi(b0.z); st[6] = st[6] * dA + xd * bflo(b0.w); st[7] = st[7] * dA + xd * bfhi(b0.w);
                st[8] = st[8] * dA + xd * bflo(b1.x); st[9] = st[9] * dA + xd * bfhi(b1.x); st[10] = st[10] * dA + xd * bflo(b1.y); st[11] = st[11] * dA + xd * bfhi(b1.y);
                st[12] = st[12] * dA + xd * bflo(b1.z); st[13] = st[13] * dA + xd * bfhi(b1.z); st[14] = st[14] * dA + xd * bflo(b1.w); st[15] = st[15] * dA + xd * bfhi(b1.w);
                float y = ((st[0] * bflo(c0.x) + st[1] * bfhi(c0.x)) + (st[2] * bflo(c0.y) + st[3] * bfhi(c0.y))) + ((st[4] * bflo(c0.z) + st[5] * bfhi(c0.z)) + (st[6] * bflo(c0.w) + st[7] * bfhi(c0.w)))
                        + ((st[8] * bflo(c1.x) + st[9] * bfhi(c1.x)) + (st[10] * bflo(c1.y) + st[11] * bfhi(c1.y))) + ((st[12] * bflo(c1.z) + st[13] * bfhi(c1.z)) + (st[14] * bflo(c1.w) + st[15] * bfhi(c1.w)));
                y += shx(y, 4, lane); y += shx(y, 2, lane); y += shx(y, 1, lane);
                if (no == 0) { const float z = bf2f(proj[row * NPROJ + PC_Z + h * 64 + p]); yb[s2 * 256 + hg * 64 + p] = (y + dsk * x) * silu_f(z); }
            }
        }
        __syncthreads();
        const float* ng = a.ssd_ng + l * 512 + g * 256;
        const f32x4 gg = *(const f32x4*)(ng + 4 * lane);
        for (int tk = wave; tk < 128; tk += 8) {
            const f32x4 v = *(const LAS f32x4*)(yb + tk * 256 + 4 * lane);
            const float sq = wave_sum((v.x * v.x + v.y * v.y) + (v.z * v.z + v.w * v.w), lane);
            const float r = 1.f / sqrtf(sq * (1.f / 256.f) + EPS);
            u32x2 w; w.x = cvt_pk_bf16(v.x * r * gg.x, v.y * r * gg.y); w.y = cvt_pk_bf16(v.z * r * gg.z, v.w * r * gg.w);
            *(u32x2*)(ycat + (row0 + tk) * 1024 + g * 256 + 4 * lane) = w;
        }
        __syncthreads();
    }
}

__device__ __forceinline__ void phase_mla_naive(const Args& a, int G) {
    const int tid_ = tid_opaque(a.wv), lane = tid_ & 63, wave = tid_ >> 6;
    const bf16_t* qb = (const bf16_t*)(a.ws + WS_Q); const bf16_t* kv = (const bf16_t*)(a.ws + WS_KV); const bf16_t* kr = (const bf16_t*)(a.ws + WS_KR);
    bf16_t* ycat = (bf16_t*)(a.ws + WS_YCAT);
    for (int blk = blockIdx.x; blk < 256; blk += G) {
        const int bh = blk >> 3, s = blk & 7, b = bh >> 2, h = bh & 3;
        const int c = (wave & 1) ? (16 * (wave >> 1) + 15 - s) : (16 * (wave >> 1) + s);
        const int t = c * 64 + lane; const size_t row = (size_t)b * SEQ + t;
        u32x4 qw[12];
#pragma unroll
        for (int i = 0; i < 12; ++i) qw[i] = *(const u32x4*)(qb + row * 384 + h * 96 + 8 * i);
        { const float* rp = (const float*)(a.ws + WS_ROPE) + row * 32;
#pragma unroll
          for (int i = 0; i < 4; ++i) { const f32x4 cs = *(const f32x4*)(rp + 4 * i), sn = *(const f32x4*)(rp + 16 + 4 * i); u32x4 w = qw[8 + i];
              w.x = cvt_pk_bf16(bflo(w.x) * cs.x - bfhi(w.x) * sn.x, bflo(w.x) * sn.x + bfhi(w.x) * cs.x); w.y = cvt_pk_bf16(bflo(w.y) * cs.y - bfhi(w.y) * sn.y, bflo(w.y) * sn.y + bfhi(w.y) * cs.y);
              w.z = cvt_pk_bf16(bflo(w.z) * cs.z - bfhi(w.z) * sn.z, bflo(w.z) * sn.z + bfhi(w.z) * cs.z); w.w = cvt_pk_bf16(bflo(w.w) * cs.w - bfhi(w.w) * sn.w, bflo(w.w) * sn.w + bfhi(w.w) * cs.w);
              qw[8 + i] = w; } }
        float o[64];
#pragma unroll
        for (int i = 0; i < 64; ++i) o[i] = 0.f;
        float mx = -1e30f, ls = 0.f;
        const int jend = c * 64 + 63;
        for (int j = 0; j <= jend; ++j) {
            const size_t rj = (size_t)b * SEQ + j;
            const bf16_t* kp = kv + rj * 512 + h * 128; const bf16_t* krp = kr + rj * 32;
            float sc = 0.f;
#pragma unroll
            for (int i = 0; i < 8; ++i) { const u32x4 w = *(const u32x4*)(kp + 8 * i); const u32x4 qq = qw[i];
                sc += bflo(qq.x) * bflo(w.x) + bfhi(qq.x) * bfhi(w.x) + bflo(qq.y) * bflo(w.y) + bfhi(qq.y) * bfhi(w.y) + bflo(qq.z) * bflo(w.z) + bfhi(qq.z) * bfhi(w.z) + bflo(qq.w) * bflo(w.w) + bfhi(qq.w) * bfhi(w.w); }
#pragma unroll
            for (int i = 0; i < 4; ++i) { const u32x4 w = *(const u32x4*)(krp + 8 * i); const u32x4 qq = qw[8 + i];
                sc += bflo(qq.x) * bflo(w.x) + bfhi(qq.x) * bfhi(w.x) + bflo(qq.y) * bflo(w.y) + bfhi(qq.y) * bfhi(w.y) + bflo(qq.z) * bflo(w.z) + bfhi(qq.z) * bfhi(w.z) + bflo(qq.w) * bflo(w.w) + bfhi(qq.w) * bfhi(w.w); }
            if (j <= t) {
                const float mn = fmaxf(mx, sc), f = exp2f(mx - mn), p = exp2f(sc - mn);
                ls = ls * f + p; mx = mn;
#pragma unroll
                for (int i = 0; i < 8; ++i) { const u32x4 w = *(const u32x4*)(kp + 64 + 8 * i);
                    o[8 * i] = o[8 * i] * f + p * bflo(w.x); o[8 * i + 1] = o[8 * i + 1] * f + p * bfhi(w.x); o[8 * i + 2] = o[8 * i + 2] * f + p * bflo(w.y); o[8 * i + 3] = o[8 * i + 3] * f + p * bfhi(w.y);
                    o[8 * i + 4] = o[8 * i + 4] * f + p * bflo(w.z); o[8 * i + 5] = o[8 * i + 5] * f + p * bfhi(w.z); o[8 * i + 6] = o[8 * i + 6] * f + p * bflo(w.w); o[8 * i + 7] = o[8 * i + 7] * f + p * bfhi(w.w); }
            }
        }
        const float il = 1.f / ls;
#pragma unroll
        for (int i = 0; i < 8; ++i) { u32x4 w; w.x = cvt_pk_bf16(o[8 * i] * il, o[8 * i + 1] * il); w.y = cvt_pk_bf16(o[8 * i + 2] * il, o[8 * i + 3] * il); w.z = cvt_pk_bf16(o[8 * i + 4] * il, o[8 * i + 5] * il); w.w = cvt_pk_bf16(o[8 * i + 6] * il, o[8 * i + 7] * il);
            *(u32x4*)(ycat + row * 1024 + 512 + h * 64 + 8 * i) = w; }
    }
}
__device__ __forceinline__ void phase_swa_naive(const Args& a, int l, int G) {
    const int tid_ = tid_opaque(a.wv), lane = tid_ & 63, wave = tid_ >> 6;
    const bf16_t* proj = (const bf16_t*)(a.ws + WS_PROJ); bf16_t* ycat = (bf16_t*)(a.ws + WS_YCAT);
    for (int blk = blockIdx.x; blk < 256; blk += G) {
        const int bh = blk >> 3, b = bh >> 2, h = bh & 3, c = (blk & 7) * 8 + wave, hk = h >> 1;
        const int t = c * 64 + lane; const size_t row = (size_t)b * SEQ + t;
        u32x4 qw[8];
#pragma unroll
        for (int i = 0; i < 8; ++i) qw[i] = *(const u32x4*)(proj + row * NPROJ + PC_SQ + h * 64 + 8 * i);
        float o[64];
#pragma unroll
        for (int i = 0; i < 64; ++i) o[i] = 0.f;
        float mx = a.sinks[l * 4 + h] * LOG2E, ls = 1.f;
        const int j0 = (c * 64 - 127) > 0 ? (c * 64 - 127) : 0, jend = c * 64 + 63;
        for (int j = j0; j <= jend; ++j) {
            const size_t rj = (size_t)b * SEQ + j;
            const bf16_t* kp = proj + rj * NPROJ + PC_SK + hk * 64; const bf16_t* vp = proj + rj * NPROJ + PC_SV + hk * 64;
            float sc = 0.f;
#pragma unroll
            for (int i = 0; i < 8; ++i) { const u32x4 w = *(const u32x4*)(kp + 8 * i); const u32x4 qq = qw[i];
                sc += bflo(qq.x) * bflo(w.x) + bfhi(qq.x) * bfhi(w.x) + bflo(qq.y) * bflo(w.y) + bfhi(qq.y) * bfhi(w.y) + bflo(qq.z) * bflo(w.z) + bfhi(qq.z) * bfhi(w.z) + bflo(qq.w) * bflo(w.w) + bfhi(qq.w) * bfhi(w.w); }
            sc *= SWA_QSCALE;
            if (j <= t && t - j < 128) {
                const float mn = fmaxf(mx, sc), f = exp2f(mx - mn), p = exp2f(sc - mn);
                ls = ls * f + p; mx = mn;
#pragma unroll
                for (int i = 0; i < 8; ++i) { const u32x4 w = *(const u32x4*)(vp + 8 * i);
                    o[8 * i] = o[8 * i] * f + p * bflo(w.x); o[8 * i + 1] = o[8 * i + 1] * f + p * bfhi(w.x); o[8 * i + 2] = o[8 * i + 2] * f + p * bflo(w.y); o[8 * i + 3] = o[8 * i + 3] * f + p * bfhi(w.y);
                    o[8 * i + 4] = o[8 * i + 4] * f + p * bflo(w.z); o[8 * i + 5] = o[8 * i + 5] * f + p * bfhi(w.z); o[8 * i + 6] = o[8 * i + 6] * f + p * bflo(w.w); o[8 * i + 7] = o[8 * i + 7] * f + p * bfhi(w.w); }
            }
        }
        const float il = 1.f / ls;
#pragma unroll
        for (int i = 0; i < 8; ++i) { u32x4 w; w.x = cvt_pk_bf16(o[8 * i] * il, o[8 * i + 1] * il); w.y = cvt_pk_bf16(o[8 * i + 2] * il, o[8 * i + 3] * il); w.z = cvt_pk_bf16(o[8 * i + 4] * il, o[8 * i + 5] * il); w.w = cvt_pk_bf16(o[8 * i + 6] * il, o[8 * i + 7] * il);
            *(u32x4*)(ycat + row * 1024 + 768 + h * 64 + 8 * i) = w; }
    }
}


typedef float f32x16 __attribute__((ext_vector_type(16)));
typedef short s16x4 __attribute__((ext_vector_type(4)));
__device__ __forceinline__ s16x4 lds_tr16(LAS unsigned char* p) { return __builtin_bit_cast(s16x4, __builtin_amdgcn_ds_read_tr16_b64_v4i16((LAS s16x4*)p)); }
template <bool MLA>
__device__ __forceinline__ void attn_unit(const Args& a, int l, LAS unsigned char* lds, int b, int hd, int qb) {
    constexpr int KS = MLA ? 6 : 4, KROW = MLA ? 208 : 144, KBUF = 128 * KROW, VBUF = 16384, VOFF = 2 * KBUF;
    const int tid = tid_opaque(a.wv), lane = tid & 63, wave = __builtin_amdgcn_readfirstlane(tid >> 6), r = lane & 31, h = lane >> 5;
    const bf16_t* proj = (const bf16_t*)(a.ws + WS_PROJ);
    const bf16_t* Kp; const bf16_t* Vp; int ldk;
    if (MLA) { Kp = (const bf16_t*)(a.ws + WS_KV) + (size_t)b * SEQ * 512 + hd * 128; Vp = Kp + 64; ldk = 512; }
    else { Kp = proj + (size_t)b * SEQ * NPROJ + PC_SK + (hd >> 1) * 64; Vp = proj + (size_t)b * SEQ * NPROJ + PC_SV + (hd >> 1) * 64; ldk = NPROJ; }
    const bf16_t* Krp = (const bf16_t*)(a.ws + WS_KR) + (size_t)b * SEQ * 32;
    const int q0 = qb * 256, Q0 = q0 + wave * 32, qpos = Q0 + r;
    const size_t qrow = (size_t)b * SEQ + qpos;
    bf16x8 qr[KS];
    {
        u32x4 qw[KS]; f32x4 rcs[2], rsn[2];
        const bf16_t* qp = MLA ? (const bf16_t*)(a.ws + WS_Q) + qrow * 384 + hd * 96 + 8 * h : proj + qrow * NPROJ + PC_SQ + hd * 64 + 8 * h;
#pragma unroll
        for (int ks = 0; ks < KS; ++ks) qw[ks] = *(const u32x4*)(qp + 16 * ks);
        if (MLA) {
#pragma unroll
            for (int k2 = 0; k2 < 2; ++k2) { const float* rp = (const float*)(a.ws + WS_ROPE) + qrow * 32 + 8 * k2 + 4 * h; rcs[k2] = *(const f32x4*)rp; rsn[k2] = *(const f32x4*)(rp + 16); }
        }
#pragma unroll
        for (int ks = 0; ks < KS; ++ks) { u32x4 w = qw[ks];
            if (MLA) { if (ks >= 4) { const f32x4 cs = rcs[ks - 4 < 0 ? 0 : ks - 4], sn = rsn[ks - 4 < 0 ? 0 : ks - 4];
                w.x = cvt_pk_bf16(bflo(w.x) * cs.x - bfhi(w.x) * sn.x, bflo(w.x) * sn.x + bfhi(w.x) * cs.x); w.y = cvt_pk_bf16(bflo(w.y) * cs.y - bfhi(w.y) * sn.y, bflo(w.y) * sn.y + bfhi(w.y) * cs.y);
                w.z = cvt_pk_bf16(bflo(w.z) * cs.z - bfhi(w.z) * sn.z, bflo(w.z) * sn.z + bfhi(w.z) * cs.z); w.w = cvt_pk_bf16(bflo(w.w) * cs.w - bfhi(w.w) * sn.w, bflo(w.w) * sn.w + bfhi(w.w) * cs.w); } }
            else {
                w.x = cvt_pk_bf16(bflo(w.x) * SWA_QSCALE, bfhi(w.x) * SWA_QSCALE); w.y = cvt_pk_bf16(bflo(w.y) * SWA_QSCALE, bfhi(w.y) * SWA_QSCALE);
                w.z = cvt_pk_bf16(bflo(w.z) * SWA_QSCALE, bfhi(w.z) * SWA_QSCALE); w.w = cvt_pk_bf16(bflo(w.w) * SWA_QSCALE, bfhi(w.w) * SWA_QSCALE); }
            qr[ks] = __builtin_bit_cast(bf16x8, w); }
    }
    const int T_lo = MLA ? 0 : (qb == 0 ? 0 : 2 * qb - 1), T_hi = 2 * qb + 1;
    const int skey = tid >> 3, sch = tid & 7, rkey = tid >> 2, rch = tid & 3;
    u32x4 kreg[2], vreg[2], k2reg[2];
    auto gload = [&](int T) {
#pragma unroll
        for (int sub = 0; sub < 2; ++sub) { const int t = 2 * T + sub;
            kreg[sub] = *(const u32x4*)(Kp + (size_t)(64 * t + skey) * ldk + 8 * sch);
            vreg[sub] = *(const u32x4*)(Vp + (size_t)(64 * t + skey) * ldk + 8 * sch);
            if (MLA && tid < 256) k2reg[sub] = *(const u32x4*)(Krp + (size_t)(64 * t + rkey) * 32 + 8 * rch); }
    };
    auto lstore = [&](int buf) {
#pragma unroll
        for (int sub = 0; sub < 2; ++sub) {
            *(LAS u32x4*)(lds + buf * KBUF + (64 * sub + skey) * KROW + 16 * sch) = kreg[sub];
            *(LAS u32x4*)(lds + VOFF + buf * VBUF + sub * 8192 + (sch >> 2) * 4096 + skey * 64 + (sch & 3) * 16) = vreg[sub];
            if (MLA && tid < 256) *(LAS u32x4*)(lds + buf * KBUF + (64 * sub + rkey) * KROW + 128 + 16 * rch) = k2reg[sub]; }
    };
    f32x16 o0, o1;
#pragma unroll
    for (int i = 0; i < 16; ++i) { o0[i] = 0.f; o1[i] = 0.f; }
    float mx = MLA ? 0.f : a.sinks[l * 4 + hd] * LOG2E, ls = (MLA || h == 1) ? 0.f : 1.f;
    f32x16 negm;
#pragma unroll
    for (int i = 0; i < 16; ++i) negm[i] = -mx;
    gload(T_lo); lstore(0);
    __syncthreads();
    const int trb = (4 * h + ((lane & 15) >> 2)) * 64 + ((lane >> 4) & 1) * 32 + (lane & 3) * 8;
    for (int T = T_lo; T <= T_hi; ++T) {
        const int buf = (T - T_lo) & 1;
        if (T < T_hi) gload(T + 1);
#pragma unroll
        for (int sub = 0; sub < 2; ++sub) {
        const int t = 2 * T + sub;
        const bool active = (64 * t <= Q0 + 31) && (MLA || 64 * t + 63 >= Q0 - 127);
        if (active) {
            LAS unsigned char* Kb = lds + buf * KBUF + (64 * sub + r) * KROW + 16 * h;
            f32x16 p0 = negm, p1 = negm;
#pragma unroll
            for (int ks = 0; ks < KS; ++ks) {
                const bf16x8 k0 = *(const LAS bf16x8*)(Kb + 32 * ks), k1 = *(const LAS bf16x8*)(Kb + 32 * KROW + 32 * ks);
                p0 = __builtin_amdgcn_mfma_f32_32x32x16_bf16(k0, qr[ks], p0, 0, 0, 0);
                p1 = __builtin_amdgcn_mfma_f32_32x32x16_bf16(k1, qr[ks], p1, 0, 0, 0);
            }
            const bool need_mask = (64 * t + 63 > Q0) || (!MLA && 64 * t < Q0 + 31 - 127);
            if (need_mask) {
#pragma unroll
                for (int i = 0; i < 16; ++i) { const int kp = 64 * t + (i & 3) + 8 * (i >> 2) + 4 * h;
                    if (kp > qpos || (!MLA && qpos - kp >= 128)) p0[i] = -1e30f;
                    if (kp + 32 > qpos || (!MLA && qpos - kp - 32 >= 128)) p1[i] = -1e30f; } }
            float mt = fmaxf(p0[0], p1[0]);
#pragma unroll
            for (int i = 1; i < 16; ++i) mt = fmaxf(mt, fmaxf(p0[i], p1[i]));
            mt = fmaxf(mt, shx(mt, 32, lane));
            const bool first = MLA && (t == 0);
            if (first || __builtin_amdgcn_ballot_w64(mt > 8.f) != 0ull) {
                const float dl = first ? mt : fmaxf(mt, 0.f), f = first ? 1.f : __builtin_amdgcn_exp2f(-dl);
                mx += dl; ls *= f;
#pragma unroll
                for (int i = 0; i < 16; ++i) { p0[i] -= dl; p1[i] -= dl; o0[i] *= f; o1[i] *= f; negm[i] = -mx; }
            }
            float sum = 0.f;
#pragma unroll
            for (int i = 0; i < 16; ++i) { p0[i] = __builtin_amdgcn_exp2f(p0[i]); p1[i] = __builtin_amdgcn_exp2f(p1[i]); sum += p0[i] + p1[i]; }
            ls += sum;
            bf16x8 pw[2][2];
#pragma unroll
            for (int s2 = 0; s2 < 2; ++s2) {
                u32x4 w0, w1;
                w0.x = cvt_pk_bf16(p0[8 * s2], p0[8 * s2 + 1]); w0.y = cvt_pk_bf16(p0[8 * s2 + 2], p0[8 * s2 + 3]); w0.z = cvt_pk_bf16(p0[8 * s2 + 4], p0[8 * s2 + 5]); w0.w = cvt_pk_bf16(p0[8 * s2 + 6], p0[8 * s2 + 7]);
                w1.x = cvt_pk_bf16(p1[8 * s2], p1[8 * s2 + 1]); w1.y = cvt_pk_bf16(p1[8 * s2 + 2], p1[8 * s2 + 3]); w1.z = cvt_pk_bf16(p1[8 * s2 + 4], p1[8 * s2 + 5]); w1.w = cvt_pk_bf16(p1[8 * s2 + 6], p1[8 * s2 + 7]);
                pw[0][s2] = __builtin_bit_cast(bf16x8, w0); pw[1][s2] = __builtin_bit_cast(bf16x8, w1);
            }
            LAS unsigned char* Vb = lds + VOFF + buf * VBUF + sub * 8192 + trb;
#pragma unroll
            for (int kb = 0; kb < 2; ++kb)
#pragma unroll
                for (int s2 = 0; s2 < 2; ++s2) {
                    const int ko = (32 * kb + 16 * s2) * 64;
                    const s16x4 a0l = lds_tr16(Vb + ko), a0h = lds_tr16(Vb + ko + 512), a1l = lds_tr16(Vb + 4096 + ko), a1h = lds_tr16(Vb + 4096 + ko + 512);
                    const bf16x8 A0 = {a0l[0], a0l[1], a0l[2], a0l[3], a0h[0], a0h[1], a0h[2], a0h[3]}, A1 = {a1l[0], a1l[1], a1l[2], a1l[3], a1h[0], a1h[1], a1h[2], a1h[3]};
                    o0 = __builtin_amdgcn_mfma_f32_32x32x16_bf16(A0, pw[kb][s2], o0, 0, 0, 0);
                    o1 = __builtin_amdgcn_mfma_f32_32x32x16_bf16(A1, pw[kb][s2], o1, 0, 0, 0);
                }
        }
        }
        if (T < T_hi) lstore(buf ^ 1);
        __syncthreads();
    }
    ls += shx(ls, 32, lane);
    const float il = 1.f / ls;
    bf16_t* op = (bf16_t*)(a.ws + WS_YCAT) + qrow * 1024 + (MLA ? 512 : 768) + hd * 64 + 4 * h;
#pragma unroll
    for (int g4 = 0; g4 < 4; ++g4) {
        u32x2 w; w.x = cvt_pk_bf16(o0[4 * g4] * il, o0[4 * g4 + 1] * il); w.y = cvt_pk_bf16(o0[4 * g4 + 2] * il, o0[4 * g4 + 3] * il); *(u32x2*)(op + 8 * g4) = w;
        w.x = cvt_pk_bf16(o1[4 * g4] * il, o1[4 * g4 + 1] * il); w.y = cvt_pk_bf16(o1[4 * g4 + 2] * il, o1[4 * g4 + 3] * il); *(u32x2*)(op + 32 + 8 * g4) = w;
    }
}
__device__ __forceinline__ int xcd_vid(int blk, int G) { return (G % 8 == 0) ? (blk % 8) * (G / 8) + blk / 8 : blk; }
__device__ __forceinline__ void phase_mla(const Args& a, int l, LAS unsigned char* lds, int G) {
    for (int v0 = blockIdx.x; v0 < 256; v0 += G) { const int v = (G == 256) ? xcd_vid(v0, G) : v0; const int bh = v >> 3, s = v & 7;
        attn_unit<true>(a, l, lds, bh >> 2, bh & 3, s); attn_unit<true>(a, l, lds, bh >> 2, bh & 3, 15 - s); }
}
__device__ __forceinline__ void phase_swa(const Args& a, int l, LAS unsigned char* lds, int G) {
    for (int v0 = blockIdx.x; v0 < 512; v0 += G) { const int v = (G == 256) ? 2 * xcd_vid(v0 & 255, G) + (v0 >> 8) : v0; const int bh = v >> 4; attn_unit<false>(a, l, lds, bh >> 2, bh & 3, v & 15); }
}
__device__ __forceinline__ int crow16(int i, int h2) { return (i & 3) + 8 * (i >> 2) + 4 * h2; }
__device__ __forceinline__ void ssd_tables(const Args& a, int l, LAS float* dts, LAS float* acs, size_t row0, int g, int tid) {
    const int hg = tid >> 7, s = tid & 127, h = 4 * g + hg;
    const float av = -__expf(a.a_log[l * 8 + h]);
    const float dt = ((const float*)(a.ws + WS_DTSP))[(row0 + s) * 8 + h];
    dts[hg * 128 + s] = dt;
    const int lane = tid & 63;
    float v = dt * av;
#pragma unroll
    for (int d = 1; d < 64; d <<= 1) { const float o = __builtin_bit_cast(float, __builtin_amdgcn_ds_bpermute(((lane - d) & 63) << 2, __builtin_bit_cast(int, v))); v += (lane >= d) ? o : 0.f; }
    if ((tid & 127) == 63) acs[hg * 128] = v;
    __syncthreads();
    const float add = (tid & 64) ? acs[hg * 128] : 0.f;
    __syncthreads();
    acs[hg * 128 + s] = v + add;
    __syncthreads();
}
template <bool SCALED>
__device__ __forceinline__ void ssd_stage_x(const bf16_t* xbc, size_t row0, int g, LAS unsigned char* Xi, const LAS float* dts, const LAS float* acs, int tid) {
    u32x4 vv[8];
#pragma unroll
    for (int i = 0; i < 8; ++i) { const int ch = tid + 512 * i, hg = ch >> 10, s = (ch >> 3) & 127, c8 = ch & 7;
        vv[i] = *(const u32x4*)(xbc + (row0 + s) * 1024 + (4 * g + hg) * 64 + 8 * c8); }
#pragma unroll
    for (int i = 0; i < 8; ++i) { const int ch = tid + 512 * i, hg = ch >> 10, s = (ch >> 3) & 127, c8 = ch & 7;
        u32x4 v = vv[i];
        if (SCALED) { const float w = dts[hg * 128 + s] * __expf(acs[hg * 128 + 127] - acs[hg * 128 + s]);
            v.x = cvt_pk_bf16(bflo(v.x) * w, bfhi(v.x) * w); v.y = cvt_pk_bf16(bflo(v.y) * w, bfhi(v.y) * w); v.z = cvt_pk_bf16(bflo(v.z) * w, bfhi(v.z) * w); v.w = cvt_pk_bf16(bflo(v.w) * w, bfhi(v.w) * w); }
        *(LAS u32x4*)(Xi + hg * 16384 + (c8 >> 2) * 8192 + s * 64 + (c8 & 3) * 16) = v; }
}
__device__ __forceinline__ bf16x8 tr_frag(LAS unsigned char* p, int hi_off) {
    const s16x4 lo = lds_tr16(p), hi = lds_tr16(p + hi_off);
    return (bf16x8){lo[0], lo[1], lo[2], lo[3], hi[0], hi[1], hi[2], hi[3]};
}
__device__ __forceinline__ void phase_ssd_states_mfma(const Args& a, int l, LAS unsigned char* lds, int G) {
    const int tid = tid_opaque(a.wv), lane = tid & 63, wave = __builtin_amdgcn_readfirstlane(tid >> 6), r = lane & 31, h2 = lane >> 5;
    const bf16_t* xbc = (const bf16_t*)(a.ws + WS_H);
    bf16_t* states = (bf16_t*)(a.ws + WS_YS); float* cdec = (float*)(a.ws + WS_CDEC);
    LAS unsigned char* Bi = lds; LAS unsigned char* Xi = lds + 32768; LAS float* dts = (LAS float*)(lds + 98304); LAS float* acs = dts + 512;
    const int trb2 = (8 * h2 + ((lane & 15) >> 2)) * 64 + ((lane >> 4) & 1) * 32 + (lane & 3) * 8;
    for (int u = blockIdx.x; u < 512; u += G) {
        const int b = u >> 6, c = (u >> 1) & 31, g = u & 1; const size_t row0 = (size_t)b * SEQ + c * 128;
        ssd_tables(a, l, dts, acs, row0, g, tid);
#pragma unroll
        for (int i = 0; i < 4; ++i) { const int ch = tid + 512 * i, s = ch >> 4, c16 = ch & 15;
            *(LAS u32x4*)(Bi + (c16 >> 2) * 8192 + s * 64 + (c16 & 3) * 16) = *(const u32x4*)(xbc + (row0 + s) * 1024 + 512 + g * 128 + 8 * c16); }
        ssd_stage_x<true>(xbc, row0, g, Xi, dts, acs, tid);
        __syncthreads();
        const int hg = wave >> 1, nbh = wave & 1;
        f32x16 d00, d01, d10, d11;
#pragma unroll
        for (int i = 0; i < 16; ++i) { d00[i] = 0.f; d01[i] = 0.f; d10[i] = 0.f; d11[i] = 0.f; }
        LAS unsigned char* xa = Xi + hg * 16384 + trb2; LAS unsigned char* ba = Bi + (2 * nbh) * 8192 + trb2;
#pragma unroll
        for (int ks = 0; ks < 8; ++ks) {
            const bf16x8 A0 = tr_frag(xa + ks * 1024, 256), A1 = tr_frag(xa + 8192 + ks * 1024, 256), B0 = tr_frag(ba + ks * 1024, 256), B1 = tr_frag(ba + 8192 + ks * 1024, 256);
            d00 = __builtin_amdgcn_mfma_f32_32x32x16_bf16(B0, A0, d00, 0, 0, 0); d01 = __builtin_amdgcn_mfma_f32_32x32x16_bf16(B0, A1, d01, 0, 0, 0);
            d10 = __builtin_amdgcn_mfma_f32_32x32x16_bf16(B1, A0, d10, 0, 0, 0); d11 = __builtin_amdgcn_mfma_f32_32x32x16_bf16(B1, A1, d11, 0, 0, 0);
        }
        asm volatile("s_nop 15\n\ts_nop 7" : "+v"(d00), "+v"(d01), "+v"(d10), "+v"(d11));
        bf16_t* sp = states + (size_t)((b * 32 + c) * 8 + 4 * g + hg) * 8192 + (size_t)r * 128 + 64 * nbh + 4 * h2;
#pragma unroll
        for (int g4 = 0; g4 < 4; ++g4) { u32x2 w;
            w.x = cvt_pk_bf16(d00[4 * g4], d00[4 * g4 + 1]); w.y = cvt_pk_bf16(d00[4 * g4 + 2], d00[4 * g4 + 3]); *(u32x2*)(sp + 8 * g4) = w;
            w.x = cvt_pk_bf16(d01[4 * g4], d01[4 * g4 + 1]); w.y = cvt_pk_bf16(d01[4 * g4 + 2], d01[4 * g4 + 3]); *(u32x2*)(sp + 32 * 128 + 8 * g4) = w;
            w.x = cvt_pk_bf16(d10[4 * g4], d10[4 * g4 + 1]); w.y = cvt_pk_bf16(d10[4 * g4 + 2], d10[4 * g4 + 3]); *(u32x2*)(sp + 32 + 8 * g4) = w;
            w.x = cvt_pk_bf16(d11[4 * g4], d11[4 * g4 + 1]); w.y = cvt_pk_bf16(d11[4 * g4 + 2], d11[4 * g4 + 3]); *(u32x2*)(sp + 32 * 128 + 32 + 8 * g4) = w; }
        if (tid < 4) cdec[(b * 32 + c) * 8 + 4 * g + tid] = __expf(acs[tid * 128 + 127]);
        __syncthreads();
    }
}
__device__ __forceinline__ void phase_ssd_out_mfma(const Args& a, int l, LAS unsigned char* lds, int G) {
    constexpr int RW = 272;
    const int tid = tid_opaque(a.wv), lane = tid & 63, wave = __builtin_amdgcn_readfirstlane(tid >> 6), r = lane & 31, h2 = lane >> 5;
    const bf16_t* xbc = (const bf16_t*)(a.ws + WS_H); const bf16_t* proj = (const bf16_t*)(a.ws + WS_PROJ);
    const bf16_t* states = (const bf16_t*)(a.ws + WS_YS); bf16_t* ycat = (bf16_t*)(a.ws + WS_YCAT);
    LAS unsigned char* Cr = lds; LAS unsigned char* Br = lds + 34816; LAS unsigned char* Xi = lds + 69632;
    LAS float* dts = (LAS float*)(lds + 135168); LAS float* acs = dts + 512; LAS float* sq = dts + 1024;
    const int trb = (4 * h2 + ((lane & 15) >> 2)) * 64 + ((lane >> 4) & 1) * 32 + (lane & 3) * 8;
    for (int u = blockIdx.x; u < 512; u += G) {
        const int b = u >> 6, c = (u >> 1) & 31, g = u & 1; const size_t row0 = (size_t)b * SEQ + c * 128;
        const int hg = wave >> 1, lh = wave & 1, h = 4 * g + hg;
        const float dsk = a.ssd_d[l * 8 + h];
        bf16x8 hf[2][8];
        { const bf16_t* hp = states + (size_t)((b * 32 + c) * 8 + h) * 8192 + (size_t)r * 128 + 8 * h2;
#pragma unroll
          for (int pb = 0; pb < 2; ++pb)
#pragma unroll
              for (int ks = 0; ks < 8; ++ks) hf[pb][ks] = *(const bf16x8*)(hp + pb * 4096 + 16 * ks); }
        ssd_tables(a, l, dts, acs, row0, g, tid);
#pragma unroll
        for (int i = 0; i < 4; ++i) { const int ch = tid + 512 * i, s = ch >> 4, c16 = ch & 15; const bf16_t* src = xbc + (row0 + s) * 1024 + 512 + g * 128 + 8 * c16;
            *(LAS u32x4*)(Br + s * RW + 16 * c16) = *(const u32x4*)src; *(LAS u32x4*)(Cr + s * RW + 16 * c16) = *(const u32x4*)(src + 256); }
        ssd_stage_x<false>(xbc, row0, g, Xi, dts, acs, tid);
        __syncthreads();
        f32x16 yv[2][2];
#pragma unroll
        for (int lb = 0; lb < 2; ++lb) {
            const int Lb = lb == 0 ? lh : 3 - lh, L0 = 32 * Lb, lq = L0 + r;
            bf16x8 cf[8];
#pragma unroll
            for (int ks = 0; ks < 8; ++ks) cf[ks] = *(const LAS bf16x8*)(Cr + lq * RW + 32 * ks + 16 * h2);
            f32x16 o0, o1;
#pragma unroll
            for (int i = 0; i < 16; ++i) { o0[i] = 0.f; o1[i] = 0.f; }
#pragma unroll
            for (int ks = 0; ks < 8; ++ks) {
                o0 = __builtin_amdgcn_mfma_f32_32x32x16_bf16(hf[0][ks], cf[ks], o0, 0, 0, 0);
                o1 = __builtin_amdgcn_mfma_f32_32x32x16_bf16(hf[1][ks], cf[ks], o1, 0, 0, 0);
            }
            const float Al = acs[hg * 128 + lq], eAl = __expf(Al);
#pragma unroll
            for (int i = 0; i < 16; ++i) { o0[i] *= eAl; o1[i] *= eAl; }
            for (int sb = 0; sb <= Lb; ++sb) {
                f32x16 X;
#pragma unroll
                for (int i = 0; i < 16; ++i) X[i] = 0.f;
#pragma unroll
                for (int ks = 0; ks < 8; ++ks) X = __builtin_amdgcn_mfma_f32_32x32x16_bf16(*(const LAS bf16x8*)(Br + (32 * sb + r) * RW + 32 * ks + 16 * h2), cf[ks], X, 0, 0, 0);
#pragma unroll
                for (int i = 0; i < 16; ++i) { const int s = 32 * sb + crow16(i, h2); X[i] = (s <= lq) ? X[i] * __expf(Al - acs[hg * 128 + s]) * dts[hg * 128 + s] : 0.f; }
                u32x4 w0, w1;
                w0.x = cvt_pk_bf16(X[0], X[1]); w0.y = cvt_pk_bf16(X[2], X[3]); w0.z = cvt_pk_bf16(X[4], X[5]); w0.w = cvt_pk_bf16(X[6], X[7]);
                w1.x = cvt_pk_bf16(X[8], X[9]); w1.y = cvt_pk_bf16(X[10], X[11]); w1.z = cvt_pk_bf16(X[12], X[13]); w1.w = cvt_pk_bf16(X[14], X[15]);
                LAS unsigned char* xa = Xi + hg * 16384 + trb + (32 * sb) * 64;
                o0 = __builtin_amdgcn_mfma_f32_32x32x16_bf16(tr_frag(xa, 512), __builtin_bit_cast(bf16x8, w0), o0, 0, 0, 0);
                o1 = __builtin_amdgcn_mfma_f32_32x32x16_bf16(tr_frag(xa + 8192, 512), __builtin_bit_cast(bf16x8, w0), o1, 0, 0, 0);
                o0 = __builtin_amdgcn_mfma_f32_32x32x16_bf16(tr_frag(xa + 1024, 512), __builtin_bit_cast(bf16x8, w1), o0, 0, 0, 0);
                o1 = __builtin_amdgcn_mfma_f32_32x32x16_bf16(tr_frag(xa + 8192 + 1024, 512), __builtin_bit_cast(bf16x8, w1), o1, 0, 0, 0);
            }
            float ssq = 0.f;
            const bf16_t* zp = proj + (row0 + lq) * NPROJ + PC_Z + h * 64 + 4 * h2;
#pragma unroll
            for (int g4 = 0; g4 < 4; ++g4) {
                const u32x2 x0 = *(const LAS u32x2*)(Xi + hg * 16384 + lq * 64 + (8 * g4 + 4 * h2) * 2), x1 = *(const LAS u32x2*)(Xi + hg * 16384 + 8192 + lq * 64 + (8 * g4 + 4 * h2) * 2);
                const u32x2 z0 = *(const u32x2*)(zp + 8 * g4), z1 = *(const u32x2*)(zp + 32 + 8 * g4);
                float v;
                v = (o0[4 * g4] + dsk * bflo(x0.x)) * silu_f(bflo(z0.x)); o0[4 * g4] = v; ssq += v * v;
                v = (o0[4 * g4 + 1] + dsk * bfhi(x0.x)) * silu_f(bfhi(z0.x)); o0[4 * g4 + 1] = v; ssq += v * v;
                v = (o0[4 * g4 + 2] + dsk * bflo(x0.y)) * silu_f(bflo(z0.y)); o0[4 * g4 + 2] = v; ssq += v * v;
                v = (o0[4 * g4 + 3] + dsk * bfhi(x0.y)) * silu_f(bfhi(z0.y)); o0[4 * g4 + 3] = v; ssq += v * v;
                v = (o1[4 * g4] + dsk * bflo(x1.x)) * silu_f(bflo(z1.x)); o1[4 * g4] = v; ssq += v * v;
                v = (o1[4 * g4 + 1] + dsk * bfhi(x1.x)) * silu_f(bfhi(z1.x)); o1[4 * g4 + 1] = v; ssq += v * v;
                v = (o1[4 * g4 + 2] + dsk * bflo(x1.y)) * silu_f(bflo(z1.y)); o1[4 * g4 + 2] = v; ssq += v * v;
                v = (o1[4 * g4 + 3] + dsk * bfhi(x1.y)) * silu_f(bfhi(z1.y)); o1[4 * g4 + 3] = v; ssq += v * v;
            }
            ssq += shx(ssq, 32, lane);
            if (h2 == 0) sq[lq * 4 + hg] = ssq;
            yv[lb][0] = o0; yv[lb][1] = o1;
        }
        f32x4 ngv[4][2];
        { const float* ngp = a.ssd_ng + l * 512 + g * 256 + hg * 64 + 4 * h2;
#pragma unroll
          for (int g4 = 0; g4 < 4; ++g4)
#pragma unroll
              for (int pb = 0; pb < 2; ++pb) ngv[g4][pb] = *(const f32x4*)(ngp + 32 * pb + 8 * g4); }
        __syncthreads();
#pragma unroll
        for (int lb = 0; lb < 2; ++lb) {
            const int Lb = lb == 0 ? lh : 3 - lh, lq = 32 * Lb + r;
            const f32x4 t4 = *(const LAS f32x4*)(sq + lq * 4);
            const float rinv = __builtin_amdgcn_rsqf(((t4.x + t4.y) + (t4.z + t4.w)) * (1.f / 256.f) + EPS);
            bf16_t* op = ycat + (row0 + lq) * 1024 + g * 256 + hg * 64 + 4 * h2;
#pragma unroll
            for (int g4 = 0; g4 < 4; ++g4)
#pragma unroll
                for (int pb = 0; pb < 2; ++pb) { const f32x4 gg = ngv[g4][pb];
                    u32x2 w; w.x = cvt_pk_bf16(yv[lb][pb][4 * g4] * rinv * gg.x, yv[lb][pb][4 * g4 + 1] * rinv * gg.y); w.y = cvt_pk_bf16(yv[lb][pb][4 * g4 + 2] * rinv * gg.z, yv[lb][pb][4 * g4 + 3] * rinv * gg.w);
                    *(u32x2*)(op + 32 * pb + 8 * g4) = w; }
        }
        __syncthreads();
    }
}


#define XB_TMO      128
#define XB_XCNT(j)  (256  + 64 * (j))
#define XB_XSUB(j)  (1280 + 64 * (j))
#define XB_XGEN(j)  (2304 + 64 * (j))
#define XB_TOP      3328
#define XB_TOPGEN   3392
#define XCD_BAR_WORDS 3456
#define XB_SPIN_CAP (1u << 18)
__device__ __forceinline__ unsigned xb_ld(unsigned* p)              { return __hip_atomic_load(p, __ATOMIC_RELAXED, __HIP_MEMORY_SCOPE_AGENT); }
__device__ __forceinline__ unsigned xb_add(unsigned* p, unsigned v) { return __hip_atomic_fetch_add(p, v, __ATOMIC_RELAXED, __HIP_MEMORY_SCOPE_AGENT); }
__device__ __forceinline__ unsigned xb_xcc_id() { return (unsigned)__builtin_amdgcn_s_getreg((3 << 11) | 20) & 0xFu; }
#define XB_SPIN(cond, bar) do { unsigned _sp = 0; while (cond) { __builtin_amdgcn_s_sleep(1); \
    if ((++_sp & 255u) == 0u) { if (xb_ld(&(bar)[XB_TMO])) break; if (_sp > XB_SPIN_CAP) { atomicAdd(&(bar)[XB_TMO], 1u); break; } } } } while (0)
struct XcdBarrier { unsigned* bar; unsigned x; volatile LAS unsigned* st; };
__device__ __forceinline__ XcdBarrier xcd_barrier_post(unsigned* bar, volatile LAS unsigned* st) {
    XcdBarrier b; b.bar = bar; b.x = xb_xcc_id(); b.st = st;
    if (threadIdx.x == 0) (void)xb_add(&bar[XB_XCNT(b.x)], 1u);
    return b;
}
__device__ __forceinline__ void xcd_barrier_complete(unsigned* bar, unsigned x, unsigned& nloc, unsigned& nx) {
    const unsigned G = gridDim.x * gridDim.y * gridDim.z;
    unsigned sum, cnt, mine, sp = 0u;
    for (;;) {
        sum = 0u; cnt = 0u; mine = 0u;
#pragma unroll
        for (unsigned j = 0; j < 16; ++j) { const unsigned c = xb_ld(&bar[XB_XCNT(j)]); sum += c; cnt += (c > 0u) ? 1u : 0u; mine = (j == x) ? c : mine; }
        if (sum == G) break;
        __builtin_amdgcn_s_sleep(1);
        if ((++sp & 255u) == 0u) { if (xb_ld(&bar[XB_TMO])) break; if (sp > XB_SPIN_CAP) { atomicAdd(&bar[XB_TMO], 1u); break; } }
    }
    nloc = mine > 0u ? mine : 1u; nx = cnt > 0u ? cnt : 1u;
}
__device__ __forceinline__ void xcd_barrier(const XcdBarrier& b) {
    asm volatile("s_waitcnt vmcnt(0)" ::: "memory");
    __syncthreads();
    if (threadIdx.x == 0) {
        unsigned* bar = b.bar;
        __builtin_amdgcn_s_waitcnt(0);
        unsigned nloc = b.st[0], nx = b.st[1];
        if (nloc == 0u) { xcd_barrier_complete(bar, b.x, nloc, nx); b.st[0] = nloc; b.st[1] = nx; }
        const unsigned old = xb_add(&bar[XB_XSUB(b.x)], 1u);
        const unsigned gen = old / nloc;
        if (old + 1u == (gen + 1u) * nloc) {
            __builtin_amdgcn_fence(__ATOMIC_RELEASE, "agent");
            asm volatile("s_waitcnt vmcnt(0)" ::: "memory");
            const unsigned og = xb_add(&bar[XB_TOP], 1u);
            const unsigned tg = og / nx;
            if (og + 1u == (tg + 1u) * nx) xb_add(&bar[XB_TOPGEN], 1u);
            else XB_SPIN(xb_ld(&bar[XB_TOPGEN]) == tg, bar);
            __builtin_amdgcn_fence(__ATOMIC_ACQUIRE, "agent");
            xb_add(&bar[XB_XGEN(b.x)], 1u);
            asm volatile("s_waitcnt vmcnt(0)" ::: "memory");
        } else {
            XB_SPIN(xb_ld(&bar[XB_XGEN(b.x)]) == gen, bar);
            __builtin_amdgcn_fence(__ATOMIC_ACQUIRE, "agent");
            asm volatile("s_waitcnt vmcnt(0)" ::: "memory");
        }
    }
    __syncthreads();
}

constexpr int PH_PER_LAYER = 8, N_PHASES = 2 + DEPTH * PH_PER_LAYER + 1;
__global__ void __launch_bounds__(512, 2) fwd_kernel(Args a0) {
    extern __shared__ __attribute__((aligned(16))) unsigned char lds_raw[];
    LAS unsigned char* lds = (LAS unsigned char*)lds_raw;
    const int G = gridDim.x;
    const int wave_s = __builtin_amdgcn_readfirstlane((int)threadIdx.x >> 6);
#if MK_PER_PHASE
#define SEAM() do {} while (0)
#else
    cg::grid_group grid = cg::this_grid();
    volatile LAS unsigned* bst = (volatile LAS unsigned*)(lds + LDS_BYTES - 64);
    if (threadIdx.x < 2) bst[threadIdx.x] = 0u;
    __syncthreads();
    const XcdBarrier xbar = xcd_barrier_post((unsigned*)a0.ws, bst);
#define SEAM() do { if (ph + 1 < a.ph_hi) { if (ph == 0) grid.sync(); else xcd_barrier(xbar); if (PROBE_MASK & 256) xcd_barrier(xbar); } } while (0)
#endif
    for (int ph = a0.ph_lo; ph < a0.ph_hi; ++ph) {
        unsigned long long wsi_ = (unsigned long long)a0.ws, oi_ = (unsigned long long)a0.out; asm volatile("" : "+s"(wsi_), "+s"(oi_));
        unsigned char* ws = (unsigned char*)(__attribute__((address_space(1))) unsigned char*)wsi_;
        Args a = a0; a.ws = ws; a.wv = wave_s;
        a.out = (float*)(__attribute__((address_space(1))) float*)oi_;
        const float* mod = (const float*)(ws + WS_MOD);
        bf16_t* hbuf = (bf16_t*)(ws + WS_H);
        unsigned long long* rowsq1 = (unsigned long long*)(ws + WS_RSQ); unsigned long long* rowsq2 = rowsq1 + M;
        if (ph == 0) { RUN(16, phase_mod(a, lds, G)); phase_rope(a, G); __syncthreads(); phase_weights(a, 0, ws + WS_W, lds, G); SEAM(); continue; }
        if (ph == 1) { phase_norm0(a.x, a.n1g, mod + 1024, hbuf, rowsq1, G, a.wv); phase_bias(a, 0, (float*)(ws + WS_BIAS), lds, G); SEAM(); continue; }
        if (ph == N_PHASES - 1) { phase_final(a.out, a.fng, G, a.wv); continue; }
        const int l = (ph - 2) / PH_PER_LAYER, sp = (ph - 2) % PH_PER_LAYER;
        const float* ml = mod + (size_t)l * 8 * 6144;
        const float* xcur = (l == 0) ? a.x : a.out;
        const unsigned char* Wb = ws + ((l & 1) ? WS_W2 : WS_W);
        const float* biasb = (const float*)(ws + WS_BIAS + (size_t)(l & 1) * 262144);
        if (sp == 0) {
            pg8::Gemm g{hbuf, (const bf16_t*)(Wb + WO_IN), D, D, a.wv}; pg8::Order S; S.init(M / 256, NPROJ / 256, G, (int)blockIdx.x, 0);
            pg8::EpiProj E{(bf16_t*)(ws + WS_PROJ), (float*)(ws + WS_DTRAW), rowsq1, biasb};
            RUN(32, pg8::gemm_phase(lds, g, S, E));
        } else if (sp == 1) {
            RUN(8, phase_prep(a, l, G));
        } else if (sp == 2) {
            { pg8::Gemm g{(const bf16_t*)(ws + WS_PROJ) + PC_CQ, (const bf16_t*)(Wb + WO_UQ), 256, NPROJ, a.wv}; pg8::Order S; S.init(M / 256, 2, G, (int)blockIdx.x, 0);
              pg8::EpiMla E{(bf16_t*)(ws + WS_Q), (bf16_t*)(ws + WS_KV), (const float*)(ws + WS_RS), 1};
              pg8::gemm_phase(lds, g, S, E); }
            { pg8::Gemm g{(const bf16_t*)(ws + WS_PROJ) + PC_CKV, (const bf16_t*)(Wb + WO_UKV), 128, NPROJ, a.wv}; pg8::Order S; S.init(M / 256, 2, G, (int)blockIdx.x, 0);
              pg8::EpiMla E{(bf16_t*)(ws + WS_Q), (bf16_t*)(ws + WS_KV), (const float*)(ws + WS_RS), 0};
              pg8::gemm_phase(lds, g, S, E); }
            RUN(4, phase_ssd_states_mfma(a, l, lds, G));
            RUN(2, phase_swa(a, l, lds, G));
        } else if (sp == 3) {
            phase_ssd_scan(a, G);
            RUN(2, phase_mla(a, l, lds, G));
            if (l + 1 < DEPTH) { __syncthreads(); RUN(1024, phase_weights(a, l + 1, ws + (((l + 1) & 1) ? WS_W2 : WS_W), lds, G)); RUN(512, phase_bias(a, l + 1, (float*)(ws + WS_BIAS + (size_t)((l + 1) & 1) * 262144), lds, G)); }
        } else if (sp == 4) {
            RUN(2048, phase_ssd_out_mfma(a, l, lds, G));
        } else if (sp == 5) {
            pg8::Gemm g{(const bf16_t*)(ws + WS_YCAT), (const bf16_t*)(Wb + WO_OUT), D, D, a.wv}; pg8::Order S; S.init(M / 256, D / 256, G, (int)blockIdx.x, 0);
            pg8::EpiRes E{xcur, a.out, ml + 2048, hbuf, a.n2g + l * D, ml + 4096, rowsq2};
            pg8::gemm_phase(lds, g, S, E);
        } else if (sp == 6) {
            pg8::Gemm g{hbuf, (const bf16_t*)(Wb + WO_UP), D, D, a.wv}; pg8::Order S; S.init(NB * 17, DFF / 128, G, (int)blockIdx.x, 1);
            pg8::EpiUp E{(bf16_t*)(ws + WS_PROJ), a.fconv_w + (size_t)l * 3 * 2 * DFF, a.fconv_b + (size_t)l * 2 * DFF, rowsq2, biasb + 8 * NPROJ};
            RUN(128, pg8::gemm_phase(lds, g, S, E));
        } else {
            pg8::Gemm g{(const bf16_t*)(ws + WS_PROJ), (const bf16_t*)(Wb + WO_DN), DFF, DFF, a.wv}; pg8::Order S; S.init(M / 256, D / 256, G, (int)blockIdx.x, 0);
            const bool nxt = l + 1 < DEPTH;
            pg8::EpiRes E{a.out, a.out, ml + 5120, nxt ? hbuf : nullptr, a.n1g + (nxt ? l + 1 : l) * D, ml + (nxt ? 8 * 6144 : 0) + 1024, rowsq1};
            pg8::gemm_phase(lds, g, S, E);
        }
        SEAM();
    }
}

extern "C" void kernel_launch(void* const* d_in, const int* in_sizes, int n_in, void* d_out, int out_size, void* d_ws, size_t ws_size, hipStream_t stream) {
    static int grid = 0;
    if (grid == 0) {
        if (n_in != 25 || ws_size < WS_END) { fprintf(stderr, "kernel_launch: unexpected n_in %d / ws %zu\n", n_in, ws_size); grid = -1; return; }
        int dev = 0, cus = 0, per_cu = 0;
        hipGetDevice(&dev); hipDeviceGetAttribute(&cus, hipDeviceAttributeMultiprocessorCount, dev);
        if (hipFuncSetAttribute((const void*)fwd_kernel, hipFuncAttributeMaxDynamicSharedMemorySize, LDS_BYTES) != hipSuccess) { fprintf(stderr, "hipFuncSetAttribute failed\n"); }
        hipOccupancyMaxActiveBlocksPerMultiprocessor(&per_cu, (const void*)fwd_kernel, 512, LDS_BYTES);
        (void)hipGetLastError();
        if (per_cu < 1) { fprintf(stderr, "occupancy query says %d blocks/CU\n", per_cu); per_cu = 1; }
        grid = cus;
    }
    if (grid < 0) return;
    if (hipMemsetAsync(d_ws, 0, 16384, stream) != hipSuccess) { fprintf(stderr, "kernel_launch: memset of the barrier words failed\n"); return; }
    Args a{};
    a.x = (const float*)d_in[0]; a.c = (const float*)d_in[1]; a.pos = (const int*)d_in[2];
    a.ada_w = (const float*)d_in[3]; a.ada_b = (const float*)d_in[4]; a.n1g = (const float*)d_in[5]; a.n2g = (const float*)d_in[6]; a.w_in = (const float*)d_in[7];
    a.sconv_w = (const float*)d_in[8]; a.sconv_b = (const float*)d_in[9]; a.dt_bias = (const float*)d_in[10]; a.a_log = (const float*)d_in[11]; a.ssd_d = (const float*)d_in[12]; a.ssd_ng = (const float*)d_in[13];
    a.qng = (const float*)d_in[14]; a.w_uq = (const float*)d_in[15]; a.kvng = (const float*)d_in[16]; a.w_ukv = (const float*)d_in[17]; a.sinks = (const float*)d_in[18]; a.w_out = (const float*)d_in[19];
    a.w_up = (const float*)d_in[20]; a.fconv_w = (const float*)d_in[21]; a.fconv_b = (const float*)d_in[22]; a.w_dn = (const float*)d_in[23]; a.fng = (const float*)d_in[24];
    a.out = (float*)d_out; a.ws = (unsigned char*)d_ws;
#if MK_PER_PHASE
    for (int ph = 0; ph < N_PHASES; ++ph) { a.ph_lo = ph; a.ph_hi = ph + 1; hipLaunchKernelGGL(fwd_kernel, dim3(grid), dim3(512), LDS_BYTES, stream, a); }
#else
    a.ph_lo = 0; a.ph_hi = N_PHASES;
    void* args[] = {&a};
    hipError_t e = hipLaunchCooperativeKernel((const void*)fwd_kernel, dim3(grid), dim3(512), args, LDS_BYTES, stream);
    if (e != hipSuccess) fprintf(stderr, "cooperative launch failed: %s (grid %d)\n", hipGetErrorString(e), grid);
#endif
}
```

```cpp
#include <hip/hip_runtime.h>
#include <hip/hip_cooperative_groups.h>
#include <cstdio>
#include <cstdint>
namespace cg = cooperative_groups;

#define LAS __attribute__((address_space(3)))
typedef unsigned short bf16_t;
typedef short bf16x8 __attribute__((ext_vector_type(8)));
typedef float f32x4 __attribute__((ext_vector_type(4)));
typedef float f32x2 __attribute__((ext_vector_type(2)));
typedef unsigned u32x4 __attribute__((ext_vector_type(4)));
typedef unsigned u32x2 __attribute__((ext_vector_type(2)));

#ifndef PROBE_MASK
#define PROBE_MASK 0
#endif
#define RUN(bit, call) do { call; if (PROBE_MASK & (bit)) { call; } } while (0)
#ifndef MK_PER_PHASE
#define MK_PER_PHASE 0
#endif

constexpr int D = 1024, NB = 8, SEQ = 4096, M = NB * SEQ, DEPTH = 4, DFF = 2816, DIN = 2472, NPROJ = 2560;
constexpr float EPS = 1e-6f;
constexpr int PC_Z = 0, PC_X = 512, PC_CQ = 1536, PC_CKV = 1792, PC_KR = 1920, PC_SQ = 1952, PC_SK = 2208, PC_SV = 2336, PC_DT = 2464;
constexpr float LOG2E = 1.4426950408889634f;
constexpr float RSQ_SCALE = 16777216.f;
constexpr float MLA_QSCALE = 0.10206207261596577f * LOG2E;
constexpr float SWA_QSCALE = 0.125f * LOG2E;

constexpr size_t MiB = 1u << 20;
constexpr size_t WS_MOD = 1 * MiB;
constexpr size_t WS_ROPE = 2 * MiB;
constexpr size_t WS_W = 6 * MiB;
constexpr size_t WO_IN = 0, WO_OUT = 5 * MiB, WO_UP = 7 * MiB, WO_DN = 18 * MiB, WO_UQ = 23 * MiB + 512 * 1024, WO_UKV = 23 * MiB + 768 * 1024;
constexpr size_t WS_H = 32 * MiB;
constexpr size_t WS_PROJ = 96 * MiB;
constexpr size_t WS_YCAT = 272 * MiB;
constexpr size_t WS_Q = 336 * MiB;
constexpr size_t WS_KV = 360 * MiB;
constexpr size_t WS_KR = 392 * MiB;
constexpr size_t WS_DTRAW = 394 * MiB;
constexpr size_t WS_DTSP = 395 * MiB;
constexpr size_t WS_RS = 396 * MiB;
constexpr size_t WS_YS = 400 * MiB;
constexpr size_t WS_RSQ = 396 * MiB + 256 * 1024;
constexpr size_t WS_BIAS = 397 * MiB;
constexpr size_t WS_W2 = 464 * MiB;
constexpr size_t WS_END = 490 * MiB;

constexpr int LDS_BYTES = 147456;
constexpr int LDS_EXTRA = 131072;

__device__ __forceinline__ unsigned f2bf(float f) { unsigned u = __builtin_bit_cast(unsigned, f); return (u + 0x7fffu + ((u >> 16) & 1u)) >> 16; }
__device__ __forceinline__ unsigned pk2(float lo, float hi) { return f2bf(lo) | (f2bf(hi) << 16); }
__device__ __forceinline__ float bflo(unsigned w) { return __builtin_bit_cast(float, w << 16); }
__device__ __forceinline__ float bfhi(unsigned w) { return __builtin_bit_cast(float, w & 0xffff0000u); }
__device__ __forceinline__ float bf2f(bf16_t h) { return __builtin_bit_cast(float, (unsigned)h << 16); }
__device__ __forceinline__ unsigned cvt_pk_bf16(float lo, float hi) { unsigned r; asm volatile("v_cvt_pk_bf16_f32 %0, %1, %2" : "=v"(r) : "v"(lo), "v"(hi)); return r; }
__device__ __forceinline__ float shx(float v, int o, int lane) { return __builtin_bit_cast(float, __builtin_amdgcn_ds_bpermute((lane ^ o) << 2, __builtin_bit_cast(int, v))); }
__device__ __forceinline__ float wave_sum(float v, int lane) {
#pragma unroll
    for (int o = 1; o < 64; o <<= 1) v += shx(v, o, lane);
    return v;
}
__device__ __forceinline__ int tid_opaque(int wv) { unsigned m = ~0u; asm volatile("" : "+s"(m), "+s"(wv)); int t = (wv << 6) | (int)__builtin_amdgcn_mbcnt_hi(m, __builtin_amdgcn_mbcnt_lo(m, 0u)); asm volatile("" : "+v"(t)); return t; }
__device__ __forceinline__ float silu_f(float v) { return v * __builtin_amdgcn_rcpf(1.f + __builtin_amdgcn_exp2f(v * -1.4426950408889634f)); }

namespace pg8 {
constexpr int BM = 256, BK = 64, HALF = 128, HTB = HALF * BK * 2, STAGE_BYTES = 8 * HTB, NXCD = 8, WGM = 8;
__host__ __device__ __forceinline__ int lds_byte(int r, int c) { const int st = (r >> 4) * 2 + (c >> 5), rr = r & 15, cc = c & 31, ob = rr * 64 + cc * 2; return st * 1024 + (ob ^ (((ob >> 9) & 1) << 5)); }
__host__ __device__ __forceinline__ void stage_rc(int b, int& R, int& C) { const int st = b / 1024, sb = b % 1024, swz = sb ^ (((sb >> 9) & 1) << 5); R = (st >> 1) * 16 + swz / 64; C = (st & 1) * 32 + (swz % 64) / 2; }
__host__ __device__ __forceinline__ int perm32(int rho) { const int n = rho >> 4, i = rho & 15; return 8 * (i >> 2) + 4 * n + (i & 3); }

struct Unit { int pm, pn; };
struct Gemm { const bf16_t* A; const bf16_t* Bt; int K; int lda; int wv; };

struct Order {
    int nM, nN, nwg, G, c, mode;
    __device__ __forceinline__ void init(int nM_, int nN_, int G_, int c_, int mode_) { nM = nM_; nN = nN_; nwg = nM * nN; G = G_; c = c_; mode = mode_; }
    __device__ __forceinline__ bool next(int i, Unit& u) const {
        const long L = (long)i * G + c; if (L >= nwg) return false;
        int wgid = (int)L; { const int q = nwg / NXCD, r = nwg % NXCD, xcd = wgid % NXCD, off = wgid / NXCD; wgid = (xcd < r ? xcd * (q + 1) : r * (q + 1) + (xcd - r) * q) + off; }
        const int nig = WGM * nN, gid = wgid / nig, fm = gid * WGM, gsz = (nM - fm) < WGM ? (nM - fm) : WGM;
        u.pm = fm + ((wgid % nig) % gsz); u.pn = (wgid % nig) / gsz; return true;
    }
    __device__ __forceinline__ long a_row(const Unit& u) const { return mode == 0 ? (long)u.pm * 256 : (long)(u.pm / 17) * 4096 + (long)(u.pm % 17) * 254 - 2; }
};

template <class Epi, class Sched>
__device__ __forceinline__ void gemm_phase(LAS unsigned char* lds, const Gemm g, const Sched& S, const Epi& E) {
    const int tid = tid_opaque(g.wv);
    const int wid = __builtin_amdgcn_readfirstlane(tid >> 6), lane = tid & 63, wr = wid >> 2, wc = wid & 3, fr = lane & 15, fq = lane >> 4;
    const int K = g.K, nt = K / BK, lda = g.lda;
    unsigned voffA[2], voffB[2];
#pragma unroll
    for (int i = 0; i < 2; ++i) { int R, C; stage_rc(tid * 16 + i * 8192, R, C); const int Rb = Epi::PERM ? ((R & ~31) + perm32(R & 31)) : R;
        voffA[i] = (unsigned)(R * lda + C) * 2u; voffB[i] = (unsigned)(Rb * K + C) * 2u; }
    const size_t kstep = (size_t)(BK * 2);
    const size_t hA = (size_t)HALF * lda * 2, hB = (size_t)HALF * K * 2;
    const size_t tB = 2 * hB;
    const unsigned ldsw = (unsigned)wid * 1024u;
    const int aoff = lds_byte(wr * 64 + fr, fq * 8), boff = lds_byte(wc * 32 + fr, fq * 8);
#define PG8_SA(b, h) (((b) * 2 + (h)) * HTB)
#define PG8_SB(b, h) ((4 + (b) * 2 + (h)) * HTB)
#define PG8_STAGE(bufoff, gbase, voff) do { _Pragma("unroll") for (int _i = 0; _i < 2; ++_i) \
        __builtin_amdgcn_global_load_lds((const unsigned*)((const char*)(gbase) + (voff)[_i]), (LAS unsigned*)(lds + (bufoff) + ldsw + _i * 8192), 16, 0, 0); } while (0)
#define PG8_LDA(dst, b, h) do { _Pragma("unroll") for (int m = 0; m < 4; ++m) _Pragma("unroll") for (int k = 0; k < 2; ++k) dst[m][k] = *(const LAS bf16x8*)(lds + PG8_SA(b, h) + aoff + m * 2048 + k * 1024); } while (0)
#define PG8_LDB(dst, b, h) do { _Pragma("unroll") for (int n = 0; n < 2; ++n) _Pragma("unroll") for (int k = 0; k < 2; ++k) dst[n][k] = *(const LAS bf16x8*)(lds + PG8_SB(b, h) + boff + n * 2048 + k * 1024); } while (0)
#define PG8_MMA(ai, bj, At, Bt) do { __builtin_amdgcn_s_setprio(1); _Pragma("unroll") for (int m = 0; m < 4; ++m) _Pragma("unroll") for (int n = 0; n < 2; ++n) _Pragma("unroll") for (int k = 0; k < 2; ++k) \
        acc[ai][bj][m][n] = __builtin_amdgcn_mfma_f32_16x16x32_bf16(Bt[n][k], At[m][k], acc[ai][bj][m][n], 0, 0, 0); __builtin_amdgcn_s_setprio(0); } while (0)
#define PG8_WAIT_V(n) asm volatile("s_waitcnt vmcnt(" #n ")" ::: "memory")
#define PG8_WAIT_L(n) asm volatile("s_waitcnt lgkmcnt(" #n ")" ::: "memory")
#define PG8_BAR __builtin_amdgcn_s_barrier()
#define PG8_SCHED __builtin_amdgcn_sched_barrier(0)
    Unit cur, nxt; int ui = 0;
    if (!S.next(0, cur)) return;
    f32x4 acc[2][2][4][2];
#pragma unroll
    for (int a = 0; a < 2; ++a)
#pragma unroll
        for (int b = 0; b < 2; ++b)
#pragma unroll
            for (int m = 0; m < 4; ++m)
#pragma unroll
                for (int n = 0; n < 2; ++n) acc[a][b][m][n] = (f32x4){0.f, 0.f, 0.f, 0.f};
    bf16x8 At[4][2], B0[2][2], B1[2][2];
    const char* cA = (const char*)g.A + S.a_row(cur) * (long)lda * 2; const char* cB = (const char*)g.Bt + (size_t)cur.pn * tB;
    PG8_STAGE(PG8_SB(0, 0), cB, voffB); PG8_STAGE(PG8_SB(0, 1), cB + hB, voffB); PG8_STAGE(PG8_SA(0, 0), cA, voffA); PG8_STAGE(PG8_SA(0, 1), cA + hA, voffA);
    if (wr == 1) PG8_BAR;
    PG8_WAIT_V(2); PG8_BAR;
    PG8_STAGE(PG8_SB(1, 0), cB + kstep, voffB); PG8_STAGE(PG8_SA(1, 0), cA + kstep, voffA); PG8_STAGE(PG8_SB(1, 1), cB + hB + kstep, voffB);
    PG8_WAIT_V(6); PG8_BAR;
    for (;;) {
        const bool has_next = S.next(ui + 1, nxt);
        const char* nA = has_next ? (const char*)g.A + S.a_row(nxt) * (long)lda * 2 : cA; const char* nB = has_next ? (const char*)g.Bt + (size_t)nxt.pn * tB : cB;
        for (int t = 0; t < nt; t += 2) {
            const bool last = (t == nt - 2);
            const char* a1 = cA + (size_t)(t + 1) * kstep;
            const char* a2 = last ? nA : cA + (size_t)(t + 2) * kstep; const char* b2 = last ? nB : cB + (size_t)(t + 2) * kstep;
            const char* a3 = a2 + kstep; const char* b3 = b2 + kstep;
            PG8_LDB(B0, 0, 0); PG8_LDB(B1, 0, 1); PG8_SCHED; PG8_LDA(At, 0, 0); PG8_STAGE(PG8_SA(1, 1), a1 + hA, voffA);
            PG8_WAIT_V(8); PG8_WAIT_L(0); PG8_BAR; PG8_MMA(0, 0, At, B0); PG8_MMA(0, 1, At, B1); PG8_BAR; PG8_SCHED;
            PG8_LDA(At, 0, 1); PG8_STAGE(PG8_SB(0, 0), b2, voffB); PG8_STAGE(PG8_SB(0, 1), b2 + hB, voffB); PG8_STAGE(PG8_SA(0, 0), a2, voffA);
            PG8_WAIT_V(8); PG8_WAIT_L(0); PG8_BAR; PG8_MMA(1, 0, At, B0); PG8_MMA(1, 1, At, B1); PG8_BAR; PG8_SCHED;
            PG8_LDB(B0, 1, 0); PG8_LDB(B1, 1, 1); PG8_SCHED; PG8_LDA(At, 1, 0); PG8_STAGE(PG8_SA(0, 1), a2 + hA, voffA);
            PG8_WAIT_V(8); PG8_WAIT_L(0); PG8_BAR; PG8_MMA(0, 0, At, B0); PG8_MMA(0, 1, At, B1); PG8_BAR; PG8_SCHED;
            PG8_LDA(At, 1, 1); PG8_STAGE(PG8_SB(1, 0), b3, voffB); PG8_STAGE(PG8_SB(1, 1), b3 + hB, voffB); PG8_STAGE(PG8_SA(1, 0), a3, voffA);
            PG8_WAIT_V(8); PG8_WAIT_L(0); PG8_BAR; PG8_MMA(1, 0, At, B0); PG8_MMA(1, 1, At, B1); PG8_BAR; PG8_SCHED;
        }
        if (wr == 0) PG8_BAR;
        { const int t2 = tid_opaque(g.wv), w2 = __builtin_amdgcn_readfirstlane(t2 >> 6), l2 = t2 & 63;
          E(acc, cur, S, w2 >> 2, w2 & 3, l2 & 15, l2 >> 4, lds, w2, l2); }
        if (!has_next) break;
#pragma unroll
        for (int a = 0; a < 2; ++a)
#pragma unroll
            for (int b = 0; b < 2; ++b)
#pragma unroll
                for (int m = 0; m < 4; ++m)
#pragma unroll
                    for (int n = 0; n < 2; ++n) acc[a][b][m][n] = (f32x4){0.f, 0.f, 0.f, 0.f};
        cur = nxt; cA = nA; cB = nB; ++ui;
        if (wr == 1) PG8_BAR;
    }
    PG8_WAIT_V(0);
    PG8_BAR;
#undef PG8_SA
#undef PG8_SB
#undef PG8_STAGE
#undef PG8_LDA
#undef PG8_LDB
#undef PG8_MMA
#undef PG8_WAIT_V
#undef PG8_WAIT_L
#undef PG8_BAR
#undef PG8_SCHED
}

typedef f32x4 Acc[2][2][4][2];

struct EpiProj {
    static constexpr bool PERM = true;
    bf16_t* O; float* dtraw; const unsigned long long* rowsq; const float* bias;
    __device__ __forceinline__ void operator()(Acc& acc, const Unit& u, const Order&, int wr, int wc, int fr, int fq, LAS unsigned char*, int, int) const {
        const int row0 = u.pm * BM + wr * 64 + fr, col0 = u.pn * BM + wc * 32 + 8 * fq;
        const float* bp = bias + (size_t)((u.pm * BM) / SEQ) * NPROJ + col0;
        f32x4 bv[2][2];
#pragma unroll
        for (int bj = 0; bj < 2; ++bj) { bv[bj][0] = *(const f32x4*)(bp + bj * HALF); bv[bj][1] = *(const f32x4*)(bp + bj * HALF + 4); }
        float r8[2][4];
#pragma unroll
        for (int ai = 0; ai < 2; ++ai)
#pragma unroll
            for (int m = 0; m < 4; ++m) r8[ai][m] = (float)rowsq[row0 + ai * HALF + m * 16] * (1.f / RSQ_SCALE);
#pragma unroll
        for (int ai = 0; ai < 2; ++ai)
#pragma unroll
            for (int m = 0; m < 4; ++m) { const int row = row0 + ai * HALF + m * 16; bf16_t* rowp = O + (size_t)row * NPROJ + col0;
                const float r = __builtin_amdgcn_rsqf(r8[ai][m] * (1.f / D) + EPS);
#pragma unroll
                for (int bj = 0; bj < 2; ++bj) { const f32x4 v0 = acc[ai][bj][m][0] * r + bv[bj][0], v1 = acc[ai][bj][m][1] * r + bv[bj][1];
                    u32x4 w; w.x = cvt_pk_bf16(v0[0], v0[1]); w.y = cvt_pk_bf16(v0[2], v0[3]); w.z = cvt_pk_bf16(v1[0], v1[1]); w.w = cvt_pk_bf16(v1[2], v1[3]);
                    *(u32x4*)(rowp + bj * HALF) = w;
                    if (bj == 1 && col0 + HALF == PC_DT) { *(f32x4*)(dtraw + (size_t)row * 8) = v0; *(f32x4*)(dtraw + (size_t)row * 8 + 4) = v1; } } }
    }
};
struct EpiRes {
    static constexpr bool PERM = false;
    const float* base; float* out; const float* gate;
    bf16_t* hb; const float* ng; const float* sc; unsigned long long* rowsq;
    __device__ __forceinline__ void operator()(Acc& acc, const Unit& u, const Order&, int wr, int wc, int fr, int fq, LAS unsigned char*, int, int lane) const {
        const int row0 = u.pm * BM + wr * 64 + fr, col0 = u.pn * BM + wc * 32 + 4 * fq, b = (u.pm * BM) / SEQ;
        const float* gp = gate + (size_t)b * 6144 + col0;
        f32x4 gv[2][2], gm[2][2];
        {
            f32x4 nv[2][2], sv[2][2];
#pragma unroll
            for (int bj = 0; bj < 2; ++bj)
#pragma unroll
                for (int n = 0; n < 2; ++n) { gv[bj][n] = *(const f32x4*)(gp + bj * HALF + n * 16);
                    nv[bj][n] = *(const f32x4*)(ng + col0 + bj * HALF + n * 16);
                    sv[bj][n] = *(const f32x4*)(sc + (size_t)b * 6144 + col0 + bj * HALF + n * 16); }
#pragma unroll
            for (int bj = 0; bj < 2; ++bj)
#pragma unroll
                for (int n = 0; n < 2; ++n) gm[bj][n] = nv[bj][n] * (sv[bj][n] + 1.f);
        }
        constexpr int EPI_PF = 2;
        f32x4 bsv[8][2][2];
#define RES_LOAD(k) do { const size_t off_ = (size_t)(row0 + ((k) >> 2) * HALF + ((k) & 3) * 16) * D + col0; \
            _Pragma("unroll") for (int bj = 0; bj < 2; ++bj) _Pragma("unroll") for (int n = 0; n < 2; ++n) bsv[k][bj][n] = *(const f32x4*)(base + off_ + bj * HALF + n * 16); } while (0)
#pragma unroll
        for (int k = 0; k < EPI_PF; ++k) RES_LOAD(k);
#pragma unroll
        for (int k = 0; k < 8; ++k) { const int ai = k >> 2, m = k & 3; const int row = row0 + ai * HALF + m * 16; const size_t off = (size_t)row * D + col0; float ss = 0.f;
            f32x4 v[2][2];
#pragma unroll
            for (int bj = 0; bj < 2; ++bj)
#pragma unroll
                for (int n = 0; n < 2; ++n) v[bj][n] = bsv[k][bj][n] + gv[bj][n] * acc[ai][bj][m][n];
            if (k + EPI_PF < 8) RES_LOAD(k + EPI_PF);
#pragma unroll
            for (int bj = 0; bj < 2; ++bj)
#pragma unroll
                for (int n = 0; n < 2; ++n) { const f32x4 vv = v[bj][n];
                    *(f32x4*)(out + off + bj * HALF + n * 16) = vv;
                    if (hb) { ss += (vv.x * vv.x + vv.y * vv.y) + (vv.z * vv.z + vv.w * vv.w); const f32x4 hv = vv * gm[bj][n];
                        u32x2 w; w.x = cvt_pk_bf16(hv.x, hv.y); w.y = cvt_pk_bf16(hv.z, hv.w); *(u32x2*)(hb + off + bj * HALF + n * 16) = w; } }
            if (hb) { ss += shx(ss, 16, lane); ss += shx(ss, 32, lane); if (fq == 0) atomicAdd(rowsq + row, (unsigned long long)(ss * RSQ_SCALE + 0.5f)); }
        }
#undef RES_LOAD
    }
};
struct EpiMla {
    static constexpr bool PERM = true;
    bf16_t* Q; bf16_t* KV; const float* rs; int isq_;
    __device__ __forceinline__ void operator()(Acc& acc, const Unit& u, const Order&, int wr, int wc, int fr, int fq, LAS unsigned char*, int, int) const {
        const bool isq = isq_ != 0;
        const int row0 = u.pm * BM + wr * 64 + fr, col0 = u.pn * BM + wc * 32 + 8 * fq;
        bf16_t* O = isq ? Q : KV; const int ldo = isq ? 384 : 512; const float* rsp = isq ? rs : rs + M; const float scale = isq ? MLA_QSCALE : 1.f;
        float r8[2][4];
#pragma unroll
        for (int ai = 0; ai < 2; ++ai)
#pragma unroll
            for (int m = 0; m < 4; ++m) r8[ai][m] = rsp[row0 + ai * HALF + m * 16];
#pragma unroll
        for (int ai = 0; ai < 2; ++ai)
#pragma unroll
            for (int m = 0; m < 4; ++m) { const int row = row0 + ai * HALF + m * 16; const float r = r8[ai][m] * scale;
#pragma unroll
                for (int bj = 0; bj < 2; ++bj) { const int c8 = col0 + bj * HALF; if (c8 < ldo) { const f32x4 v0 = acc[ai][bj][m][0] * r, v1 = acc[ai][bj][m][1] * r;
                    u32x4 w; w.x = cvt_pk_bf16(v0[0], v0[1]); w.y = cvt_pk_bf16(v0[2], v0[3]); w.z = cvt_pk_bf16(v1[0], v1[1]); w.w = cvt_pk_bf16(v1[2], v1[3]);
                    *(u32x4*)(O + (size_t)row * ldo + c8) = w; } } }
    }
};
#define DPPR(src, ctrl) __builtin_bit_cast(float, __builtin_amdgcn_update_dpp(0, __builtin_bit_cast(int, (float)(src)), (ctrl), 0xf, 0xf, true))
#define DPPF(old, src, ctrl) __builtin_bit_cast(float, __builtin_amdgcn_update_dpp(__builtin_bit_cast(int, (float)(old)), __builtin_bit_cast(int, (float)(src)), (ctrl), 0xf, 0xf, false))
struct EpiUp {
    static constexpr bool PERM = true;
    bf16_t* O; const float* cw; const float* cb;
    const unsigned long long* rowsq; const float* bias;
    __device__ __forceinline__ void operator()(Acc& acc, const Unit& u, const Order&, int wr, int wc, int fr, int fq, LAS unsigned char* lds, int, int) const {
        LAS float* bnd = (LAS float*)(lds + LDS_EXTRA);
        const int cl = wc * 32 + 8 * fq;
        {
            const int bq = u.pm / 17, tq0 = (u.pm % 17) * 254 - 2;
            const float* bp = bias + (size_t)bq * (2 * DFF) + u.pn * BM + cl;
            f32x4 bv[2][2];
#pragma unroll
            for (int bj = 0; bj < 2; ++bj) { bv[bj][0] = *(const f32x4*)(bp + bj * HALF); bv[bj][1] = *(const f32x4*)(bp + bj * HALF + 4); }
#pragma unroll
            for (int ai = 0; ai < 2; ++ai)
#pragma unroll
                for (int m = 0; m < 4; ++m) { int gr = bq * SEQ + tq0 + ai * HALF + wr * 64 + m * 16 + fr; gr = gr < 0 ? 0 : (gr > M - 1 ? M - 1 : gr);
                    const float r = __builtin_amdgcn_rsqf((float)rowsq[gr] * (1.f / RSQ_SCALE) * (1.f / D) + EPS);
#pragma unroll
                    for (int bj = 0; bj < 2; ++bj) { acc[ai][bj][m][0] = acc[ai][bj][m][0] * r + bv[bj][0]; acc[ai][bj][m][1] = acc[ai][bj][m][1] * r + bv[bj][1]; } }
        }
        if (fr >= 14) {
#pragma unroll
            for (int ai = 0; ai < 2; ++ai)
#pragma unroll
                for (int bj = 0; bj < 2; ++bj)
#pragma unroll
                    for (int n = 0; n < 2; ++n) *(LAS f32x4*)(bnd + ((ai * 2 + wr) * 2 + (fr - 14)) * 256 + bj * HALF + cl + 4 * n) = acc[ai][bj][3][n];
        }
        asm volatile("s_waitcnt lgkmcnt(0)" ::: "memory"); __builtin_amdgcn_s_barrier(); asm volatile("" ::: "memory");
        const int b = u.pm / 17, t0 = (u.pm % 17) * 254 - 2;
        const int ch0 = u.pn * HALF + cl;
#pragma unroll
        for (int ai = 0; ai < 2; ++ai) {
        u32x2 stash[4];
#pragma unroll
        for (int n = 0; n < 2; ++n) {
            f32x4 w0[2], w1[2], w2[2], bb[2];
#pragma unroll
            for (int bj = 0; bj < 2; ++bj) { const int cc = bj * DFF + ch0 + 4 * n;
                w0[bj] = *(const f32x4*)(cw + cc); w1[bj] = *(const f32x4*)(cw + 2 * DFF + cc); w2[bj] = *(const f32x4*)(cw + 4 * DFF + cc); bb[bj] = *(const f32x4*)(cb + cc); }
#pragma unroll
                for (int m = 0; m < 4; ++m) {
                    f32x4 uu[2];
#pragma unroll
                    for (int bj = 0; bj < 2; ++bj) {
                        const f32x4 v = acc[ai][bj][m][n];
                        f32x4 pv;
                        if (m > 0) pv = acc[ai][bj][m - 1][n];
                        else if (wr == 1 || ai == 1) { const int src = (wr == 1) ? (ai * 2 + 0) : (0 * 2 + 1); pv = *(const LAS f32x4*)(bnd + (src * 2 + ((fr - 14) & 1)) * 256 + bj * HALF + cl + 4 * n); }
                        else pv = (f32x4){0.f, 0.f, 0.f, 0.f};
                        f32x4 p1, p2;
#pragma unroll
                        for (int j = 0; j < 4; ++j) { const float c1 = (fr == 15) ? pv[j] : v[j], c2 = (fr >= 14) ? pv[j] : v[j];
                            p1[j] = DPPR(c1, 0x121); p2[j] = DPPR(c2, 0x122); }
                        if (ai == 0 && m == 0 && wr == 0 && t0 < 0) { const int tq = t0 + fr; if (tq < 1) p1 = (f32x4){0.f, 0.f, 0.f, 0.f}; if (tq < 2) p2 = (f32x4){0.f, 0.f, 0.f, 0.f}; }
                        uu[bj] = bb[bj] + w2[bj] * v + w1[bj] * p1 + w0[bj] * p2;
                    }
                    const int r = ai * HALF + wr * 64 + m * 16 + fr, t = t0 + r;
                    f32x4 o;
#pragma unroll
                    for (int j = 0; j < 4; ++j) o[j] = silu_f(uu[0][j]) * uu[1][j];
                    if (n == 0) { stash[m].x = cvt_pk_bf16(o[0], o[1]); stash[m].y = cvt_pk_bf16(o[2], o[3]); }
                    else if (r >= 2 && t < SEQ) { u32x4 w; w.x = stash[m].x; w.y = stash[m].y; w.z = cvt_pk_bf16(o[0], o[1]); w.w = cvt_pk_bf16(o[2], o[3]);
                        *(u32x4*)(O + ((size_t)b * SEQ + t) * DFF + ch0) = w; }
                    asm volatile("" ::: "memory");
                }
        }
        }
    }
};
}

struct Args {
    const float* x; const float* c; const int* pos;
    const float* ada_w; const float* ada_b; const float* n1g; const float* n2g; const float* w_in;
    const float* sconv_w; const float* sconv_b; const float* dt_bias; const float* a_log; const float* ssd_d; const float* ssd_ng;
    const float* qng; const float* w_uq; const float* kvng; const float* w_ukv; const float* sinks; const float* w_out;
    const float* w_up; const float* fconv_w; const float* fconv_b; const float* w_dn; const float* fng;
    float* out; unsigned char* ws; int ph_lo, ph_hi, wv, pad2;
};

__device__ __forceinline__ void phase_mod(const Args& a, LAS unsigned char* lds, int G) {
    LAS float* cact = (LAS float*)lds;
    LAS float* red = (LAS float*)(lds + 32768);
    const int tid = tid_opaque(a.wv), lane = tid & 63, wave = __builtin_amdgcn_readfirstlane(tid >> 6);
    for (int i = tid; i < 8 * 1024; i += 512) cact[i] = silu_f(a.c[i]);
    __syncthreads();
    float* mod = (float*)(a.ws + WS_MOD);
    for (int item = blockIdx.x; item < 4 * 96; item += G) {
        const int l = item / 96, col = (item % 96) * 64 + lane;
        const float* W = a.ada_w + (size_t)l * 1024 * 6144 + col;
        float s[8];
#pragma unroll
        for (int b = 0; b < 8; ++b) s[b] = 0.f;
        for (int k0 = wave * 128; k0 < wave * 128 + 128; k0 += 16) { float wv16[16];
#pragma unroll
            for (int q = 0; q < 16; ++q) wv16[q] = W[(size_t)(k0 + q) * 6144];
#pragma unroll
            for (int q = 0; q < 16; ++q)
#pragma unroll
                for (int b = 0; b < 8; ++b) s[b] += cact[b * 1024 + k0 + q] * wv16[q]; }
#pragma unroll
        for (int b = 0; b < 8; ++b) red[(wave * 8 + b) * 64 + lane] = s[b];
        __syncthreads();
        float t = 0.f;
#pragma unroll
        for (int w = 0; w < 8; ++w) t += red[(w * 8 + wave) * 64 + lane];
        mod[((size_t)l * 8 + wave) * 6144 + col] = t + a.ada_b[(size_t)l * 6144 + col];
        __syncthreads();
    }
}
__device__ __forceinline__ void phase_rope(const Args& a, int G) {
    float* rope = (float*)(a.ws + WS_ROPE);
    for (int idx = blockIdx.x * 512 + tid_opaque(a.wv); idx < M * 16; idx += G * 512) {
        const int row = idx >> 4, i = idx & 15;
        float inv = 1.778279402e-04f;
        inv = (i == 14) ? 3.162277571e-04f : inv;
        inv = (i == 13) ? 5.623413017e-04f : inv;
        inv = (i == 12) ? 1.000000047e-03f : inv;
        inv = (i == 11) ? 1.778279431e-03f : inv;
        inv = (i == 10) ? 3.162277630e-03f : inv;
        inv = (i == 9) ? 5.623413250e-03f : inv;
        inv = (i == 8) ? 9.999999776e-03f : inv;
        inv = (i == 7) ? 1.778279431e-02f : inv;
        inv = (i == 6) ? 3.162277490e-02f : inv;
        inv = (i == 5) ? 5.623413250e-02f : inv;
        inv = (i == 4) ? 1.000000015e-01f : inv;
        inv = (i == 3) ? 1.778279394e-01f : inv;
        inv = (i == 2) ? 3.162277639e-01f : inv;
        inv = (i == 1) ? 5.623413324e-01f : inv;
        inv = (i == 0) ? 1.000000000e+00f : inv;
        const float ang = (float)a.pos[row] * inv;
        const double rev = (double)ang * 0.15915494309189535;
        const float fr = (float)(rev - (double)(int)rev);
        rope[(size_t)row * 32 + i] = __builtin_amdgcn_cosf(fr);
        rope[(size_t)row * 32 + 16 + i] = __builtin_amdgcn_sinf(fr);
    }
}
enum { MAP_ID = 0, MAP_IN = 1, MAP_UP = 2, MAP_UQ = 3, MAP_ZERO = 4 };
__device__ __forceinline__ int map_col(int kind, int n) {
    if (kind == MAP_ID) return n;
    if (kind == MAP_ZERO) return -1;
    if (kind == MAP_IN) {
        if (n < 1536) return n;
        if (n < 1920) return n + 8;
        if (n < 1952) { const int e = n - 1920; return 1928 + 16 * (e & 1) + (e >> 1); }
        if (n < 2464) return n + 8;
        if (n < 2472) return n - 2464 + 1536;
        return -1;
    }
    if (kind == MAP_UP) { const int pn = n >> 8, cl = n & 255; return cl < 128 ? pn * 128 + cl : DFF + pn * 128 + (cl - 128); }
    if (n >= 384) return -1;
    { const int h = n / 96, d = n % 96; if (d < 64) return h * 96 + d; const int e = d - 64; return h * 96 + 64 + 16 * (e & 1) + (e >> 1); }
}
__device__ __forceinline__ void tr_item(const float* W, int N, int ks0, bf16_t* WT, int Kd, int kd0, int n0, int kind, const float* ksc, LAS float* scr, int lane) {
    const int src = map_col(kind, n0 + (lane & 31));
    const int srcc = src < 0 ? 0 : src; const float msk = src < 0 ? 0.f : 1.f;
    float vals[32];
#pragma unroll
    for (int i = 0; i < 32; ++i) vals[i] = W[(size_t)(ks0 + 2 * i + (lane >> 5)) * N + srcc];
    if (ksc) {
#pragma unroll
        for (int i = 0; i < 32; ++i) vals[i] *= ksc[ks0 + 2 * i + (lane >> 5)];
    }
#pragma unroll
    for (int i = 0; i < 32; ++i) scr[(2 * i + (lane >> 5)) * 33 + (lane & 31)] = vals[i] * msk;
    asm volatile("s_waitcnt lgkmcnt(0)" ::: "memory");
    const int c = lane & 7;
#pragma unroll
    for (int j = 0; j < 4; ++j) { const int n = (lane >> 3) + 8 * j; const LAS float* s = scr + (8 * c) * 33 + n;
        u32x4 o; o.x = pk2(s[0 * 33], s[1 * 33]); o.y = pk2(s[2 * 33], s[3 * 33]); o.z = pk2(s[4 * 33], s[5 * 33]); o.w = pk2(s[6 * 33], s[7 * 33]);
        *(u32x4*)(WT + (size_t)(n0 + n) * Kd + kd0 + 8 * c) = o; }
    asm volatile("s_waitcnt lgkmcnt(0)" ::: "memory");
}
__device__ __forceinline__ void phase_weights(const Args& a, int l, unsigned char* wb, LAS unsigned char* lds, int G) {
    const int tid_ = tid_opaque(a.wv), lane = tid_ & 63, wave = tid_ >> 6;
    LAS float* scr = (LAS float*)(lds + wave * 16384);
    constexpr int I_IN = 16 * 80, I_OUT = 16 * 32, I_UP = 16 * 176, I_DN = 44 * 32, I_QKV = 4 * 16 + 2 * 16;
    constexpr int NIT = I_IN + I_OUT + I_UP + I_DN + I_QKV;
    for (int it = blockIdx.x * 8 + wave; it < NIT; it += G * 8) {
        int r = it;
        if (r < I_IN) { tr_item(a.w_in + (size_t)l * D * DIN, DIN, 64 * (r / 80), (bf16_t*)(wb + WO_IN), D, 64 * (r / 80), 32 * (r % 80), MAP_IN, nullptr, scr, lane); continue; } r -= I_IN;
        if (r < I_OUT) { tr_item(a.w_out + (size_t)l * D * D, D, 64 * (r / 32), (bf16_t*)(wb + WO_OUT), D, 64 * (r / 32), 32 * (r % 32), MAP_ID, nullptr, scr, lane); continue; } r -= I_OUT;
        if (r < I_UP) { tr_item(a.w_up + (size_t)l * D * 2 * DFF, 2 * DFF, 64 * (r / 176), (bf16_t*)(wb + WO_UP), D, 64 * (r / 176), 32 * (r % 176), MAP_UP, nullptr, scr, lane); continue; } r -= I_UP;
        if (r < I_DN) { tr_item(a.w_dn + (size_t)l * DFF * D, D, 64 * (r / 32), (bf16_t*)(wb + WO_DN), DFF, 64 * (r / 32), 32 * (r % 32), MAP_ID, nullptr, scr, lane); continue; } r -= I_DN;
        { if (r < 4 * 16) tr_item(a.w_uq + (size_t)l * 256 * 384, 384, 64 * (r / 16), (bf16_t*)(wb + WO_UQ), 256, 64 * (r / 16), 32 * (r % 16), MAP_UQ, a.qng + l * 256, scr, lane);
          else { r -= 64; tr_item(a.w_ukv + (size_t)l * 128 * 512, 512, 64 * (r / 16), (bf16_t*)(wb + WO_UKV), 128, 64 * (r / 16), 32 * (r % 16), MAP_ID, a.kvng + l * 128, scr, lane); } }
    }
}

__device__ __forceinline__ void phase_bias(const Args& a, int l, float* bias, LAS unsigned char* lds, int G) {
    LAS float* shv = (LAS float*)lds;
    LAS float* red = (LAS float*)(lds + 65536);
    const int tid = tid_opaque(a.wv), lane = tid & 63, wave = __builtin_amdgcn_readfirstlane(tid >> 6);
    const float* ml = (const float*)(a.ws + WS_MOD) + (size_t)l * 8 * 6144;
    __syncthreads();
    for (int i = tid; i < 2 * 8 * 1024; i += 512) { const int which = i >> 13, b = (i >> 10) & 7, k = i & 1023; shv[i] = ml[(size_t)b * 6144 + (which ? 3072 : 0) + k]; }
    __syncthreads();
    for (int item = blockIdx.x; item < 80 + 176; item += G) {
        const bool up = item >= 80; const int n = (up ? item - 80 : item) * 32 + (lane & 31), N = up ? 2 * DFF : DIN;
        const int src = map_col(up ? MAP_UP : MAP_IN, n);
        const float* W = (up ? a.w_up + (size_t)l * D * 2 * DFF : a.w_in + (size_t)l * D * DIN) + (src < 0 ? 0 : src);
        const LAS float* sv = shv + (up ? 8192 : 0);
        float s8[8];
#pragma unroll
        for (int b = 0; b < 8; ++b) s8[b] = 0.f;
        const int kb = wave * 128 + (lane >> 5) * 64;
        for (int k0 = kb; k0 < kb + 64; k0 += 16) { float wv16[16];
#pragma unroll
            for (int q = 0; q < 16; ++q) wv16[q] = W[(size_t)(k0 + q) * N];
#pragma unroll
            for (int q = 0; q < 16; ++q)
#pragma unroll
                for (int b = 0; b < 8; ++b) s8[b] += sv[b * 1024 + k0 + q] * wv16[q]; }
#pragma unroll
        for (int b = 0; b < 8; ++b) { s8[b] += shx(s8[b], 32, lane); red[(wave * 8 + b) * 64 + lane] = s8[b]; }
        __syncthreads();
        if (lane < 32) { float t = 0.f;
#pragma unroll
            for (int w = 0; w < 8; ++w) t += red[(w * 8 + wave) * 64 + lane];
            (up ? bias + 8 * NPROJ : bias)[(size_t)wave * (up ? 2 * DFF : NPROJ) + n] = src < 0 ? 0.f : t; }
        __syncthreads();
    }
}
__device__ __forceinline__ void phase_norm0(const float* xin, const float* g, const float* sc, bf16_t* hout, unsigned long long* rowsq, int G, int wv) {
    const int tid_ = tid_opaque(wv), lane = tid_ & 63, wave = tid_ >> 6;
    for (int row = blockIdx.x * 8 + wave; row < M; row += G * 8) {
        const int b = row / SEQ;
        const f32x4* xr = (const f32x4*)(xin + (size_t)row * D) + lane;
        f32x4 v[4]; float s = 0.f;
#pragma unroll
        for (int j = 0; j < 4; ++j) { v[j] = xr[64 * j]; s += (v[j].x * v[j].x + v[j].y * v[j].y) + (v[j].z * v[j].z + v[j].w * v[j].w); }
        s = wave_sum(s, lane);
        if (lane == 0) rowsq[row] = (unsigned long long)(s * RSQ_SCALE + 0.5f);
        u32x2* o8 = (u32x2*)(hout + (size_t)row * D) + lane;
#pragma unroll
        for (int j = 0; j < 4; ++j) { const int col = 4 * lane + 256 * j;
            const f32x4 y = v[j] * *(const f32x4*)(g + col) * (*(const f32x4*)(sc + (size_t)b * 6144 + col) + 1.f);
            u32x2 w; w.x = cvt_pk_bf16(y.x, y.y); w.y = cvt_pk_bf16(y.z, y.w); o8[64 * j] = w; }
    }
}
__device__ __forceinline__ void phase_final(float* x, const float* g, int G, int wv) {
    const int tid_ = tid_opaque(wv), lane = tid_ & 63, wave = tid_ >> 6;
    for (int row = blockIdx.x * 8 + wave; row < M; row += G * 8) {
        f32x4* xr = (f32x4*)(x + (size_t)row * D) + lane;
        f32x4 v[4]; float s = 0.f;
#pragma unroll
        for (int j = 0; j < 4; ++j) { v[j] = xr[64 * j]; s += (v[j].x * v[j].x + v[j].y * v[j].y) + (v[j].z * v[j].z + v[j].w * v[j].w); }
        const float r = 1.f / sqrtf(wave_sum(s, lane) * (1.f / D) + EPS);
#pragma unroll
        for (int j = 0; j < 4; ++j) { const f32x4 gg = *(const f32x4*)(g + 4 * lane + 256 * j); xr[64 * j] = v[j] * r * gg; }
    }
}
__device__ __forceinline__ void phase_prep(const Args& a, int l, int G) {
    const int tid_ = tid_opaque(a.wv), lane = tid_ & 63, wave = tid_ >> 6;
    const bf16_t* proj = (const bf16_t*)(a.ws + WS_PROJ);
    bf16_t* xbc = (bf16_t*)(a.ws + WS_H);
    const float* cw = a.sconv_w + (size_t)l * 4 * 1024; const float* cb = a.sconv_b + (size_t)l * 1024;
    const float* dtraw = (const float*)(a.ws + WS_DTRAW); float* dtsp = (float*)(a.ws + WS_DTSP);
    float* rq = (float*)(a.ws + WS_RS); float* rkv = rq + M; unsigned long long* rsq = (unsigned long long*)(a.ws + WS_RSQ);
    const float* rope = (const float*)(a.ws + WS_ROPE); bf16_t* kr = (bf16_t*)(a.ws + WS_KR);
    f32x4 wk[2][4][2], bk[2][2];
#pragma unroll
    for (int j = 0; j < 2; ++j) { const int ch = 8 * lane + 512 * j; bk[j][0] = *(const f32x4*)(cb + ch); bk[j][1] = *(const f32x4*)(cb + ch + 4);
#pragma unroll
        for (int k = 0; k < 4; ++k) { wk[j][k][0] = *(const f32x4*)(cw + k * 1024 + ch); wk[j][k][1] = *(const f32x4*)(cw + k * 1024 + ch + 4); } }
    const float dtb = lane < 8 ? a.dt_bias[l * 8 + lane] : 0.f;
    for (int run = blockIdx.x * 8 + wave; run < M / 16; run += G * 8) {
        const int rowb = run * 16, tb = rowb % SEQ;
        u32x4 win[2][3];
#pragma unroll
        for (int j = 0; j < 2; ++j)
#pragma unroll
            for (int k = 0; k < 3; ++k) { win[j][k] = (u32x4){0u, 0u, 0u, 0u}; if (tb - 3 + k >= 0) win[j][k] = *(const u32x4*)(proj + (size_t)(rowb - 3 + k) * NPROJ + PC_X + 8 * lane + 512 * j); }
        for (int r4 = 0; r4 < 16; r4 += 4) {
            u32x4 curv[4][2], cqv[4]; float dtr[4], rcs[4], rsn[4]; unsigned krv[4];
#pragma unroll
            for (int q = 0; q < 4; ++q) { const size_t row = (size_t)(rowb + r4 + q);
                curv[q][0] = *(const u32x4*)(proj + row * NPROJ + PC_X + 8 * lane); curv[q][1] = *(const u32x4*)(proj + row * NPROJ + PC_X + 8 * lane + 512);
                cqv[q] = (u32x4){0u, 0u, 0u, 0u}; if (lane < 48) cqv[q] = *(const u32x4*)(proj + row * NPROJ + PC_CQ + 8 * lane);
                dtr[q] = lane < 8 ? dtraw[row * 8 + lane] : 0.f;
                krv[q] = 0u; rcs[q] = 0.f; rsn[q] = 0.f;
                if (lane < 16) { krv[q] = *(const unsigned*)(proj + row * NPROJ + PC_KR + 2 * lane); rcs[q] = rope[row * 32 + lane]; rsn[q] = rope[row * 32 + 16 + lane]; } }
#pragma unroll
            for (int q = 0; q < 4; ++q) { const int row = rowb + r4 + q;
#pragma unroll
                for (int j = 0; j < 2; ++j) { const int ch = 8 * lane + 512 * j;
                    const u32x4 cur = curv[q][j];
                    f32x4 a0 = bk[j][0], a1 = bk[j][1];
#pragma unroll
                    for (int k = 0; k < 4; ++k) { const u32x4 pv = k < 3 ? win[j][k] : cur;
                        a0 += wk[j][k][0] * (f32x4){bflo(pv.x), bfhi(pv.x), bflo(pv.y), bfhi(pv.y)}; a1 += wk[j][k][1] * (f32x4){bflo(pv.z), bfhi(pv.z), bflo(pv.w), bfhi(pv.w)}; }
                    win[j][0] = win[j][1]; win[j][1] = win[j][2]; win[j][2] = cur;
                    u32x4 o; o.x = cvt_pk_bf16(silu_f(a0.x), silu_f(a0.y)); o.y = cvt_pk_bf16(silu_f(a0.z), silu_f(a0.w)); o.z = cvt_pk_bf16(silu_f(a1.x), silu_f(a1.y)); o.w = cvt_pk_bf16(silu_f(a1.z), silu_f(a1.w));
                    *(u32x4*)(xbc + (size_t)row * 1024 + ch) = o; }
                if (lane == 0) { rsq[row] = 0ull; rsq[M + row] = 0ull; }
                if (lane < 8) { const float v = dtr[q] + dtb; dtsp[(size_t)row * 8 + lane] = v > 15.f ? v : __logf(1.f + __expf(v)); }
                { const u32x4 pv = cqv[q];
                  const float f0 = bflo(pv.x), f1 = bfhi(pv.x), f2 = bflo(pv.y), f3 = bfhi(pv.y), f4 = bflo(pv.z), f5 = bfhi(pv.z), f6 = bflo(pv.w), f7 = bfhi(pv.w);
                  const float s = (f0 * f0 + f1 * f1) + (f2 * f2 + f3 * f3) + (f4 * f4 + f5 * f5) + (f6 * f6 + f7 * f7);
                  float sq = lane < 32 ? s : 0.f, sk = (lane >= 32 && lane < 48) ? s : 0.f;
                  sq = wave_sum(sq, lane); sk = wave_sum(sk, lane);
                  if (lane == 0) { rq[row] = __builtin_amdgcn_rsqf(sq * (1.f / 256.f) + EPS); rkv[row] = __builtin_amdgcn_rsqf(sk * (1.f / 128.f) + EPS); } }
                if (lane < 16) { const float x1 = bflo(krv[q]), x2 = bfhi(krv[q]);
                    *(unsigned*)(kr + (size_t)row * 32 + 2 * lane) = cvt_pk_bf16(x1 * rcs[q] - x2 * rsn[q], x1 * rsn[q] + x2 * rcs[q]); }
            }
        }
    }
}
__device__ __forceinline__ void phase_ssd_naive(const Args& a, int l, int G) {
    const int tid = tid_opaque(a.wv), pl = tid >> 5, nq = tid & 31, lane = tid & 63;
    const bf16_t* xbc = (const bf16_t*)(a.ws + WS_H);
    const bf16_t* proj = (const bf16_t*)(a.ws + WS_PROJ);
    const float* dtsp = (const float*)(a.ws + WS_DTSP);
    float* ytmp = (float*)(a.ws + WS_YS);
    for (int unit = blockIdx.x; unit < 256; unit += G) {
        const int b = unit >> 5, h = (unit >> 2) & 7, pq = unit & 3, g = h >> 2, p = pq * 16 + pl;
        const float av = -__expf(a.a_log[l * 8 + h]), dsk = a.ssd_d[l * 8 + h];
        float s0 = 0.f, s1 = 0.f, s2 = 0.f, s3 = 0.f;
        for (int t = 0; t < SEQ; ++t) {
            const size_t row = (size_t)b * SEQ + t;
            const float dt = dtsp[row * 8 + h];
            const float x = bf2f(xbc[row * 1024 + h * 64 + p]);
            const u32x2 bv = *(const u32x2*)(xbc + row * 1024 + 512 + g * 128 + 4 * nq);
            const u32x2 cv = *(const u32x2*)(xbc + row * 1024 + 768 + g * 128 + 4 * nq);
            const float dA = __expf(dt * av), xd = dt * x;
            s0 = s0 * dA + xd * bflo(bv.x); s1 = s1 * dA + xd * bfhi(bv.x); s2 = s2 * dA + xd * bflo(bv.y); s3 = s3 * dA + xd * bfhi(bv.y);
            float y = (s0 * bflo(cv.x) + s1 * bfhi(cv.x)) + (s2 * bflo(cv.y) + s3 * bfhi(cv.y));
            y += shx(y, 16, lane); y += shx(y, 8, lane); y += shx(y, 4, lane); y += shx(y, 2, lane); y += shx(y, 1, lane);
            if (nq == 0) { const float z = bf2f(proj[row * NPROJ + PC_Z + h * 64 + p]); ytmp[row * 512 + h * 64 + p] = (y + dsk * x) * silu_f(z); }
        }
    }
}
__device__ __forceinline__ void phase_ssd_norm(const Args& a, int l, int G) {
    const int tid_ = tid_opaque(a.wv), lane = tid_ & 63, wave = tid_ >> 6;
    const float* ytmp = (const float*)(a.ws + WS_YS); bf16_t* ycat = (bf16_t*)(a.ws + WS_YCAT);
    const float* ng = a.ssd_ng + l * 512;
    for (int row = blockIdx.x * 8 + wave; row < M; row += G * 8) {
        const f32x4 v0 = *(const f32x4*)(ytmp + (size_t)row * 512 + 8 * lane), v1 = *(const f32x4*)(ytmp + (size_t)row * 512 + 8 * lane + 4);
        float s = (v0.x * v0.x + v0.y * v0.y) + (v0.z * v0.z + v0.w * v0.w) + (v1.x * v1.x + v1.y * v1.y) + (v1.z * v1.z + v1.w * v1.w);
        s += shx(s, 16, lane); s += shx(s, 8, lane); s += shx(s, 4, lane); s += shx(s, 2, lane); s += shx(s, 1, lane);
        const float r = 1.f / sqrtf(s * (1.f / 256.f) + EPS);
        const f32x4 g0 = *(const f32x4*)(ng + 8 * lane), g1 = *(const f32x4*)(ng + 8 * lane + 4);
        u32x4 o; o.x = cvt_pk_bf16(v0.x * r * g0.x, v0.y * r * g0.y); o.y = cvt_pk_bf16(v0.z * r * g0.z, v0.w * r * g0.w); o.z = cvt_pk_bf16(v1.x * r * g1.x, v1.y * r * g1.y); o.w = cvt_pk_bf16(v1.z * r * g1.z, v1.w * r * g1.w);
        *(u32x4*)(ycat + (size_t)row * 1024 + 8 * lane) = o;
    }
}

constexpr size_t WS_CDEC = 399 * MiB;
__device__ __forceinline__ void phase_ssd_states(const Args& a, int l, int G) {
    const int tid = tid_opaque(a.wv), p = tid >> 3, no = tid & 7;
    const bf16_t* xbc = (const bf16_t*)(a.ws + WS_H); const float* dtsp = (const float*)(a.ws + WS_DTSP);
    float* states = (float*)(a.ws + WS_YS); float* cdec = (float*)(a.ws + WS_CDEC);
    for (int u = blockIdx.x; u < 2048; u += G) {
        const int b = u >> 8, c = (u >> 3) & 31, h = u & 7, g = h >> 2;
        const float av = -__expf(a.a_log[l * 8 + h]);
        float st[16];
#pragma unroll
        for (int j = 0; j < 16; ++j) st[j] = 0.f;
        float asum = 0.f;
        const size_t row0 = (size_t)b * SEQ + c * 128;
#pragma unroll 2
        for (int s2 = 0; s2 < 128; ++s2) { const size_t row = row0 + s2;
            const float dt = dtsp[row * 8 + h], da = dt * av, dA = __expf(da), xd = dt * bf2f(xbc[row * 1024 + h * 64 + p]);
            const u32x4 b0 = *(const u32x4*)(xbc + row * 1024 + 512 + g * 128 + 16 * no), b1 = *(const u32x4*)(xbc + row * 1024 + 512 + g * 128 + 16 * no + 8);
            asum += da;
            st[0] = st[0] * dA + xd * bflo(b0.x); st[1] = st[1] * dA + xd * bfhi(b0.x); st[2] = st[2] * dA + xd * bflo(b0.y); st[3] = st[3] * dA + xd * bfhi(b0.y);
            st[4] = st[4] * dA + xd * bflo(b0.z); st[5] = st[5] * dA + xd * bfhi(b0.z); st[6] = st[6] * dA + xd * bflo(b0.w); st[7] = st[7] * dA + xd * bfhi(b0.w);
            st[8] = st[8] * dA + xd * bflo(b1.x); st[9] = st[9] * dA + xd * bfhi(b1.x); st[10] = st[10] * dA + xd * bflo(b1.y); st[11] = st[11] * dA + xd * bfhi(b1.y);
            st[12] = st[12] * dA + xd * bflo(b1.z); st[13] = st[13] * dA + xd * bfhi(b1.z); st[14] = st[14] * dA + xd * bflo(b1.w); st[15] = st[15] * dA + xd * bfhi(b1.w); }
        float* sp = states + (size_t)u * 8192 + p * 128 + 16 * no;
#pragma unroll
        for (int j = 0; j < 4; ++j) *(f32x4*)(sp + 4 * j) = (f32x4){st[4 * j], st[4 * j + 1], st[4 * j + 2], st[4 * j + 3]};
        if (tid == 0) cdec[u] = __expf(asum);
    }
}
__device__ __forceinline__ void phase_ssd_scan(const Args& a, int G) {
    bf16_t* states = (bf16_t*)(a.ws + WS_YS); const float* cdec = (const float*)(a.ws + WS_CDEC);
    for (int e = blockIdx.x * 512 + tid_opaque(a.wv); e < 8 * 8 * 2048; e += G * 512) {
        const int b = e >> 14, h = (e >> 11) & 7, pn = e & 2047;
        f32x4 hc = (f32x4){0.f, 0.f, 0.f, 0.f};
#pragma unroll 8
        for (int c = 0; c < 32; ++c) { const int u = (b * 32 + c) * 8 + h; u32x2* sp = (u32x2*)(states + (size_t)u * 8192) + pn;
            const u32x2 v = *sp; u32x2 w; w.x = cvt_pk_bf16(hc.x, hc.y); w.y = cvt_pk_bf16(hc.z, hc.w); *sp = w;
            hc = hc * cdec[u] + (f32x4){bflo(v.x), bfhi(v.x), bflo(v.y), bfhi(v.y)}; }
    }
}
__device__ __forceinline__ void phase_ssd_out(const Args& a, int l, LAS unsigned char* lds, int G) {
    const int tid = tid_opaque(a.wv), p = tid >> 3, no = tid & 7, lane = tid & 63, wave = tid >> 6;
    const bf16_t* xbc = (const bf16_t*)(a.ws + WS_H); const bf16_t* proj = (const bf16_t*)(a.ws + WS_PROJ); const float* dtsp = (const float*)(a.ws + WS_DTSP);
    const float* states = (const float*)(a.ws + WS_YS); bf16_t* ycat = (bf16_t*)(a.ws + WS_YCAT);
    LAS float* yb = (LAS float*)lds;
    for (int u = blockIdx.x; u < 512; u += G) {
        const int b = u >> 6, c = (u >> 1) & 31, g = u & 1;
        const size_t row0 = (size_t)b * SEQ + c * 128;
        for (int hg = 0; hg < 4; ++hg) { const int h = g * 4 + hg;
            const float av = -__expf(a.a_log[l * 8 + h]), dsk = a.ssd_d[l * 8 + h];
            float st[16];
            { const float* sp = states + (size_t)((b * 32 + c) * 8 + h) * 8192 + p * 128 + 16 * no;
#pragma unroll
              for (int j = 0; j < 4; ++j) { const f32x4 v = *(const f32x4*)(sp + 4 * j); st[4 * j] = v.x; st[4 * j + 1] = v.y; st[4 * j + 2] = v.z; st[4 * j + 3] = v.w; } }
#pragma unroll 2
            for (int s2 = 0; s2 < 128; ++s2) { const size_t row = row0 + s2;
                const float dt = dtsp[row * 8 + h], dA = __expf(dt * av), x = bf2f(xbc[row * 1024 + h * 64 + p]), xd = dt * x;
                const bf16_t* bp = xbc + row * 1024 + 512 + g * 128 + 16 * no;
                const u32x4 b0 = *(const u32x4*)bp, b1 = *(const u32x4*)(bp + 8), c0 = *(const u32x4*)(bp + 256), c1 = *(const u32x4*)(bp + 264);
                st[0] = st[0] * dA + xd * bflo(b0.x); st[1] = st[1] * dA + xd * bfhi(b0.x); st[2] = st[2] * dA + xd * bflo(b0.y); st[3] = st[3] * dA + xd * bfhi(b0.y);
                st[4] = st[4] * dA + xd * bflo(b0.z); st[5] = st[5] * dA + xd * bfhi(b0.z); st[6] = st[6] * dA + xd * bflo(b0.w); st[7] = st[7] * dA + xd * bfhi(b0.w);
                st[8] = st[8] * dA + xd * bflo(b1.x); st[9] = st[9] * dA + xd * bfhi(b1.x); st[10] = st[10] * dA + xd * bflo(b1.y); st[11] = st[11] * dA + xd * bfhi(b1.y);
                st[12] = st[12] * dA + xd * bflo(b1.z); st[13] = st[13] * dA + xd * bfhi(b1.z); st[14] = st[14] * dA + xd * bflo(b1.w); st[15] = st[15] * dA + xd * bfhi(b1.w);
                float y = ((st[0] * bflo(c0.x) + st[1] * bfhi(c0.x)) + (st[2] * bflo(c0.y) + st[3] * bfhi(c0.y))) + ((st[4] * bflo(c0.z) + st[5] * bfhi(c0.z)) + (st[6] * bflo(c0.w) + st[7] * bfhi(c0.w)))
                        + ((st[8] * bflo(c1.x) + st[9] * bfhi(c1.x)) + (st[10] * bflo(c1.y) + st[11] * bfhi(c1.y))) + ((st[12] * bflo(c1.z) + st[13] * bfhi(c1.z)) + (st[14] * bflo(c1.w) + st[15] * bfhi(c1.w)));
                y += shx(y, 4, lane); y += shx(y, 2, lane); y += shx(y, 1, lane);
                if (no == 0) { const float z = bf2f(proj[row * NPROJ + PC_Z + h * 64 + p]); yb[s2 * 256 + hg * 64 + p] = (y + dsk * x) * silu_f(z); }
            }
        }
        __syncthreads();
        const float* ng = a.ssd_ng + l * 512 + g * 256;
        const f32x4 gg = *(const f32x4*)(ng + 4 * lane);
        for (int tk = wave; tk < 128; tk += 8) {
            const f32x4 v = *(const LAS f32x4*)(yb + tk * 256 + 4 * lane);
            const float sq = wave_sum((v.x * v.x + v.y * v.y) + (v.z * v.z + v.w * v.w), lane);
            const float r = 1.f / sqrtf(sq * (1.f / 256.f) + EPS);
            u32x2 w; w.x = cvt_pk_bf16(v.x * r * gg.x, v.y * r * gg.y); w.y = cvt_pk_bf16(v.z * r * gg.z, v.w * r * gg.w);
            *(u32x2*)(ycat + (row0 + tk) * 1024 + g * 256 + 4 * lane) = w;
        }
        __syncthreads();
    }
}

__device__ __forceinline__ void phase_mla_naive(const Args& a, int G) {
    const int tid_ = tid_opaque(a.wv), lane = tid_ & 63, wave = tid_ >> 6;
    const bf16_t* qb = (const bf16_t*)(a.ws + WS_Q); const bf16_t* kv = (const bf16_t*)(a.ws + WS_KV); const bf16_t* kr = (const bf16_t*)(a.ws + WS_KR);
    bf16_t* ycat = (bf16_t*)(a.ws + WS_YCAT);
    for (int blk = blockIdx.x; blk < 256; blk += G) {
        const int bh = blk >> 3, s = blk & 7, b = bh >> 2, h = bh & 3;
        const int c = (wave & 1) ? (16 * (wave >> 1) + 15 - s) : (16 * (wave >> 1) + s);
        const int t = c * 64 + lane; const size_t row = (size_t)b * SEQ + t;
        u32x4 qw[12];
#pragma unroll
        for (int i = 0; i < 12; ++i) qw[i] = *(const u32x4*)(qb + row * 384 + h * 96 + 8 * i);
        { const float* rp = (const float*)(a.ws + WS_ROPE) + row * 32;
#pragma unroll
          for (int i = 0; i < 4; ++i) { const f32x4 cs = *(const f32x4*)(rp + 4 * i), sn = *(const f32x4*)(rp + 16 + 4 * i); u32x4 w = qw[8 + i];
              w.x = cvt_pk_bf16(bflo(w.x) * cs.x - bfhi(w.x) * sn.x, bflo(w.x) * sn.x + bfhi(w.x) * cs.x); w.y = cvt_pk_bf16(bflo(w.y) * cs.y - bfhi(w.y) * sn.y, bflo(w.y) * sn.y + bfhi(w.y) * cs.y);
              w.z = cvt_pk_bf16(bflo(w.z) * cs.z - bfhi(w.z) * sn.z, bflo(w.z) * sn.z + bfhi(w.z) * cs.z); w.w = cvt_pk_bf16(bflo(w.w) * cs.w - bfhi(w.w) * sn.w, bflo(w.w) * sn.w + bfhi(w.w) * cs.w);
              qw[8 + i] = w; } }
        float o[64];
#pragma unroll
        for (int i = 0; i < 64; ++i) o[i] = 0.f;
        float mx = -1e30f, ls = 0.f;
        const int jend = c * 64 + 63;
        for (int j = 0; j <= jend; ++j) {
            const size_t rj = (size_t)b * SEQ + j;
            const bf16_t* kp = kv + rj * 512 + h * 128; const bf16_t* krp = kr + rj * 32;
            float sc = 0.f;
#pragma unroll
            for (int i = 0; i < 8; ++i) { const u32x4 w = *(const u32x4*)(kp + 8 * i); const u32x4 qq = qw[i];
                sc += bflo(qq.x) * bflo(w.x) + bfhi(qq.x) * bfhi(w.x) + bflo(qq.y) * bflo(w.y) + bfhi(qq.y) * bfhi(w.y) + bflo(qq.z) * bflo(w.z) + bfhi(qq.z) * bfhi(w.z) + bflo(qq.w) * bflo(w.w) + bfhi(qq.w) * bfhi(w.w); }
#pragma unroll
            for (int i = 0; i < 4; ++i) { const u32x4 w = *(const u32x4*)(krp + 8 * i); const u32x4 qq = qw[8 + i];
                sc += bflo(qq.x) * bflo(w.x) + bfhi(qq.x) * bfhi(w.x) + bflo(qq.y) * bflo(w.y) + bfhi(qq.y) * bfhi(w.y) + bflo(qq.z) * bflo(w.z) + bfhi(qq.z) * bfhi(w.z) + bflo(qq.w) * bflo(w.w) + bfhi(qq.w) * bfhi(w.w); }
            if (j <= t) {
                const float mn = fmaxf(mx, sc), f = exp2f(mx - mn), p = exp2f(sc - mn);
                ls = ls * f + p; mx = mn;
#pragma unroll
                for (int i = 0; i < 8; ++i) { const u32x4 w = *(const u32x4*)(kp + 64 + 8 * i);
                    o[8 * i] = o[8 * i] * f + p * bflo(w.x); o[8 * i + 1] = o[8 * i + 1] * f + p * bfhi(w.x); o[8 * i + 2] = o[8 * i + 2] * f + p * bflo(w.y); o[8 * i + 3] = o[8 * i + 3] * f + p * bfhi(w.y);
                    o[8 * i + 4] = o[8 * i + 4] * f + p * bflo(w.z); o[8 * i + 5] = o[8 * i + 5] * f + p * bfhi(w.z); o[8 * i + 6] = o[8 * i + 6] * f + p * bflo(w.w); o[8 * i + 7] = o[8 * i + 7] * f + p * bfhi(w.w); }
            }
        }
        const float il = 1.f / ls;
#pragma unroll
        for (int i = 0; i < 8; ++i) { u32x4 w; w.x = cvt_pk_bf16(o[8 * i] * il, o[8 * i + 1] * il); w.y = cvt_pk_bf16(o[8 * i + 2] * il, o[8 * i + 3] * il); w.z = cvt_pk_bf16(o[8 * i + 4] * il, o[8 * i + 5] * il); w.w = cvt_pk_bf16(o[8 * i + 6] * il, o[8 * i + 7] * il);
            *(u32x4*)(ycat + row * 1024 + 512 + h * 64 + 8 * i) = w; }
    }
}
__device__ __forceinline__ void phase_swa_naive(const Args& a, int l, int G) {
    const int tid_ = tid_opaque(a.wv), lane = tid_ & 63, wave = tid_ >> 6;
    const bf16_t* proj = (const bf16_t*)(a.ws + WS_PROJ); bf16_t* ycat = (bf16_t*)(a.ws + WS_YCAT);
    for (int blk = blockIdx.x; blk < 256; blk += G) {
        const int bh = blk >> 3, b = bh >> 2, h = bh & 3, c = (blk & 7) * 8 + wave, hk = h >> 1;
        const int t = c * 64 + lane; const size_t row = (size_t)b * SEQ + t;
        u32x4 qw[8];
#pragma unroll
        for (int i = 0; i < 8; ++i) qw[i] = *(const u32x4*)(proj + row * NPROJ + PC_SQ + h * 64 + 8 * i);
        float o[64];
#pragma unroll
        for (int i = 0; i < 64; ++i) o[i] = 0.f;
        float mx = a.sinks[l * 4 + h] * LOG2E, ls = 1.f;
        const int j0 = (c * 64 - 127) > 0 ? (c * 64 - 127) : 0, jend = c * 64 + 63;
        for (int j = j0; j <= jend; ++j) {
            const size_t rj = (size_t)b * SEQ + j;
            const bf16_t* kp = proj + rj * NPROJ + PC_SK + hk * 64; const bf16_t* vp = proj + rj * NPROJ + PC_SV + hk * 64;
            float sc = 0.f;
#pragma unroll
            for (int i = 0; i < 8; ++i) { const u32x4 w = *(const u32x4*)(kp + 8 * i); const u32x4 qq = qw[i];
                sc += bflo(qq.x) * bflo(w.x) + bfhi(qq.x) * bfhi(w.x) + bflo(qq.y) * bflo(w.y) + bfhi(qq.y) * bfhi(w.y) + bflo(qq.z) * bflo(w.z) + bfhi(qq.z) * bfhi(w.z) + bflo(qq.w) * bflo(w.w) + bfhi(qq.w) * bfhi(w.w); }
            sc *= SWA_QSCALE;
            if (j <= t && t - j < 128) {
                const float mn = fmaxf(mx, sc), f = exp2f(mx - mn), p = exp2f(sc - mn);
                ls = ls * f + p; mx = mn;
#pragma unroll
                for (int i = 0; i < 8; ++i) { const u32x4 w = *(const u32x4*)(vp + 8 * i);
                    o[8 * i] = o[8 * i] * f + p * bflo(w.x); o[8 * i + 1] = o[8 * i + 1] * f + p * bfhi(w.x); o[8 * i + 2] = o[8 * i + 2] * f + p * bflo(w.y); o[8 * i + 3] = o[8 * i + 3] * f + p * bfhi(w.y);
                    o[8 * i + 4] = o[8 * i + 4] * f + p * bflo(w.z); o[8 * i + 5] = o[8 * i + 5] * f + p * bfhi(w.z); o[8 * i + 6] = o[8 * i + 6] * f + p * bflo(w.w); o[8 * i + 7] = o[8 * i + 7] * f + p * bfhi(w.w); }
            }
        }
        const float il = 1.f / ls;
#pragma unroll
        for (int i = 0; i < 8; ++i) { u32x4 w; w.x = cvt_pk_bf16(o[8 * i] * il, o[8 * i + 1] * il); w.y = cvt_pk_bf16(o[8 * i + 2] * il, o[8 * i + 3] * il); w.z = cvt_pk_bf16(o[8 * i + 4] * il, o[8 * i + 5] * il); w.w = cvt_pk_bf16(o[8 * i + 6] * il, o[8 * i + 7] * il);
            *(u32x4*)(ycat + row * 1024 + 768 + h * 64 + 8 * i) = w; }
    }
}


typedef float f32x16 __attribute__((ext_vector_type(16)));
typedef short s16x4 __attribute__((ext_vector_type(4)));
__device__ __forceinline__ s16x4 lds_tr16(LAS unsigned char* p) { return __builtin_bit_cast(s16x4, __builtin_amdgcn_ds_read_tr16_b64_v4i16((LAS s16x4*)p)); }
template <bool MLA>
__device__ __forceinline__ void attn_unit(const Args& a, int l, LAS unsigned char* lds, int b, int hd, int qb) {
    constexpr int KS = MLA ? 6 : 4, KROW = MLA ? 208 : 144, KBUF = 128 * KROW, VBUF = 16384, VOFF = 2 * KBUF;
    const int tid = tid_opaque(a.wv), lane = tid & 63, wave = __builtin_amdgcn_readfirstlane(tid >> 6), r = lane & 31, h = lane >> 5;
    const bf16_t* proj = (const bf16_t*)(a.ws + WS_PROJ);
    const bf16_t* Kp; const bf16_t* Vp; int ldk;
    if (MLA) { Kp = (const bf16_t*)(a.ws + WS_KV) + (size_t)b * SEQ * 512 + hd * 128; Vp = Kp + 64; ldk = 512; }
    else { Kp = proj + (size_t)b * SEQ * NPROJ + PC_SK + (hd >> 1) * 64; Vp = proj + (size_t)b * SEQ * NPROJ + PC_SV + (hd >> 1) * 64; ldk = NPROJ; }
    const bf16_t* Krp = (const bf16_t*)(a.ws + WS_KR) + (size_t)b * SEQ * 32;
    const int q0 = qb * 256, Q0 = q0 + wave * 32, qpos = Q0 + r;
    const size_t qrow = (size_t)b * SEQ + qpos;
    bf16x8 qr[KS];
    {
        u32x4 qw[KS]; f32x4 rcs[2], rsn[2];
        const bf16_t* qp = MLA ? (const bf16_t*)(a.ws + WS_Q) + qrow * 384 + hd * 96 + 8 * h : proj + qrow * NPROJ + PC_SQ + hd * 64 + 8 * h;
#pragma unroll
        for (int ks = 0; ks < KS; ++ks) qw[ks] = *(const u32x4*)(qp + 16 * ks);
        if (MLA) {
#pragma unroll
            for (int k2 = 0; k2 < 2; ++k2) { const float* rp = (const float*)(a.ws + WS_ROPE) + qrow * 32 + 8 * k2 + 4 * h; rcs[k2] = *(const f32x4*)rp; rsn[k2] = *(const f32x4*)(rp + 16); }
        }
#pragma unroll
        for (int ks = 0; ks < KS; ++ks) { u32x4 w = qw[ks];
            if (MLA) { if (ks >= 4) { const f32x4 cs = rcs[ks - 4 < 0 ? 0 : ks - 4], sn = rsn[ks - 4 < 0 ? 0 : ks - 4];
                w.x = cvt_pk_bf16(bflo(w.x) * cs.x - bfhi(w.x) * sn.x, bflo(w.x) * sn.x + bfhi(w.x) * cs.x); w.y = cvt_pk_bf16(bflo(w.y) * cs.y - bfhi(w.y) * sn.y, bflo(w.y) * sn.y + bfhi(w.y) * cs.y);
                w.z = cvt_pk_bf16(bflo(w.z) * cs.z - bfhi(w.z) * sn.z, bflo(w.z) * sn.z + bfhi(w.z) * cs.z); w.w = cvt_pk_bf16(bflo(w.w) * cs.w - bfhi(w.w) * sn.w, bflo(w.w) * sn.w + bfhi(w.w) * cs.w); } }
            else {
                w.x = cvt_pk_bf16(bflo(w.x) * SWA_QSCALE, bfhi(w.x) * SWA_QSCALE); w.y = cvt_pk_bf16(bflo(w.y) * SWA_QSCALE, bfhi(w.y) * SWA_QSCALE);
                w.z = cvt_pk_bf16(bflo(w.z) * SWA_QSCALE, bfhi(w.z) * SWA_QSCALE); w.w = cvt_pk_bf16(bflo(w.w) * SWA_QSCALE, bfhi(w.w) * SWA_QSCALE); }
            qr[ks] = __builtin_bit_cast(bf16x8, w); }
    }
    const int T_lo = MLA ? 0 : (qb == 0 ? 0 : 2 * qb - 1), T_hi = 2 * qb + 1;
    const int skey = tid >> 3, sch = tid & 7, rkey = tid >> 2, rch = tid & 3;
    u32x4 kreg[2], vreg[2], k2reg[2];
    auto gload = [&](int T) {
#pragma unroll
        for (int sub = 0; sub < 2; ++sub) { const int t = 2 * T + sub;
            kreg[sub] = *(const u32x4*)(Kp + (size_t)(64 * t + skey) * ldk + 8 * sch);
            vreg[sub] = *(const u32x4*)(Vp + (size_t)(64 * t + skey) * ldk + 8 * sch);
            if (MLA && tid < 256) k2reg[sub] = *(const u32x4*)(Krp + (size_t)(64 * t + rkey) * 32 + 8 * rch); }
    };
    auto lstore = [&](int buf) {
#pragma unroll
        for (int sub = 0; sub < 2; ++sub) {
            *(LAS u32x4*)(lds + buf * KBUF + (64 * sub + skey) * KROW + 16 * sch) = kreg[sub];
            *(LAS u32x4*)(lds + VOFF + buf * VBUF + sub * 8192 + (sch >> 2) * 4096 + skey * 64 + (sch & 3) * 16) = vreg[sub];
            if (MLA && tid < 256) *(LAS u32x4*)(lds + buf * KBUF + (64 * sub + rkey) * KROW + 128 + 16 * rch) = k2reg[sub]; }
    };
    f32x16 o0, o1;
#pragma unroll
    for (int i = 0; i < 16; ++i) { o0[i] = 0.f; o1[i] = 0.f; }
    float mx = MLA ? 0.f : a.sinks[l * 4 + hd] * LOG2E, ls = (MLA || h == 1) ? 0.f : 1.f;
    f32x16 negm;
#pragma unroll
    for (int i = 0; i < 16; ++i) negm[i] = -mx;
    gload(T_lo); lstore(0);
    __syncthreads();
    const int trb = (4 * h + ((lane & 15) >> 2)) * 64 + ((lane >> 4) & 1) * 32 + (lane & 3) * 8;
    for (int T = T_lo; T <= T_hi; ++T) {
        const int buf = (T - T_lo) & 1;
        if (T < T_hi) gload(T + 1);
#pragma unroll
        for (int sub = 0; sub < 2; ++sub) {
        const int t = 2 * T + sub;
        const bool active = (64 * t <= Q0 + 31) && (MLA || 64 * t + 63 >= Q0 - 127);
        if (active) {
            LAS unsigned char* Kb = lds + buf * KBUF + (64 * sub + r) * KROW + 16 * h;
            f32x16 p0 = negm, p1 = negm;
#pragma unroll
            for (int ks = 0; ks < KS; ++ks) {
                const bf16x8 k0 = *(const LAS bf16x8*)(Kb + 32 * ks), k1 = *(const LAS bf16x8*)(Kb + 32 * KROW + 32 * ks);
                p0 = __builtin_amdgcn_mfma_f32_32x32x16_bf16(k0, qr[ks], p0, 0, 0, 0);
                p1 = __builtin_amdgcn_mfma_f32_32x32x16_bf16(k1, qr[ks], p1, 0, 0, 0);
            }
            const bool need_mask = (64 * t + 63 > Q0) || (!MLA && 64 * t < Q0 + 31 - 127);
            if (need_mask) {
#pragma unroll
                for (int i = 0; i < 16; ++i) { const int kp = 64 * t + (i & 3) + 8 * (i >> 2) + 4 * h;
                    if (kp > qpos || (!MLA && qpos - kp >= 128)) p0[i] = -1e30f;
                    if (kp + 32 > qpos || (!MLA && qpos - kp - 32 >= 128)) p1[i] = -1e30f; } }
            float mt = fmaxf(p0[0], p1[0]);
#pragma unroll
            for (int i = 1; i < 16; ++i) mt = fmaxf(mt, fmaxf(p0[i], p1[i]));
            const bool first = MLA && (t == 0);
            if (first || __builtin_amdgcn_ballot_w64(mt > 8.f) != 0ull) {
                mt = fmaxf(mt, shx(mt, 32, lane));
                const float dl = first ? mt : fmaxf(mt, 0.f), f = first ? 1.f : __builtin_amdgcn_exp2f(-dl);
                mx += dl; ls *= f;
#pragma unroll
                for (int i = 0; i < 16; ++i) { p0[i] -= dl; p1[i] -= dl; o0[i] *= f; o1[i] *= f; negm[i] = -mx; }
            }
            float sum = 0.f;
#pragma unroll
            for (int i = 0; i < 16; ++i) { p0[i] = __builtin_amdgcn_exp2f(p0[i]); p1[i] = __builtin_amdgcn_exp2f(p1[i]); sum += p0[i] + p1[i]; }
            ls += sum;
            bf16x8 pw[2][2];
#pragma unroll
            for (int s2 = 0; s2 < 2; ++s2) {
                u32x4 w0, w1;
                w0.x = cvt_pk_bf16(p0[8 * s2], p0[8 * s2 + 1]); w0.y = cvt_pk_bf16(p0[8 * s2 + 2], p0[8 * s2 + 3]); w0.z = cvt_pk_bf16(p0[8 * s2 + 4], p0[8 * s2 + 5]); w0.w = cvt_pk_bf16(p0[8 * s2 + 6], p0[8 * s2 + 7]);
                w1.x = cvt_pk_bf16(p1[8 * s2], p1[8 * s2 + 1]); w1.y = cvt_pk_bf16(p1[8 * s2 + 2], p1[8 * s2 + 3]); w1.z = cvt_pk_bf16(p1[8 * s2 + 4], p1[8 * s2 + 5]); w1.w = cvt_pk_bf16(p1[8 * s2 + 6], p1[8 * s2 + 7]);
                pw[0][s2] = __builtin_bit_cast(bf16x8, w0); pw[1][s2] = __builtin_bit_cast(bf16x8, w1);
            }
            LAS unsigned char* Vb = lds + VOFF + buf * VBUF + sub * 8192 + trb;
#pragma unroll
            for (int kb = 0; kb < 2; ++kb)
#pragma unroll
                for (int s2 = 0; s2 < 2; ++s2) {
                    const int ko = (32 * kb + 16 * s2) * 64;
                    const s16x4 a0l = lds_tr16(Vb + ko), a0h = lds_tr16(Vb + ko + 512), a1l = lds_tr16(Vb + 4096 + ko), a1h = lds_tr16(Vb + 4096 + ko + 512);
                    const bf16x8 A0 = {a0l[0], a0l[1], a0l[2], a0l[3], a0h[0], a0h[1], a0h[2], a0h[3]}, A1 = {a1l[0], a1l[1], a1l[2], a1l[3], a1h[0], a1h[1], a1h[2], a1h[3]};
                    o0 = __builtin_amdgcn_mfma_f32_32x32x16_bf16(A0, pw[kb][s2], o0, 0, 0, 0);
                    o1 = __builtin_amdgcn_mfma_f32_32x32x16_bf16(A1, pw[kb][s2], o1, 0, 0, 0);
                }
        }
        }
        if (T < T_hi) lstore(buf ^ 1);
        __syncthreads();
    }
    ls += shx(ls, 32, lane);
    const float il = 1.f / ls;
    bf16_t* op = (bf16_t*)(a.ws + WS_YCAT) + qrow * 1024 + (MLA ? 512 : 768) + hd * 64 + 4 * h;
#pragma unroll
    for (int g4 = 0; g4 < 4; ++g4) {
        u32x2 w; w.x = cvt_pk_bf16(o0[4 * g4] * il, o0[4 * g4 + 1] * il); w.y = cvt_pk_bf16(o0[4 * g4 + 2] * il, o0[4 * g4 + 3] * il); *(u32x2*)(op + 8 * g4) = w;
        w.x = cvt_pk_bf16(o1[4 * g4] * il, o1[4 * g4 + 1] * il); w.y = cvt_pk_bf16(o1[4 * g4 + 2] * il, o1[4 * g4 + 3] * il); *(u32x2*)(op + 32 + 8 * g4) = w;
    }
}
__device__ __forceinline__ int xcd_vid(int blk, int G) { return (G % 8 == 0) ? (blk % 8) * (G / 8) + blk / 8 : blk; }
__device__ __forceinline__ void phase_mla(const Args& a, int l, LAS unsigned char* lds, int G) {
    for (int v0 = blockIdx.x; v0 < 256; v0 += G) { const int v = (G == 256) ? xcd_vid(v0, G) : v0; const int bh = v >> 3, s = v & 7;
        attn_unit<true>(a, l, lds, bh >> 2, bh & 3, s); attn_unit<true>(a, l, lds, bh >> 2, bh & 3, 15 - s); }
}
__device__ __forceinline__ void phase_swa(const Args& a, int l, LAS unsigned char* lds, int G) {
    for (int v0 = blockIdx.x; v0 < 512; v0 += G) { const int v = (G == 256) ? 2 * xcd_vid(v0 & 255, G) + (v0 >> 8) : v0; const int bh = v >> 4; attn_unit<false>(a, l, lds, bh >> 2, bh & 3, v & 15); }
}
__device__ __forceinline__ int crow16(int i, int h2) { return (i & 3) + 8 * (i >> 2) + 4 * h2; }
__device__ __forceinline__ void ssd_tables(const Args& a, int l, LAS float* dts, LAS float* acs, size_t row0, int g, int tid) {
    const int hg = tid >> 7, s = tid & 127, h = 4 * g + hg;
    const float av = -__expf(a.a_log[l * 8 + h]);
    const float dt = ((const float*)(a.ws + WS_DTSP))[(row0 + s) * 8 + h];
    dts[hg * 128 + s] = dt;
    const int lane = tid & 63;
    float v = dt * av;
#pragma unroll
    for (int d = 1; d < 64; d <<= 1) { const float o = __builtin_bit_cast(float, __builtin_amdgcn_ds_bpermute(((lane - d) & 63) << 2, __builtin_bit_cast(int, v))); v += (lane >= d) ? o : 0.f; }
    if ((tid & 127) == 63) acs[hg * 128] = v;
    __syncthreads();
    const float add = (tid & 64) ? acs[hg * 128] : 0.f;
    __syncthreads();
    acs[hg * 128 + s] = v + add;
    __syncthreads();
}
template <bool SCALED>
__device__ __forceinline__ void ssd_stage_x(const bf16_t* xbc, size_t row0, int g, LAS unsigned char* Xi, const LAS float* dts, const LAS float* acs, int tid) {
    u32x4 vv[8];
#pragma unroll
    for (int i = 0; i < 8; ++i) { const int ch = tid + 512 * i, hg = ch >> 10, s = (ch >> 3) & 127, c8 = ch & 7;
        vv[i] = *(const u32x4*)(xbc + (row0 + s) * 1024 + (4 * g + hg) * 64 + 8 * c8); }
#pragma unroll
    for (int i = 0; i < 8; ++i) { const int ch = tid + 512 * i, hg = ch >> 10, s = (ch >> 3) & 127, c8 = ch & 7;
        u32x4 v = vv[i];
        if (SCALED) { const float w = dts[hg * 128 + s] * __expf(acs[hg * 128 + 127] - acs[hg * 128 + s]);
            v.x = cvt_pk_bf16(bflo(v.x) * w, bfhi(v.x) * w); v.y = cvt_pk_bf16(bflo(v.y) * w, bfhi(v.y) * w); v.z = cvt_pk_bf16(bflo(v.z) * w, bfhi(v.z) * w); v.w = cvt_pk_bf16(bflo(v.w) * w, bfhi(v.w) * w); }
        *(LAS u32x4*)(Xi + hg * 16384 + (c8 >> 2) * 8192 + s * 64 + (c8 & 3) * 16) = v; }
}
__device__ __forceinline__ bf16x8 tr_frag(LAS unsigned char* p, int hi_off) {
    const s16x4 lo = lds_tr16(p), hi = lds_tr16(p + hi_off);
    return (bf16x8){lo[0], lo[1], lo[2], lo[3], hi[0], hi[1], hi[2], hi[3]};
}
__device__ __forceinline__ void phase_ssd_states_mfma(const Args& a, int l, LAS unsigned char* lds, int G) {
    const int tid = tid_opaque(a.wv), lane = tid & 63, wave = __builtin_amdgcn_readfirstlane(tid >> 6), r = lane & 31, h2 = lane >> 5;
    const bf16_t* xbc = (const bf16_t*)(a.ws + WS_H);
    bf16_t* states = (bf16_t*)(a.ws + WS_YS); float* cdec = (float*)(a.ws + WS_CDEC);
    LAS unsigned char* Bi = lds; LAS unsigned char* Xi = lds + 32768; LAS float* dts = (LAS float*)(lds + 98304); LAS float* acs = dts + 512;
    const int trb2 = (8 * h2 + ((lane & 15) >> 2)) * 64 + ((lane >> 4) & 1) * 32 + (lane & 3) * 8;
    for (int u = blockIdx.x; u < 512; u += G) {
        const int b = u >> 6, c = (u >> 1) & 31, g = u & 1; const size_t row0 = (size_t)b * SEQ + c * 128;
        ssd_tables(a, l, dts, acs, row0, g, tid);
#pragma unroll
        for (int i = 0; i < 4; ++i) { const int ch = tid + 512 * i, s = ch >> 4, c16 = ch & 15;
            *(LAS u32x4*)(Bi + (c16 >> 2) * 8192 + s * 64 + (c16 & 3) * 16) = *(const u32x4*)(xbc + (row0 + s) * 1024 + 512 + g * 128 + 8 * c16); }
        ssd_stage_x<true>(xbc, row0, g, Xi, dts, acs, tid);
        __syncthreads();
        const int hg = wave >> 1, nbh = wave & 1;
        f32x16 d00, d01, d10, d11;
#pragma unroll
        for (int i = 0; i < 16; ++i) { d00[i] = 0.f; d01[i] = 0.f; d10[i] = 0.f; d11[i] = 0.f; }
        LAS unsigned char* xa = Xi + hg * 16384 + trb2; LAS unsigned char* ba = Bi + (2 * nbh) * 8192 + trb2;
#pragma unroll
        for (int ks = 0; ks < 8; ++ks) {
            const bf16x8 A0 = tr_frag(xa + ks * 1024, 256), A1 = tr_frag(xa + 8192 + ks * 1024, 256), B0 = tr_frag(ba + ks * 1024, 256), B1 = tr_frag(ba + 8192 + ks * 1024, 256);
            d00 = __builtin_amdgcn_mfma_f32_32x32x16_bf16(B0, A0, d00, 0, 0, 0); d01 = __builtin_amdgcn_mfma_f32_32x32x16_bf16(B0, A1, d01, 0, 0, 0);
            d10 = __builtin_amdgcn_mfma_f32_32x32x16_bf16(B1, A0, d10, 0, 0, 0); d11 = __builtin_amdgcn_mfma_f32_32x32x16_bf16(B1, A1, d11, 0, 0, 0);
        }
        asm volatile("s_nop 15\n\ts_nop 7" : "+v"(d00), "+v"(d01), "+v"(d10), "+v"(d11));
        bf16_t* sp = states + (size_t)((b * 32 + c) * 8 + 4 * g + hg) * 8192 + (size_t)r * 128 + 64 * nbh + 4 * h2;
#pragma unroll
        for (int g4 = 0; g4 < 4; ++g4) { u32x2 w;
            w.x = cvt_pk_bf16(d00[4 * g4], d00[4 * g4 + 1]); w.y = cvt_pk_bf16(d00[4 * g4 + 2], d00[4 * g4 + 3]); *(u32x2*)(sp + 8 * g4) = w;
            w.x = cvt_pk_bf16(d01[4 * g4], d01[4 * g4 + 1]); w.y = cvt_pk_bf16(d01[4 * g4 + 2], d01[4 * g4 + 3]); *(u32x2*)(sp + 32 * 128 + 8 * g4) = w;
            w.x = cvt_pk_bf16(d10[4 * g4], d10[4 * g4 + 1]); w.y = cvt_pk_bf16(d10[4 * g4 + 2], d10[4 * g4 + 3]); *(u32x2*)(sp + 32 + 8 * g4) = w;
            w.x = cvt_pk_bf16(d11[4 * g4], d11[4 * g4 + 1]); w.y = cvt_pk_bf16(d11[4 * g4 + 2], d11[4 * g4 + 3]); *(u32x2*)(sp + 32 * 128 + 32 + 8 * g4) = w; }
        if (tid < 4) cdec[(b * 32 + c) * 8 + 4 * g + tid] = __expf(acs[tid * 128 + 127]);
        __syncthreads();
    }
}
__device__ __forceinline__ void phase_ssd_out_mfma(const Args& a, int l, LAS unsigned char* lds, int G) {
    constexpr int RW = 272;
    const int tid = tid_opaque(a.wv), lane = tid & 63, wave = __builtin_amdgcn_readfirstlane(tid >> 6), r = lane & 31, h2 = lane >> 5;
    const bf16_t* xbc = (const bf16_t*)(a.ws + WS_H); const bf16_t* proj = (const bf16_t*)(a.ws + WS_PROJ);
    const bf16_t* states = (const bf16_t*)(a.ws + WS_YS); bf16_t* ycat = (bf16_t*)(a.ws + WS_YCAT);
    LAS unsigned char* Cr = lds; LAS unsigned char* Br = lds + 34816; LAS unsigned char* Xi = lds + 69632;
    LAS float* dts = (LAS float*)(lds + 135168); LAS float* acs = dts + 512; LAS float* sq = dts + 1024;
    const int trb = (4 * h2 + ((lane & 15) >> 2)) * 64 + ((lane >> 4) & 1) * 32 + (lane & 3) * 8;
    for (int u = blockIdx.x; u < 512; u += G) {
        const int b = u >> 6, c = (u >> 1) & 31, g = u & 1; const size_t row0 = (size_t)b * SEQ + c * 128;
        const int hg = wave >> 1, lh = wave & 1, h = 4 * g + hg;
        const float dsk = a.ssd_d[l * 8 + h];
        bf16x8 hf[2][8];
        { const bf16_t* hp = states + (size_t)((b * 32 + c) * 8 + h) * 8192 + (size_t)r * 128 + 8 * h2;
#pragma unroll
          for (int pb = 0; pb < 2; ++pb)
#pragma unroll
              for (int ks = 0; ks < 8; ++ks) hf[pb][ks] = *(const bf16x8*)(hp + pb * 4096 + 16 * ks); }
        ssd_tables(a, l, dts, acs, row0, g, tid);
#pragma unroll
        for (int i = 0; i < 4; ++i) { const int ch = tid + 512 * i, s = ch >> 4, c16 = ch & 15; const bf16_t* src = xbc + (row0 + s) * 1024 + 512 + g * 128 + 8 * c16;
            *(LAS u32x4*)(Br + s * RW + 16 * c16) = *(const u32x4*)src; *(LAS u32x4*)(Cr + s * RW + 16 * c16) = *(const u32x4*)(src + 256); }
        ssd_stage_x<false>(xbc, row0, g, Xi, dts, acs, tid);
        __syncthreads();
        f32x16 yv[2][2];
#pragma unroll
        for (int lb = 0; lb < 2; ++lb) {
            const int Lb = lb == 0 ? lh : 3 - lh, L0 = 32 * Lb, lq = L0 + r;
            bf16x8 cf[8];
#pragma unroll
            for (int ks = 0; ks < 8; ++ks) cf[ks] = *(const LAS bf16x8*)(Cr + lq * RW + 32 * ks + 16 * h2);
            f32x16 o0, o1;
#pragma unroll
            for (int i = 0; i < 16; ++i) { o0[i] = 0.f; o1[i] = 0.f; }
#pragma unroll
            for (int ks = 0; ks < 8; ++ks) {
                o0 = __builtin_amdgcn_mfma_f32_32x32x16_bf16(hf[0][ks], cf[ks], o0, 0, 0, 0);
                o1 = __builtin_amdgcn_mfma_f32_32x32x16_bf16(hf[1][ks], cf[ks], o1, 0, 0, 0);
            }
            const float Al = acs[hg * 128 + lq], eAl = __expf(Al);
#pragma unroll
            for (int i = 0; i < 16; ++i) { o0[i] *= eAl; o1[i] *= eAl; }
            for (int sb = 0; sb <= Lb; ++sb) {
                f32x16 X;
#pragma unroll
                for (int i = 0; i < 16; ++i) X[i] = 0.f;
#pragma unroll
                for (int ks = 0; ks < 8; ++ks) X = __builtin_amdgcn_mfma_f32_32x32x16_bf16(*(const LAS bf16x8*)(Br + (32 * sb + r) * RW + 32 * ks + 16 * h2), cf[ks], X, 0, 0, 0);
#pragma unroll
                for (int i = 0; i < 16; ++i) { const int s = 32 * sb + crow16(i, h2); X[i] = (s <= lq) ? X[i] * __expf(Al - acs[hg * 128 + s]) * dts[hg * 128 + s] : 0.f; }
                u32x4 w0, w1;
                w0.x = cvt_pk_bf16(X[0], X[1]); w0.y = cvt_pk_bf16(X[2], X[3]); w0.z = cvt_pk_bf16(X[4], X[5]); w0.w = cvt_pk_bf16(X[6], X[7]);
                w1.x = cvt_pk_bf16(X[8], X[9]); w1.y = cvt_pk_bf16(X[10], X[11]); w1.z = cvt_pk_bf16(X[12], X[13]); w1.w = cvt_pk_bf16(X[14], X[15]);
                LAS unsigned char* xa = Xi + hg * 16384 + trb + (32 * sb) * 64;
                o0 = __builtin_amdgcn_mfma_f32_32x32x16_bf16(tr_frag(xa, 512), __builtin_bit_cast(bf16x8, w0), o0, 0, 0, 0);
                o1 = __builtin_amdgcn_mfma_f32_32x32x16_bf16(tr_frag(xa + 8192, 512), __builtin_bit_cast(bf16x8, w0), o1, 0, 0, 0);
                o0 = __builtin_amdgcn_mfma_f32_32x32x16_bf16(tr_frag(xa + 1024, 512), __builtin_bit_cast(bf16x8, w1), o0, 0, 0, 0);
                o1 = __builtin_amdgcn_mfma_f32_32x32x16_bf16(tr_frag(xa + 8192 + 1024, 512), __builtin_bit_cast(bf16x8, w1), o1, 0, 0, 0);
            }
            float ssq = 0.f;
            const bf16_t* zp = proj + (row0 + lq) * NPROJ + PC_Z + h * 64 + 4 * h2;
#pragma unroll
            for (int g4 = 0; g4 < 4; ++g4) {
                const u32x2 x0 = *(const LAS u32x2*)(Xi + hg * 16384 + lq * 64 + (8 * g4 + 4 * h2) * 2), x1 = *(const LAS u32x2*)(Xi + hg * 16384 + 8192 + lq * 64 + (8 * g4 + 4 * h2) * 2);
                const u32x2 z0 = *(const u32x2*)(zp + 8 * g4), z1 = *(const u32x2*)(zp + 32 + 8 * g4);
                float v;
                v = (o0[4 * g4] + dsk * bflo(x0.x)) * silu_f(bflo(z0.x)); o0[4 * g4] = v; ssq += v * v;
                v = (o0[4 * g4 + 1] + dsk * bfhi(x0.x)) * silu_f(bfhi(z0.x)); o0[4 * g4 + 1] = v; ssq += v * v;
                v = (o0[4 * g4 + 2] + dsk * bflo(x0.y)) * silu_f(bflo(z0.y)); o0[4 * g4 + 2] = v; ssq += v * v;
                v = (o0[4 * g4 + 3] + dsk * bfhi(x0.y)) * silu_f(bfhi(z0.y)); o0[4 * g4 + 3] = v; ssq += v * v;
                v = (o1[4 * g4] + dsk * bflo(x1.x)) * silu_f(bflo(z1.x)); o1[4 * g4] = v; ssq += v * v;
                v = (o1[4 * g4 + 1] + dsk * bfhi(x1.x)) * silu_f(bfhi(z1.x)); o1[4 * g4 + 1] = v; ssq += v * v;
                v = (o1[4 * g4 + 2] + dsk * bflo(x1.y)) * silu_f(bflo(z1.y)); o1[4 * g4 + 2] = v; ssq += v * v;
                v = (o1[4 * g4 + 3] + dsk * bfhi(x1.y)) * silu_f(bfhi(z1.y)); o1[4 * g4 + 3] = v; ssq += v * v;
            }
            ssq += shx(ssq, 32, lane);
            if (h2 == 0) sq[lq * 4 + hg] = ssq;
            yv[lb][0] = o0; yv[lb][1] = o1;
        }
        f32x4 ngv[4][2];
        { const float* ngp = a.ssd_ng + l * 512 + g * 256 + hg * 64 + 4 * h2;
#pragma unroll
          for (int g4 = 0; g4 < 4; ++g4)
#pragma unroll
              for (int pb = 0; pb < 2; ++pb) ngv[g4][pb] = *(const f32x4*)(ngp + 32 * pb + 8 * g4); }
        __syncthreads();
#pragma unroll
        for (int lb = 0; lb < 2; ++lb) {
            const int Lb = lb == 0 ? lh : 3 - lh, lq = 32 * Lb + r;
            const f32x4 t4 = *(const LAS f32x4*)(sq + lq * 4);
            const float rinv = __builtin_amdgcn_rsqf(((t4.x + t4.y) + (t4.z + t4.w)) * (1.f / 256.f) + EPS);
            bf16_t* op = ycat + (row0 + lq) * 1024 + g * 256 + hg * 64 + 4 * h2;
#pragma unroll
            for (int g4 = 0; g4 < 4; ++g4)
#pragma unroll
                for (int pb = 0; pb < 2; ++pb) { const f32x4 gg = ngv[g4][pb];
                    u32x2 w; w.x = cvt_pk_bf16(yv[lb][pb][4 * g4] * rinv * gg.x, yv[lb][pb][4 * g4 + 1] * rinv * gg.y); w.y = cvt_pk_bf16(yv[lb][pb][4 * g4 + 2] * rinv * gg.z, yv[lb][pb][4 * g4 + 3] * rinv * gg.w);
                    *(u32x2*)(op + 32 * pb + 8 * g4) = w; }
        }
        __syncthreads();
    }
}


#define XB_TMO      128
#define XB_XCNT(j)  (256  + 64 * (j))
#define XB_XSUB(j)  (1280 + 64 * (j))
#define XB_XGEN(j)  (2304 + 64 * (j))
#define XB_TOP      3328
#define XB_TOPGEN   3392
#define XCD_BAR_WORDS 3456
#define XB_SPIN_CAP (1u << 18)
__device__ __forceinline__ unsigned xb_ld(unsigned* p)              { return __hip_atomic_load(p, __ATOMIC_RELAXED, __HIP_MEMORY_SCOPE_AGENT); }
__device__ __forceinline__ unsigned xb_add(unsigned* p, unsigned v) { return __hip_atomic_fetch_add(p, v, __ATOMIC_RELAXED, __HIP_MEMORY_SCOPE_AGENT); }
__device__ __forceinline__ unsigned xb_xcc_id() { return (unsigned)__builtin_amdgcn_s_getreg((3 << 11) | 20) & 0xFu; }
#define XB_SPIN(cond, bar) do { unsigned _sp = 0; while (cond) { __builtin_amdgcn_s_sleep(1); \
    if ((++_sp & 255u) == 0u) { if (xb_ld(&(bar)[XB_TMO])) break; if (_sp > XB_SPIN_CAP) { atomicAdd(&(bar)[XB_TMO], 1u); break; } } } } while (0)
struct XcdBarrier { unsigned* bar; unsigned x; volatile LAS unsigned* st; };
__device__ __forceinline__ XcdBarrier xcd_barrier_post(unsigned* bar, volatile LAS unsigned* st) {
    XcdBarrier b; b.bar = bar; b.x = xb_xcc_id(); b.st = st;
    if (threadIdx.x == 0) (void)xb_add(&bar[XB_XCNT(b.x)], 1u);
    return b;
}
__device__ __forceinline__ void xcd_barrier_complete(unsigned* bar, unsigned x, unsigned& nloc, unsigned& nx) {
    const unsigned G = gridDim.x * gridDim.y * gridDim.z;
    unsigned sum, cnt, mine, sp = 0u;
    for (;;) {
        sum = 0u; cnt = 0u; mine = 0u;
#pragma unroll
        for (unsigned j = 0; j < 16; ++j) { const unsigned c = xb_ld(&bar[XB_XCNT(j)]); sum += c; cnt += (c > 0u) ? 1u : 0u; mine = (j == x) ? c : mine; }
        if (sum == G) break;
        __builtin_amdgcn_s_sleep(1);
        if ((++sp & 255u) == 0u) { if (xb_ld(&bar[XB_TMO])) break; if (sp > XB_SPIN_CAP) { atomicAdd(&bar[XB_TMO], 1u); break; } }
    }
    nloc = mine > 0u ? mine : 1u; nx = cnt > 0u ? cnt : 1u;
}
__device__ __forceinline__ void xcd_barrier(const XcdBarrier& b) {
    asm volatile("s_waitcnt vmcnt(0)" ::: "memory");
    __syncthreads();
    if (threadIdx.x == 0) {
        unsigned* bar = b.bar;
        __builtin_amdgcn_s_waitcnt(0);
        unsigned nloc = b.st[0], nx = b.st[1];
        if (nloc == 0u) { xcd_barrier_complete(bar, b.x, nloc, nx); b.st[0] = nloc; b.st[1] = nx; }
        const unsigned old = xb_add(&bar[XB_XSUB(b.x)], 1u);
        const unsigned gen = old / nloc;
        if (old + 1u == (gen + 1u) * nloc) {
            __builtin_amdgcn_fence(__ATOMIC_RELEASE, "agent");
            asm volatile("s_waitcnt vmcnt(0)" ::: "memory");
            const unsigned og = xb_add(&bar[XB_TOP], 1u);
            const unsigned tg = og / nx;
            if (og + 1u == (tg + 1u) * nx) xb_add(&bar[XB_TOPGEN], 1u);
            else XB_SPIN(xb_ld(&bar[XB_TOPGEN]) == tg, bar);
            __builtin_amdgcn_fence(__ATOMIC_ACQUIRE, "agent");
            xb_add(&bar[XB_XGEN(b.x)], 1u);
            asm volatile("s_waitcnt vmcnt(0)" ::: "memory");
        } else {
            XB_SPIN(xb_ld(&bar[XB_XGEN(b.x)]) == gen, bar);
            __builtin_amdgcn_fence(__ATOMIC_ACQUIRE, "agent");
            asm volatile("s_waitcnt vmcnt(0)" ::: "memory");
        }
    }
    __syncthreads();
}

constexpr int PH_PER_LAYER = 8, N_PHASES = 2 + DEPTH * PH_PER_LAYER + 1;
__global__ void __launch_bounds__(512, 2) fwd_kernel(Args a0) {
    extern __shared__ __attribute__((aligned(16))) unsigned char lds_raw[];
    LAS unsigned char* lds = (LAS unsigned char*)lds_raw;
    const int G = gridDim.x;
    const int wave_s = __builtin_amdgcn_readfirstlane((int)threadIdx.x >> 6);
#if MK_PER_PHASE
#define SEAM() do {} while (0)
#else
    cg::grid_group grid = cg::this_grid();
    volatile LAS unsigned* bst = (volatile LAS unsigned*)(lds + LDS_BYTES - 64);
    if (threadIdx.x < 2) bst[threadIdx.x] = 0u;
    __syncthreads();
    const XcdBarrier xbar = xcd_barrier_post((unsigned*)a0.ws, bst);
#define SEAM() do { if (ph + 1 < a.ph_hi) { if (ph == 0) grid.sync(); else xcd_barrier(xbar); if (PROBE_MASK & 256) xcd_barrier(xbar); } } while (0)
#endif
    for (int ph = a0.ph_lo; ph < a0.ph_hi; ++ph) {
        unsigned long long wsi_ = (unsigned long long)a0.ws, oi_ = (unsigned long long)a0.out; asm volatile("" : "+s"(wsi_), "+s"(oi_));
        unsigned char* ws = (unsigned char*)(__attribute__((address_space(1))) unsigned char*)wsi_;
        Args a = a0; a.ws = ws; a.wv = wave_s;
        a.out = (float*)(__attribute__((address_space(1))) float*)oi_;
        const float* mod = (const float*)(ws + WS_MOD);
        bf16_t* hbuf = (bf16_t*)(ws + WS_H);
        unsigned long long* rowsq1 = (unsigned long long*)(ws + WS_RSQ); unsigned long long* rowsq2 = rowsq1 + M;
        if (ph == 0) { RUN(16, phase_mod(a, lds, G)); phase_rope(a, G); __syncthreads(); phase_weights(a, 0, ws + WS_W, lds, G); SEAM(); continue; }
        if (ph == 1) { phase_norm0(a.x, a.n1g, mod + 1024, hbuf, rowsq1, G, a.wv); phase_bias(a, 0, (float*)(ws + WS_BIAS), lds, G); SEAM(); continue; }
        if (ph == N_PHASES - 1) { phase_final(a.out, a.fng, G, a.wv); continue; }
        const int l = (ph - 2) / PH_PER_LAYER, sp = (ph - 2) % PH_PER_LAYER;
        const float* ml = mod + (size_t)l * 8 * 6144;
        const float* xcur = (l == 0) ? a.x : a.out;
        const unsigned char* Wb = ws + ((l & 1) ? WS_W2 : WS_W);
        const float* biasb = (const float*)(ws + WS_BIAS + (size_t)(l & 1) * 262144);
        if (sp == 0) {
            pg8::Gemm g{hbuf, (const bf16_t*)(Wb + WO_IN), D, D, a.wv}; pg8::Order S; S.init(M / 256, NPROJ / 256, G, (int)blockIdx.x, 0);
            pg8::EpiProj E{(bf16_t*)(ws + WS_PROJ), (float*)(ws + WS_DTRAW), rowsq1, biasb};
            RUN(32, pg8::gemm_phase(lds, g, S, E));
        } else if (sp == 1) {
            RUN(8, phase_prep(a, l, G));
        } else if (sp == 2) {
            { pg8::Gemm g{(const bf16_t*)(ws + WS_PROJ) + PC_CQ, (const bf16_t*)(Wb + WO_UQ), 256, NPROJ, a.wv}; pg8::Order S; S.init(M / 256, 2, G, (int)blockIdx.x, 0);
              pg8::EpiMla E{(bf16_t*)(ws + WS_Q), (bf16_t*)(ws + WS_KV), (const float*)(ws + WS_RS), 1};
              pg8::gemm_phase(lds, g, S, E); }
            { pg8::Gemm g{(const bf16_t*)(ws + WS_PROJ) + PC_CKV, (const bf16_t*)(Wb + WO_UKV), 128, NPROJ, a.wv}; pg8::Order S; S.init(M / 256, 2, G, (int)blockIdx.x, 0);
              pg8::EpiMla E{(bf16_t*)(ws + WS_Q), (bf16_t*)(ws + WS_KV), (const float*)(ws + WS_RS), 0};
              pg8::gemm_phase(lds, g, S, E); }
            RUN(4, phase_ssd_states_mfma(a, l, lds, G));
            RUN(2, phase_swa(a, l, lds, G));
        } else if (sp == 3) {
            phase_ssd_scan(a, G);
            RUN(2, phase_mla(a, l, lds, G));
            if (l + 1 < DEPTH) { __syncthreads(); RUN(1024, phase_weights(a, l + 1, ws + (((l + 1) & 1) ? WS_W2 : WS_W), lds, G)); RUN(512, phase_bias(a, l + 1, (float*)(ws + WS_BIAS + (size_t)((l + 1) & 1) * 262144), lds, G)); }
        } else if (sp == 4) {
            RUN(2048, phase_ssd_out_mfma(a, l, lds, G));
        } else if (sp == 5) {
            pg8::Gemm g{(const bf16_t*)(ws + WS_YCAT), (const bf16_t*)(Wb + WO_OUT), D, D, a.wv}; pg8::Order S; S.init(M / 256, D / 256, G, (int)blockIdx.x, 0);
            pg8::EpiRes E{xcur, a.out, ml + 2048, hbuf, a.n2g + l * D, ml + 4096, rowsq2};
            pg8::gemm_phase(lds, g, S, E);
        } else if (sp == 6) {
            pg8::Gemm g{hbuf, (const bf16_t*)(Wb + WO_UP), D, D, a.wv}; pg8::Order S; S.init(NB * 17, DFF / 128, G, (int)blockIdx.x, 1);
            pg8::EpiUp E{(bf16_t*)(ws + WS_PROJ), a.fconv_w + (size_t)l * 3 * 2 * DFF, a.fconv_b + (size_t)l * 2 * DFF, rowsq2, biasb + 8 * NPROJ};
            RUN(128, pg8::gemm_phase(lds, g, S, E));
        } else {
            pg8::Gemm g{(const bf16_t*)(ws + WS_PROJ), (const bf16_t*)(Wb + WO_DN), DFF, DFF, a.wv}; pg8::Order S; S.init(M / 256, D / 256, G, (int)blockIdx.x, 0);
            const bool nxt = l + 1 < DEPTH;
            pg8::EpiRes E{a.out, a.out, ml + 5120, nxt ? hbuf : nullptr, a.n1g + (nxt ? l + 1 : l) * D, ml + (nxt ? 8 * 6144 : 0) + 1024, rowsq1};
            pg8::gemm_phase(lds, g, S, E);
        }
        SEAM();
    }
}

extern "C" void kernel_launch(void* const* d_in, const int* in_sizes, int n_in, void* d_out, int out_size, void* d_ws, size_t ws_size, hipStream_t stream) {
    static int grid = 0;
    if (grid == 0) {
        if (n_in != 25 || ws_size < WS_END) { fprintf(stderr, "kernel_launch: unexpected n_in %d / ws %zu\n", n_in, ws_size); grid = -1; return; }
        int dev = 0, cus = 0, per_cu = 0;
        hipGetDevice(&dev); hipDeviceGetAttribute(&cus, hipDeviceAttributeMultiprocessorCount, dev);
        if (hipFuncSetAttribute((const void*)fwd_kernel, hipFuncAttributeMaxDynamicSharedMemorySize, LDS_BYTES) != hipSuccess) { fprintf(stderr, "hipFuncSetAttribute failed\n"); }
        hipOccupancyMaxActiveBlocksPerMultiprocessor(&per_cu, (const void*)fwd_kernel, 512, LDS_BYTES);
        (void)hipGetLastError();
        if (per_cu < 1) { fprintf(stderr, "occupancy query says %d blocks/CU\n", per_cu); per_cu = 1; }
        grid = cus;
    }
    if (grid < 0) return;
    if (hipMemsetAsync(d_ws, 0, 16384, stream) != hipSuccess) { fprintf(stderr, "kernel_launch: memset of the barrier words failed\n"); return; }
    Args a{};
    a.x = (const float*)d_in[0]; a.c = (const float*)d_in[1]; a.pos = (const int*)d_in[2];
    a.ada_w = (const float*)d_in[3]; a.ada_b = (const float*)d_in[4]; a.n1g = (const float*)d_in[5]; a.n2g = (const float*)d_in[6]; a.w_in = (const float*)d_in[7];
    a.sconv_w = (const float*)d_in[8]; a.sconv_b = (const float*)d_in[9]; a.dt_bias = (const float*)d_in[10]; a.a_log = (const float*)d_in[11]; a.ssd_d = (const float*)d_in[12]; a.ssd_ng = (const float*)d_in[13];
    a.qng = (const float*)d_in[14]; a.w_uq = (const float*)d_in[15]; a.kvng = (const float*)d_in[16]; a.w_ukv = (const float*)d_in[17]; a.sinks = (const float*)d_in[18]; a.w_out = (const float*)d_in[19];
    a.w_up = (const float*)d_in[20]; a.fconv_w = (const float*)d_in[21]; a.fconv_b = (const float*)d_in[22]; a.w_dn = (const float*)d_in[23]; a.fng = (const float*)d_in[24];
    a.out = (float*)d_out; a.ws = (unsigned char*)d_ws;
#if MK_PER_PHASE
    for (int ph = 0; ph < N_PHASES; ++ph) { a.ph_lo = ph; a.ph_hi = ph + 1; hipLaunchKernelGGL(fwd_kernel, dim3(grid), dim3(512), LDS_BYTES, stream, a); }
#else
    a.ph_lo = 0; a.ph_hi = N_PHASES;
    void* args[] = {&a};
    hipError_t e = hipLaunchCooperativeKernel((const void*)fwd_kernel, dim3(grid), dim3(512), args, LDS_BYTES, stream);
    if (e != hipSuccess) fprintf(stderr, "cooperative launch failed: %s (grid %d)\n", hipGetErrorString(e), grid);
#endif
}
```

```cpp
#include <hip/hip_runtime.h>
#include <hip/hip_cooperative_groups.h>
#include <cstdio>
#include <cstdint>
namespace cg = cooperative_groups;

#define LAS __attribute__((address_space(3)))
typedef unsigned short bf16_t;
typedef short bf16x8 __attribute__((ext_vector_type(8)));
typedef float f32x4 __attribute__((ext_vector_type(4)));
typedef float f32x2 __attribute__((ext_vector_type(2)));
typedef unsigned u32x4 __attribute__((ext_vector_type(4)));
typedef unsigned u32x2 __attribute__((ext_vector_type(2)));

#ifndef PROBE_MASK
#define PROBE_MASK 0
#endif
#define RUN(bit, call) do { call; if (PROBE_MASK & (bit)) { call; } } while (0)
#ifndef MK_PER_PHASE
#define MK_PER_PHASE 0
#endif

constexpr int D = 1024, NB = 8, SEQ = 4096, M = NB * SEQ, DEPTH = 4, DFF = 2816, DIN = 2472, NPROJ = 2560;
constexpr float EPS = 1e-6f;
constexpr int PC_Z = 0, PC_X = 512, PC_CQ = 1536, PC_CKV = 1792, PC_KR = 1920, PC_SQ = 1952, PC_SK = 2208, PC_SV = 2336, PC_DT = 2464;
constexpr float LOG2E = 1.4426950408889634f;
constexpr float RSQ_SCALE = 16777216.f;
constexpr float MLA_QSCALE = 0.10206207261596577f * LOG2E;
constexpr float SWA_QSCALE = 0.125f * LOG2E;

constexpr size_t MiB = 1u << 20;
constexpr size_t WS_MOD = 1 * MiB;
constexpr size_t WS_ROPE = 2 * MiB;
constexpr size_t WS_W = 6 * MiB;
constexpr size_t WO_IN = 0, WO_OUT = 5 * MiB, WO_UP = 7 * MiB, WO_DN = 18 * MiB, WO_UQ = 23 * MiB + 512 * 1024, WO_UKV = 23 * MiB + 768 * 1024;
constexpr size_t WS_H = 32 * MiB;
constexpr size_t WS_PROJ = 96 * MiB;
constexpr size_t WS_YCAT = 272 * MiB;
constexpr size_t WS_Q = 336 * MiB;
constexpr size_t WS_KV = 360 * MiB;
constexpr size_t WS_KR = 392 * MiB;
constexpr size_t WS_DTRAW = 394 * MiB;
constexpr size_t WS_DTSP = 395 * MiB;
constexpr size_t WS_RS = 396 * MiB;
constexpr size_t WS_YS = 400 * MiB;
constexpr size_t WS_RSQ = 396 * MiB + 256 * 1024;
constexpr size_t WS_BIAS = 397 * MiB;
constexpr size_t WS_W2 = 464 * MiB;
constexpr size_t WS_END = 490 * MiB;

constexpr int LDS_BYTES = 147456;
constexpr int LDS_EXTRA = 131072;

__device__ __forceinline__ unsigned f2bf(float f) { unsigned u = __builtin_bit_cast(unsigned, f); return (u + 0x7fffu + ((u >> 16) & 1u)) >> 16; }
__device__ __forceinline__ unsigned pk2(float lo, float hi) { return f2bf(lo) | (f2bf(hi) << 16); }
__device__ __forceinline__ float bflo(unsigned w) { return __builtin_bit_cast(float, w << 16); }
__device__ __forceinline__ float bfhi(unsigned w) { return __builtin_bit_cast(float, w & 0xffff0000u); }
__device__ __forceinline__ float bf2f(bf16_t h) { return __builtin_bit_cast(float, (unsigned)h << 16); }
__device__ __forceinline__ unsigned cvt_pk_bf16(float lo, float hi) { unsigned r; asm volatile("v_cvt_pk_bf16_f32 %0, %1, %2" : "=v"(r) : "v"(lo), "v"(hi)); return r; }
__device__ __forceinline__ float shx(float v, int o, int lane) { return __builtin_bit_cast(float, __builtin_amdgcn_ds_bpermute((lane ^ o) << 2, __builtin_bit_cast(int, v))); }
__device__ __forceinline__ float wave_sum(float v, int lane) {
#pragma unroll
    for (int o = 1; o < 64; o <<= 1) v += shx(v, o, lane);
    return v;
}
__device__ __forceinline__ int tid_opaque(int wv) { unsigned m = ~0u; asm volatile("" : "+s"(m), "+s"(wv)); int t = (wv << 6) | (int)__builtin_amdgcn_mbcnt_hi(m, __builtin_amdgcn_mbcnt_lo(m, 0u)); asm volatile("" : "+v"(t)); return t; }
__device__ __forceinline__ float silu_f(float v) { return v * __builtin_amdgcn_rcpf(1.f + __builtin_amdgcn_exp2f(v * -1.4426950408889634f)); }

namespace pg8 {
constexpr int BM = 256, BK = 64, HALF = 128, HTB = HALF * BK * 2, STAGE_BYTES = 8 * HTB, NXCD = 8, WGM = 8;
__host__ __device__ __forceinline__ int lds_byte(int r, int c) { const int st = (r >> 4) * 2 + (c >> 5), rr = r & 15, cc = c & 31, ob = rr * 64 + cc * 2; return st * 1024 + (ob ^ (((ob >> 9) & 1) << 5)); }
__host__ __device__ __forceinline__ void stage_rc(int b, int& R, int& C) { const int st = b / 1024, sb = b % 1024, swz = sb ^ (((sb >> 9) & 1) << 5); R = (st >> 1) * 16 + swz / 64; C = (st & 1) * 32 + (swz % 64) / 2; }
__host__ __device__ __forceinline__ int perm32(int rho) { const int n = rho >> 4, i = rho & 15; return 8 * (i >> 2) + 4 * n + (i & 3); }

struct Unit { int pm, pn; };
struct Gemm { const bf16_t* A; const bf16_t* Bt; int K; int lda; int wv; };

struct Order {
    int nM, nN, nwg, G, c, mode;
    __device__ __forceinline__ void init(int nM_, int nN_, int G_, int c_, int mode_) { nM = nM_; nN = nN_; nwg = nM * nN; G = G_; c = c_; mode = mode_; }
    __device__ __forceinline__ bool next(int i, Unit& u) const {
        const long L = (long)i * G + c; if (L >= nwg) return false;
        int wgid = (int)L; { const int q = nwg / NXCD, r = nwg % NXCD, xcd = wgid % NXCD, off = wgid / NXCD; wgid = (xcd < r ? xcd * (q + 1) : r * (q + 1) + (xcd - r) * q) + off; }
        const int nig = WGM * nN, gid = wgid / nig, fm = gid * WGM, gsz = (nM - fm) < WGM ? (nM - fm) : WGM;
        u.pm = fm + ((wgid % nig) % gsz); u.pn = (wgid % nig) / gsz; return true;
    }
    __device__ __forceinline__ long a_row(const Unit& u) const { return mode == 0 ? (long)u.pm * 256 : (long)(u.pm / 17) * 4096 + (long)(u.pm % 17) * 254 - 2; }
};

template <class Epi, class Sched>
__device__ __forceinline__ void gemm_phase(LAS unsigned char* lds, const Gemm g, const Sched& S, const Epi& E) {
    const int tid = tid_opaque(g.wv);
    const int wid = __builtin_amdgcn_readfirstlane(tid >> 6), lane = tid & 63, wr = wid >> 2, wc = wid & 3, fr = lane & 15, fq = lane >> 4;
    const int K = g.K, nt = K / BK, lda = g.lda;
    unsigned voffA[2], voffB[2];
#pragma unroll
    for (int i = 0; i < 2; ++i) { int R, C; stage_rc(tid * 16 + i * 8192, R, C); const int Rb = Epi::PERM ? ((R & ~31) + perm32(R & 31)) : R;
        voffA[i] = (unsigned)(R * lda + C) * 2u; voffB[i] = (unsigned)(Rb * K + C) * 2u; }
    const size_t kstep = (size_t)(BK * 2);
    const size_t hA = (size_t)HALF * lda * 2, hB = (size_t)HALF * K * 2;
    const size_t tB = 2 * hB;
    const unsigned ldsw = (unsigned)wid * 1024u;
    const int aoff = lds_byte(wr * 64 + fr, fq * 8), boff = lds_byte(wc * 32 + fr, fq * 8);
#define PG8_SA(b, h) (((b) * 2 + (h)) * HTB)
#define PG8_SB(b, h) ((4 + (b) * 2 + (h)) * HTB)
#define PG8_STAGE(bufoff, gbase, voff) do { _Pragma("unroll") for (int _i = 0; _i < 2; ++_i) \
        __builtin_amdgcn_global_load_lds((const unsigned*)((const char*)(gbase) + (voff)[_i]), (LAS unsigned*)(lds + (bufoff) + ldsw + _i * 8192), 16, 0, 0); } while (0)
#define PG8_LDA(dst, b, h) do { _Pragma("unroll") for (int m = 0; m < 4; ++m) _Pragma("unroll") for (int k = 0; k < 2; ++k) dst[m][k] = *(const LAS bf16x8*)(lds + PG8_SA(b, h) + aoff + m * 2048 + k * 1024); } while (0)
#define PG8_LDB(dst, b, h) do { _Pragma("unroll") for (int n = 0; n < 2; ++n) _Pragma("unroll") for (int k = 0; k < 2; ++k) dst[n][k] = *(const LAS bf16x8*)(lds + PG8_SB(b, h) + boff + n * 2048 + k * 1024); } while (0)
#define PG8_MMA(ai, bj, At, Bt) do { __builtin_amdgcn_s_setprio(1); _Pragma("unroll") for (int m = 0; m < 4; ++m) _Pragma("unroll") for (int n = 0; n < 2; ++n) _Pragma("unroll") for (int k = 0; k < 2; ++k) \
        acc[ai][bj][m][n] = __builtin_amdgcn_mfma_f32_16x16x32_bf16(Bt[n][k], At[m][k], acc[ai][bj][m][n], 0, 0, 0); __builtin_amdgcn_s_setprio(0); } while (0)
#define PG8_WAIT_V(n) asm volatile("s_waitcnt vmcnt(" #n ")" ::: "memory")
#define PG8_WAIT_L(n) asm volatile("s_waitcnt lgkmcnt(" #n ")" ::: "memory")
#define PG8_BAR __builtin_amdgcn_s_barrier()
#define PG8_SCHED __builtin_amdgcn_sched_barrier(0)
    Unit cur, nxt; int ui = 0;
    if (!S.next(0, cur)) return;
    f32x4 acc[2][2][4][2];
#pragma unroll
    for (int a = 0; a < 2; ++a)
#pragma unroll
        for (int b = 0; b < 2; ++b)
#pragma unroll
            for (int m = 0; m < 4; ++m)
#pragma unroll
                for (int n = 0; n < 2; ++n) acc[a][b][m][n] = (f32x4){0.f, 0.f, 0.f, 0.f};
    bf16x8 At[4][2], B0[2][2], B1[2][2];
    const char* cA = (const char*)g.A + S.a_row(cur) * (long)lda * 2; const char* cB = (const char*)g.Bt + (size_t)cur.pn * tB;
    PG8_STAGE(PG8_SB(0, 0), cB, voffB); PG8_STAGE(PG8_SB(0, 1), cB + hB, voffB); PG8_STAGE(PG8_SA(0, 0), cA, voffA); PG8_STAGE(PG8_SA(0, 1), cA + hA, voffA);
    if (wr == 1) PG8_BAR;
    PG8_WAIT_V(2); PG8_BAR;
    PG8_STAGE(PG8_SB(1, 0), cB + kstep, voffB); PG8_STAGE(PG8_SA(1, 0), cA + kstep, voffA); PG8_STAGE(PG8_SB(1, 1), cB + hB + kstep, voffB);
    PG8_WAIT_V(6); PG8_BAR;
    for (;;) {
        const bool has_next = S.next(ui + 1, nxt);
        const char* nA = has_next ? (const char*)g.A + S.a_row(nxt) * (long)lda * 2 : cA; const char* nB = has_next ? (const char*)g.Bt + (size_t)nxt.pn * tB : cB;
        for (int t = 0; t < nt; t += 2) {
            const bool last = (t == nt - 2);
            const char* a1 = cA + (size_t)(t + 1) * kstep;
            const char* a2 = last ? nA : cA + (size_t)(t + 2) * kstep; const char* b2 = last ? nB : cB + (size_t)(t + 2) * kstep;
            const char* a3 = a2 + kstep; const char* b3 = b2 + kstep;
            PG8_LDB(B0, 0, 0); PG8_LDB(B1, 0, 1); PG8_SCHED; PG8_LDA(At, 0, 0); PG8_STAGE(PG8_SA(1, 1), a1 + hA, voffA);
            PG8_WAIT_V(8); PG8_WAIT_L(0); PG8_BAR; PG8_MMA(0, 0, At, B0); PG8_MMA(0, 1, At, B1); PG8_BAR; PG8_SCHED;
            PG8_LDA(At, 0, 1); PG8_STAGE(PG8_SB(0, 0), b2, voffB); PG8_STAGE(PG8_SB(0, 1), b2 + hB, voffB); PG8_STAGE(PG8_SA(0, 0), a2, voffA);
            PG8_WAIT_V(8); PG8_WAIT_L(0); PG8_BAR; PG8_MMA(1, 0, At, B0); PG8_MMA(1, 1, At, B1); PG8_BAR; PG8_SCHED;
            PG8_LDB(B0, 1, 0); PG8_LDB(B1, 1, 1); PG8_SCHED; PG8_LDA(At, 1, 0); PG8_STAGE(PG8_SA(0, 1), a2 + hA, voffA);
            PG8_WAIT_V(8); PG8_WAIT_L(0); PG8_BAR; PG8_MMA(0, 0, At, B0); PG8_MMA(0, 1, At, B1); PG8_BAR; PG8_SCHED;
            PG8_LDA(At, 1, 1); PG8_STAGE(PG8_SB(1, 0), b3, voffB); PG8_STAGE(PG8_SB(1, 1), b3 + hB, voffB); PG8_STAGE(PG8_SA(1, 0), a3, voffA);
            PG8_WAIT_V(8); PG8_WAIT_L(0); PG8_BAR; PG8_MMA(1, 0, At, B0); PG8_MMA(1, 1, At, B1); PG8_BAR; PG8_SCHED;
        }
        if (wr == 0) PG8_BAR;
        { const int t2 = tid_opaque(g.wv), w2 = __builtin_amdgcn_readfirstlane(t2 >> 6), l2 = t2 & 63;
          E(acc, cur, S, w2 >> 2, w2 & 3, l2 & 15, l2 >> 4, lds, w2, l2); }
        if (!has_next) break;
#pragma unroll
        for (int a = 0; a < 2; ++a)
#pragma unroll
            for (int b = 0; b < 2; ++b)
#pragma unroll
                for (int m = 0; m < 4; ++m)
#pragma unroll
                    for (int n = 0; n < 2; ++n) acc[a][b][m][n] = (f32x4){0.f, 0.f, 0.f, 0.f};
        cur = nxt; cA = nA; cB = nB; ++ui;
        if (wr == 1) PG8_BAR;
    }
    PG8_WAIT_V(0);
    PG8_BAR;
#undef PG8_SA
#undef PG8_SB
#undef PG8_STAGE
#undef PG8_LDA
#undef PG8_LDB
#undef PG8_MMA
#undef PG8_WAIT_V
#undef PG8_WAIT_L
#undef PG8_BAR
#undef PG8_SCHED
}

typedef f32x4 Acc[2][2][4][2];

struct EpiProj {
    static constexpr bool PERM = true;
    bf16_t* O; float* dtraw; const unsigned long long* rowsq; const float* bias;
    __device__ __forceinline__ void operator()(Acc& acc, const Unit& u, const Order&, int wr, int wc, int fr, int fq, LAS unsigned char*, int, int) const {
        const int row0 = u.pm * BM + wr * 64 + fr, col0 = u.pn * BM + wc * 32 + 8 * fq;
        const float* bp = bias + (size_t)((u.pm * BM) / SEQ) * NPROJ + col0;
        f32x4 bv[2][2];
#pragma unroll
        for (int bj = 0; bj < 2; ++bj) { bv[bj][0] = *(const f32x4*)(bp + bj * HALF); bv[bj][1] = *(const f32x4*)(bp + bj * HALF + 4); }
        float r8[2][4];
#pragma unroll
        for (int ai = 0; ai < 2; ++ai)
#pragma unroll
            for (int m = 0; m < 4; ++m) r8[ai][m] = (float)rowsq[row0 + ai * HALF + m * 16] * (1.f / RSQ_SCALE);
#pragma unroll
        for (int ai = 0; ai < 2; ++ai)
#pragma unroll
            for (int m = 0; m < 4; ++m) { const int row = row0 + ai * HALF + m * 16; bf16_t* rowp = O + (size_t)row * NPROJ + col0;
                const float r = __builtin_amdgcn_rsqf(r8[ai][m] * (1.f / D) + EPS);
#pragma unroll
                for (int bj = 0; bj < 2; ++bj) { const f32x4 v0 = acc[ai][bj][m][0] * r + bv[bj][0], v1 = acc[ai][bj][m][1] * r + bv[bj][1];
                    u32x4 w; w.x = cvt_pk_bf16(v0[0], v0[1]); w.y = cvt_pk_bf16(v0[2], v0[3]); w.z = cvt_pk_bf16(v1[0], v1[1]); w.w = cvt_pk_bf16(v1[2], v1[3]);
                    *(u32x4*)(rowp + bj * HALF) = w;
                    if (bj == 1 && col0 + HALF == PC_DT) { *(f32x4*)(dtraw + (size_t)row * 8) = v0; *(f32x4*)(dtraw + (size_t)row * 8 + 4) = v1; } } }
    }
};
struct EpiRes {
    static constexpr bool PERM = false;
    const float* base; float* out; const float* gate;
    bf16_t* hb; const float* ng; const float* sc; unsigned long long* rowsq;
    __device__ __forceinline__ void operator()(Acc& acc, const Unit& u, const Order&, int wr, int wc, int fr, int fq, LAS unsigned char*, int, int lane) const {
        const int row0 = u.pm * BM + wr * 64 + fr, col0 = u.pn * BM + wc * 32 + 4 * fq, b = (u.pm * BM) / SEQ;
        const float* gp = gate + (size_t)b * 6144 + col0;
        f32x4 gv[2][2], gm[2][2];
        {
            f32x4 nv[2][2], sv[2][2];
#pragma unroll
            for (int bj = 0; bj < 2; ++bj)
#pragma unroll
                for (int n = 0; n < 2; ++n) { gv[bj][n] = *(const f32x4*)(gp + bj * HALF + n * 16);
                    nv[bj][n] = *(const f32x4*)(ng + col0 + bj * HALF + n * 16);
                    sv[bj][n] = *(const f32x4*)(sc + (size_t)b * 6144 + col0 + bj * HALF + n * 16); }
#pragma unroll
            for (int bj = 0; bj < 2; ++bj)
#pragma unroll
                for (int n = 0; n < 2; ++n) gm[bj][n] = nv[bj][n] * (sv[bj][n] + 1.f);
        }
        constexpr int EPI_PF = 2;
        f32x4 bsv[8][2][2];
#define RES_LOAD(k) do { const size_t off_ = (size_t)(row0 + ((k) >> 2) * HALF + ((k) & 3) * 16) * D + col0; \
            _Pragma("unroll") for (int bj = 0; bj < 2; ++bj) _Pragma("unroll") for (int n = 0; n < 2; ++n) bsv[k][bj][n] = *(const f32x4*)(base + off_ + bj * HALF + n * 16); } while (0)
#pragma unroll
        for (int k = 0; k < EPI_PF; ++k) RES_LOAD(k);
#pragma unroll
        for (int k = 0; k < 8; ++k) { const int ai = k >> 2, m = k & 3; const int row = row0 + ai * HALF + m * 16; const size_t off = (size_t)row * D + col0; float ss = 0.f;
            f32x4 v[2][2];
#pragma unroll
            for (int bj = 0; bj < 2; ++bj)
#pragma unroll
                for (int n = 0; n < 2; ++n) v[bj][n] = bsv[k][bj][n] + gv[bj][n] * acc[ai][bj][m][n];
            if (k + EPI_PF < 8) RES_LOAD(k + EPI_PF);
#pragma unroll
            for (int bj = 0; bj < 2; ++bj)
#pragma unroll
                for (int n = 0; n < 2; ++n) { const f32x4 vv = v[bj][n];
                    *(f32x4*)(out + off + bj * HALF + n * 16) = vv;
                    if (hb) { ss += (vv.x * vv.x + vv.y * vv.y) + (vv.z * vv.z + vv.w * vv.w); const f32x4 hv = vv * gm[bj][n];
                        u32x2 w; w.x = cvt_pk_bf16(hv.x, hv.y); w.y = cvt_pk_bf16(hv.z, hv.w); *(u32x2*)(hb + off + bj * HALF + n * 16) = w; } }
            if (hb) { ss += shx(ss, 16, lane); ss += shx(ss, 32, lane); if (fq == 0) atomicAdd(rowsq + row, (unsigned long long)(ss * RSQ_SCALE + 0.5f)); }
        }
#undef RES_LOAD
    }
};
struct EpiMla {
    static constexpr bool PERM = true;
    bf16_t* Q; bf16_t* KV; const float* rs; int isq_;
    __device__ __forceinline__ void operator()(Acc& acc, const Unit& u, const Order&, int wr, int wc, int fr, int fq, LAS unsigned char*, int, int) const {
        const bool isq = isq_ != 0;
        const int row0 = u.pm * BM + wr * 64 + fr, col0 = u.pn * BM + wc * 32 + 8 * fq;
        bf16_t* O = isq ? Q : KV; const int ldo = isq ? 384 : 512; const float* rsp = isq ? rs : rs + M; const float scale = isq ? MLA_QSCALE : 1.f;
        float r8[2][4];
#pragma unroll
        for (int ai = 0; ai < 2; ++ai)
#pragma unroll
            for (int m = 0; m < 4; ++m) r8[ai][m] = rsp[row0 + ai * HALF + m * 16];
#pragma unroll
        for (int ai = 0; ai < 2; ++ai)
#pragma unroll
            for (int m = 0; m < 4; ++m) { const int row = row0 + ai * HALF + m * 16; const float r = r8[ai][m] * scale;
#pragma unroll
                for (int bj = 0; bj < 2; ++bj) { const int c8 = col0 + bj * HALF; if (c8 < ldo) { const f32x4 v0 = acc[ai][bj][m][0] * r, v1 = acc[ai][bj][m][1] * r;
                    u32x4 w; w.x = cvt_pk_bf16(v0[0], v0[1]); w.y = cvt_pk_bf16(v0[2], v0[3]); w.z = cvt_pk_bf16(v1[0], v1[1]); w.w = cvt_pk_bf16(v1[2], v1[3]);
                    *(u32x4*)(O + (size_t)row * ldo + c8) = w; } } }
    }
};
#define DPPR(src, ctrl) __builtin_bit_cast(float, __builtin_amdgcn_update_dpp(0, __builtin_bit_cast(int, (float)(src)), (ctrl), 0xf, 0xf, true))
#define DPPF(old, src, ctrl) __builtin_bit_cast(float, __builtin_amdgcn_update_dpp(__builtin_bit_cast(int, (float)(old)), __builtin_bit_cast(int, (float)(src)), (ctrl), 0xf, 0xf, false))
struct EpiUp {
    static constexpr bool PERM = true;
    bf16_t* O; const float* cw; const float* cb;
    const unsigned long long* rowsq; const float* bias;
    __device__ __forceinline__ void operator()(Acc& acc, const Unit& u, const Order&, int wr, int wc, int fr, int fq, LAS unsigned char* lds, int, int) const {
        LAS float* bnd = (LAS float*)(lds + LDS_EXTRA);
        const int cl = wc * 32 + 8 * fq;
        {
            const int bq = u.pm / 17, tq0 = (u.pm % 17) * 254 - 2;
            const float* bp = bias + (size_t)bq * (2 * DFF) + u.pn * BM + cl;
            f32x4 bv[2][2];
#pragma unroll
            for (int bj = 0; bj < 2; ++bj) { bv[bj][0] = *(const f32x4*)(bp + bj * HALF); bv[bj][1] = *(const f32x4*)(bp + bj * HALF + 4); }
#pragma unroll
            for (int ai = 0; ai < 2; ++ai)
#pragma unroll
                for (int m = 0; m < 4; ++m) { int gr = bq * SEQ + tq0 + ai * HALF + wr * 64 + m * 16 + fr; gr = gr < 0 ? 0 : (gr > M - 1 ? M - 1 : gr);
                    const float r = __builtin_amdgcn_rsqf((float)rowsq[gr] * (1.f / RSQ_SCALE) * (1.f / D) + EPS);
#pragma unroll
                    for (int bj = 0; bj < 2; ++bj) { acc[ai][bj][m][0] = acc[ai][bj][m][0] * r + bv[bj][0]; acc[ai][bj][m][1] = acc[ai][bj][m][1] * r + bv[bj][1]; } }
        }
        if (fr >= 14) {
#pragma unroll
            for (int ai = 0; ai < 2; ++ai)
#pragma unroll
                for (int bj = 0; bj < 2; ++bj)
#pragma unroll
                    for (int n = 0; n < 2; ++n) *(LAS f32x4*)(bnd + ((ai * 2 + wr) * 2 + (fr - 14)) * 256 + bj * HALF + cl + 4 * n) = acc[ai][bj][3][n];
        }
        asm volatile("s_waitcnt lgkmcnt(0)" ::: "memory"); __builtin_amdgcn_s_barrier(); asm volatile("" ::: "memory");
        const int b = u.pm / 17, t0 = (u.pm % 17) * 254 - 2;
        const int ch0 = u.pn * HALF + cl;
#pragma unroll
        for (int ai = 0; ai < 2; ++ai) {
        u32x2 stash[4];
#pragma unroll
        for (int n = 0; n < 2; ++n) {
            f32x4 w0[2], w1[2], w2[2], bb[2];
#pragma unroll
            for (int bj = 0; bj < 2; ++bj) { const int cc = bj * DFF + ch0 + 4 * n;
                w0[bj] = *(const f32x4*)(cw + cc); w1[bj] = *(const f32x4*)(cw + 2 * DFF + cc); w2[bj] = *(const f32x4*)(cw + 4 * DFF + cc); bb[bj] = *(const f32x4*)(cb + cc); }
#pragma unroll
                for (int m = 0; m < 4; ++m) {
                    f32x4 uu[2];
#pragma unroll
                    for (int bj = 0; bj < 2; ++bj) {
                        const f32x4 v = acc[ai][bj][m][n];
                        f32x4 pv;
                        if (m > 0) pv = acc[ai][bj][m - 1][n];
                        else if (wr == 1 || ai == 1) { const int src = (wr == 1) ? (ai * 2 + 0) : (0 * 2 + 1); pv = *(const LAS f32x4*)(bnd + (src * 2 + ((fr - 14) & 1)) * 256 + bj * HALF + cl + 4 * n); }
                        else pv = (f32x4){0.f, 0.f, 0.f, 0.f};
                        f32x4 p1, p2;
#pragma unroll
                        for (int j = 0; j < 4; ++j) { const float c1 = (fr == 15) ? pv[j] : v[j], c2 = (fr >= 14) ? pv[j] : v[j];
                            p1[j] = DPPR(c1, 0x121); p2[j] = DPPR(c2, 0x122); }
                        if (ai == 0 && m == 0 && wr == 0 && t0 < 0) { const int tq = t0 + fr; if (tq < 1) p1 = (f32x4){0.f, 0.f, 0.f, 0.f}; if (tq < 2) p2 = (f32x4){0.f, 0.f, 0.f, 0.f}; }
                        uu[bj] = bb[bj] + w2[bj] * v + w1[bj] * p1 + w0[bj] * p2;
                    }
                    const int r = ai * HALF + wr * 64 + m * 16 + fr, t = t0 + r;
                    f32x4 o;
#pragma unroll
                    for (int j = 0; j < 4; ++j) o[j] = silu_f(uu[0][j]) * uu[1][j];
                    if (n == 0) { stash[m].x = cvt_pk_bf16(o[0], o[1]); stash[m].y = cvt_pk_bf16(o[2], o[3]); }
                    else if (r >= 2 && t < SEQ) { u32x4 w; w.x = stash[m].x; w.y = stash[m].y; w.z = cvt_pk_bf16(o[0], o[1]); w.w = cvt_pk_bf16(o[2], o[3]);
                        *(u32x4*)(O + ((size_t)b * SEQ + t) * DFF + ch0) = w; }
                    asm volatile("" ::: "memory");
                }
        }
        }
    }
};
}

struct Args {
    const float* x; const float* c; const int* pos;
    const float* ada_w; const float* ada_b; const float* n1g; const float* n2g; const float* w_in;
    const float* sconv_w; const float* sconv_b; const float* dt_bias; const float* a_log; const float* ssd_d; const float* ssd_ng;
    const float* qng; const float* w_uq; const float* kvng; const float* w_ukv; const float* sinks; const float* w_out;
    const float* w_up; const float* fconv_w; const float* fconv_b; const float* w_dn; const float* fng;
    float* out; unsigned char* ws; int ph_lo, ph_hi, wv, pad2;
};

__device__ __forceinline__ void phase_mod(const Args& a, LAS unsigned char* lds, int G) {
    LAS float* cact = (LAS float*)lds;
    LAS float* red = (LAS float*)(lds + 32768);
    const int tid = tid_opaque(a.wv), lane = tid & 63, wave = __builtin_amdgcn_readfirstlane(tid >> 6);
    for (int i = tid; i < 8 * 1024; i += 512) cact[i] = silu_f(a.c[i]);
    __syncthreads();
    float* mod = (float*)(a.ws + WS_MOD);
    for (int item = blockIdx.x; item < 4 * 96; item += G) {
        const int l = item / 96, col = (item % 96) * 64 + lane;
        const float* W = a.ada_w + (size_t)l * 1024 * 6144 + col;
        float s[8];
#pragma unroll
        for (int b = 0; b < 8; ++b) s[b] = 0.f;
        for (int k0 = wave * 128; k0 < wave * 128 + 128; k0 += 16) { float wv16[16];
#pragma unroll
            for (int q = 0; q < 16; ++q) wv16[q] = W[(size_t)(k0 + q) * 6144];
#pragma unroll
            for (int q = 0; q < 16; ++q)
#pragma unroll
                for (int b = 0; b < 8; ++b) s[b] += cact[b * 1024 + k0 + q] * wv16[q]; }
#pragma unroll
        for (int b = 0; b < 8; ++b) red[(wave * 8 + b) * 64 + lane] = s[b];
        __syncthreads();
        float t = 0.f;
#pragma unroll
        for (int w = 0; w < 8; ++w) t += red[(w * 8 + wave) * 64 + lane];
        mod[((size_t)l * 8 + wave) * 6144 + col] = t + a.ada_b[(size_t)l * 6144 + col];
        __syncthreads();
    }
}
__device__ __forceinline__ void phase_rope(const Args& a, int G) {
    float* rope = (float*)(a.ws + WS_ROPE);
    for (int idx = blockIdx.x * 512 + tid_opaque(a.wv); idx < M * 16; idx += G * 512) {
        const int row = idx >> 4, i = idx & 15;
        float inv = 1.778279402e-04f;
        inv = (i == 14) ? 3.162277571e-04f : inv;
        inv = (i == 13) ? 5.623413017e-04f : inv;
        inv = (i == 12) ? 1.000000047e-03f : inv;
        inv = (i == 11) ? 1.778279431e-03f : inv;
        inv = (i == 10) ? 3.162277630e-03f : inv;
        inv = (i == 9) ? 5.623413250e-03f : inv;
        inv = (i == 8) ? 9.999999776e-03f : inv;
        inv = (i == 7) ? 1.778279431e-02f : inv;
        inv = (i == 6) ? 3.162277490e-02f : inv;
        inv = (i == 5) ? 5.623413250e-02f : inv;
        inv = (i == 4) ? 1.000000015e-01f : inv;
        inv = (i == 3) ? 1.778279394e-01f : inv;
        inv = (i == 2) ? 3.162277639e-01f : inv;
        inv = (i == 1) ? 5.623413324e-01f : inv;
        inv = (i == 0) ? 1.000000000e+00f : inv;
        const float ang = (float)a.pos[row] * inv;
        const double rev = (double)ang * 0.15915494309189535;
        const float fr = (float)(rev - (double)(int)rev);
        rope[(size_t)row * 32 + i] = __builtin_amdgcn_cosf(fr);
        rope[(size_t)row * 32 + 16 + i] = __builtin_amdgcn_sinf(fr);
    }
}
enum { MAP_ID = 0, MAP_IN = 1, MAP_UP = 2, MAP_UQ = 3, MAP_ZERO = 4 };
__device__ __forceinline__ int map_col(int kind, int n) {
    if (kind == MAP_ID) return n;
    if (kind == MAP_ZERO) return -1;
    if (kind == MAP_IN) {
        if (n < 1536) return n;
        if (n < 1920) return n + 8;
        if (n < 1952) { const int e = n - 1920; return 1928 + 16 * (e & 1) + (e >> 1); }
        if (n < 2464) return n + 8;
        if (n < 2472) return n - 2464 + 1536;
        return -1;
    }
    if (kind == MAP_UP) { const int pn = n >> 8, cl = n & 255; return cl < 128 ? pn * 128 + cl : DFF + pn * 128 + (cl - 128); }
    if (n >= 384) return -1;
    { const int h = n / 96, d = n % 96; if (d < 64) return h * 96 + d; const int e = d - 64; return h * 96 + 64 + 16 * (e & 1) + (e >> 1); }
}
__device__ __forceinline__ void tr_item(const float* W, int N, int ks0, bf16_t* WT, int Kd, int kd0, int n0, int kind, const float* ksc, LAS float* scr, int lane) {
    const int src = map_col(kind, n0 + (lane & 31));
    const int srcc = src < 0 ? 0 : src; const float msk = src < 0 ? 0.f : 1.f;
    float vals[32];
#pragma unroll
    for (int i = 0; i < 32; ++i) vals[i] = W[(size_t)(ks0 + 2 * i + (lane >> 5)) * N + srcc];
    if (ksc) {
#pragma unroll
        for (int i = 0; i < 32; ++i) vals[i] *= ksc[ks0 + 2 * i + (lane >> 5)];
    }
#pragma unroll
    for (int i = 0; i < 32; ++i) scr[(2 * i + (lane >> 5)) * 33 + (lane & 31)] = vals[i] * msk;
    asm volatile("s_waitcnt lgkmcnt(0)" ::: "memory");
    const int c = lane & 7;
#pragma unroll
    for (int j = 0; j < 4; ++j) { const int n = (lane >> 3) + 8 * j; const LAS float* s = scr + (8 * c) * 33 + n;
        u32x4 o; o.x = pk2(s[0 * 33], s[1 * 33]); o.y = pk2(s[2 * 33], s[3 * 33]); o.z = pk2(s[4 * 33], s[5 * 33]); o.w = pk2(s[6 * 33], s[7 * 33]);
        *(u32x4*)(WT + (size_t)(n0 + n) * Kd + kd0 + 8 * c) = o; }
    asm volatile("s_waitcnt lgkmcnt(0)" ::: "memory");
}
__device__ __forceinline__ void phase_weights(const Args& a, int l, unsigned char* wb, LAS unsigned char* lds, int G) {
    const int tid_ = tid_opaque(a.wv), lane = tid_ & 63, wave = tid_ >> 6;
    LAS float* scr = (LAS float*)(lds + wave * 16384);
    constexpr int I_IN = 16 * 80, I_OUT = 16 * 32, I_UP = 16 * 176, I_DN = 44 * 32, I_QKV = 4 * 16 + 2 * 16;
    constexpr int NIT = I_IN + I_OUT + I_UP + I_DN + I_QKV;
    for (int it = blockIdx.x * 8 + wave; it < NIT; it += G * 8) {
        int r = it;
        if (r < I_IN) { tr_item(a.w_in + (size_t)l * D * DIN, DIN, 64 * (r / 80), (bf16_t*)(wb + WO_IN), D, 64 * (r / 80), 32 * (r % 80), MAP_IN, nullptr, scr, lane); continue; } r -= I_IN;
        if (r < I_OUT) { tr_item(a.w_out + (size_t)l * D * D, D, 64 * (r / 32), (bf16_t*)(wb + WO_OUT), D, 64 * (r / 32), 32 * (r % 32), MAP_ID, nullptr, scr, lane); continue; } r -= I_OUT;
        if (r < I_UP) { tr_item(a.w_up + (size_t)l * D * 2 * DFF, 2 * DFF, 64 * (r / 176), (bf16_t*)(wb + WO_UP), D, 64 * (r / 176), 32 * (r % 176), MAP_UP, nullptr, scr, lane); continue; } r -= I_UP;
        if (r < I_DN) { tr_item(a.w_dn + (size_t)l * DFF * D, D, 64 * (r / 32), (bf16_t*)(wb + WO_DN), DFF, 64 * (r / 32), 32 * (r % 32), MAP_ID, nullptr, scr, lane); continue; } r -= I_DN;
        { if (r < 4 * 16) tr_item(a.w_uq + (size_t)l * 256 * 384, 384, 64 * (r / 16), (bf16_t*)(wb + WO_UQ), 256, 64 * (r / 16), 32 * (r % 16), MAP_UQ, a.qng + l * 256, scr, lane);
          else { r -= 64; tr_item(a.w_ukv + (size_t)l * 128 * 512, 512, 64 * (r / 16), (bf16_t*)(wb + WO_UKV), 128, 64 * (r / 16), 32 * (r % 16), MAP_ID, a.kvng + l * 128, scr, lane); } }
    }
}

__device__ __forceinline__ void phase_bias(const Args& a, int l, float* bias, LAS unsigned char* lds, int G) {
    LAS float* shv = (LAS float*)lds;
    LAS float* red = (LAS float*)(lds + 65536);
    const int tid = tid_opaque(a.wv), lane = tid & 63, wave = __builtin_amdgcn_readfirstlane(tid >> 6);
    const float* ml = (const float*)(a.ws + WS_MOD) + (size_t)l * 8 * 6144;
    __syncthreads();
    for (int i = tid; i < 2 * 8 * 1024; i += 512) { const int which = i >> 13, b = (i >> 10) & 7, k = i & 1023; shv[i] = ml[(size_t)b * 6144 + (which ? 3072 : 0) + k]; }
    __syncthreads();
    for (int item = blockIdx.x; item < 80 + 176; item += G) {
        const bool up = item >= 80; const int n = (up ? item - 80 : item) * 32 + (lane & 31), N = up ? 2 * DFF : DIN;
        const int src = map_col(up ? MAP_UP : MAP_IN, n);
        const float* W = (up ? a.w_up + (size_t)l * D * 2 * DFF : a.w_in + (size_t)l * D * DIN) + (src < 0 ? 0 : src);
        const LAS float* sv = shv + (up ? 8192 : 0);
        float s8[8];
#pragma unroll
        for (int b = 0; b < 8; ++b) s8[b] = 0.f;
        const int kb = wave * 128 + (lane >> 5) * 64;
        for (int k0 = kb; k0 < kb + 64; k0 += 16) { float wv16[16];
#pragma unroll
            for (int q = 0; q < 16; ++q) wv16[q] = W[(size_t)(k0 + q) * N];
#pragma unroll
            for (int q = 0; q < 16; ++q)
#pragma unroll
                for (int b = 0; b < 8; ++b) s8[b] += sv[b * 1024 + k0 + q] * wv16[q]; }
#pragma unroll
        for (int b = 0; b < 8; ++b) { s8[b] += shx(s8[b], 32, lane); red[(wave * 8 + b) * 64 + lane] = s8[b]; }
        __syncthreads();
        if (lane < 32) { float t = 0.f;
#pragma unroll
            for (int w = 0; w < 8; ++w) t += red[(w * 8 + wave) * 64 + lane];
            (up ? bias + 8 * NPROJ : bias)[(size_t)wave * (up ? 2 * DFF : NPROJ) + n] = src < 0 ? 0.f : t; }
        __syncthreads();
    }
}
__device__ __forceinline__ void phase_norm0(const float* xin, const float* g, const float* sc, bf16_t* hout, unsigned long long* rowsq, int G, int wv) {
    const int tid_ = tid_opaque(wv), lane = tid_ & 63, wave = tid_ >> 6;
    for (int row = blockIdx.x * 8 + wave; row < M; row += G * 8) {
        const int b = row / SEQ;
        const f32x4* xr = (const f32x4*)(xin + (size_t)row * D) + lane;
        f32x4 v[4]; float s = 0.f;
#pragma unroll
        for (int j = 0; j < 4; ++j) { v[j] = xr[64 * j]; s += (v[j].x * v[j].x + v[j].y * v[j].y) + (v[j].z * v[j].z + v[j].w * v[j].w); }
        s = wave_sum(s, lane);
        if (lane == 0) rowsq[row] = (unsigned long long)(s * RSQ_SCALE + 0.5f);
        u32x2* o8 = (u32x2*)(hout + (size_t)row * D) + lane;
#pragma unroll
        for (int j = 0; j < 4; ++j) { const int col = 4 * lane + 256 * j;
            const f32x4 y = v[j] * *(const f32x4*)(g + col) * (*(const f32x4*)(sc + (size_t)b * 6144 + col) + 1.f);
            u32x2 w; w.x = cvt_pk_bf16(y.x, y.y); w.y = cvt_pk_bf16(y.z, y.w); o8[64 * j] = w; }
    }
}
__device__ __forceinline__ void phase_final(float* x, const float* g, int G, int wv) {
    const int tid_ = tid_opaque(wv), lane = tid_ & 63, wave = tid_ >> 6;
    for (int row = blockIdx.x * 8 + wave; row < M; row += G * 8) {
        f32x4* xr = (f32x4*)(x + (size_t)row * D) + lane;
        f32x4 v[4]; float s = 0.f;
#pragma unroll
        for (int j = 0; j < 4; ++j) { v[j] = xr[64 * j]; s += (v[j].x * v[j].x + v[j].y * v[j].y) + (v[j].z * v[j].z + v[j].w * v[j].w); }
        const float r = 1.f / sqrtf(wave_sum(s, lane) * (1.f / D) + EPS);
#pragma unroll
        for (int j = 0; j < 4; ++j) { const f32x4 gg = *(const f32x4*)(g + 4 * lane + 256 * j); xr[64 * j] = v[j] * r * gg; }
    }
}
__device__ __forceinline__ void phase_prep(const Args& a, int l, int G) {
    const int tid_ = tid_opaque(a.wv), lane = tid_ & 63, wave = tid_ >> 6;
    const bf16_t* proj = (const bf16_t*)(a.ws + WS_PROJ);
    bf16_t* xbc = (bf16_t*)(a.ws + WS_H);
    const float* cw = a.sconv_w + (size_t)l * 4 * 1024; const float* cb = a.sconv_b + (size_t)l * 1024;
    const float* dtraw = (const float*)(a.ws + WS_DTRAW); float* dtsp = (float*)(a.ws + WS_DTSP);
    float* rq = (float*)(a.ws + WS_RS); float* rkv = rq + M; unsigned long long* rsq = (unsigned long long*)(a.ws + WS_RSQ);
    const float* rope = (const float*)(a.ws + WS_ROPE); bf16_t* kr = (bf16_t*)(a.ws + WS_KR);
    f32x4 wk[2][4][2], bk[2][2];
#pragma unroll
    for (int j = 0; j < 2; ++j) { const int ch = 8 * lane + 512 * j; bk[j][0] = *(const f32x4*)(cb + ch); bk[j][1] = *(const f32x4*)(cb + ch + 4);
#pragma unroll
        for (int k = 0; k < 4; ++k) { wk[j][k][0] = *(const f32x4*)(cw + k * 1024 + ch); wk[j][k][1] = *(const f32x4*)(cw + k * 1024 + ch + 4); } }
    const float dtb = lane < 8 ? a.dt_bias[l * 8 + lane] : 0.f;
    for (int run = blockIdx.x * 8 + wave; run < M / 16; run += G * 8) {
        const int rowb = run * 16, tb = rowb % SEQ;
        u32x4 win[2][3];
#pragma unroll
        for (int j = 0; j < 2; ++j)
#pragma unroll
            for (int k = 0; k < 3; ++k) { win[j][k] = (u32x4){0u, 0u, 0u, 0u}; if (tb - 3 + k >= 0) win[j][k] = *(const u32x4*)(proj + (size_t)(rowb - 3 + k) * NPROJ + PC_X + 8 * lane + 512 * j); }
        for (int r4 = 0; r4 < 16; r4 += 4) {
            u32x4 curv[4][2], cqv[4]; float dtr[4], rcs[4], rsn[4]; unsigned krv[4];
#pragma unroll
            for (int q = 0; q < 4; ++q) { const size_t row = (size_t)(rowb + r4 + q);
                curv[q][0] = *(const u32x4*)(proj + row * NPROJ + PC_X + 8 * lane); curv[q][1] = *(const u32x4*)(proj + row * NPROJ + PC_X + 8 * lane + 512);
                cqv[q] = (u32x4){0u, 0u, 0u, 0u}; if (lane < 48) cqv[q] = *(const u32x4*)(proj + row * NPROJ + PC_CQ + 8 * lane);
                dtr[q] = lane < 8 ? dtraw[row * 8 + lane] : 0.f;
                krv[q] = 0u; rcs[q] = 0.f; rsn[q] = 0.f;
                if (lane < 16) { krv[q] = *(const unsigned*)(proj + row * NPROJ + PC_KR + 2 * lane); rcs[q] = rope[row * 32 + lane]; rsn[q] = rope[row * 32 + 16 + lane]; } }
#pragma unroll
            for (int q = 0; q < 4; ++q) { const int row = rowb + r4 + q;
#pragma unroll
                for (int j = 0; j < 2; ++j) { const int ch = 8 * lane + 512 * j;
                    const u32x4 cur = curv[q][j];
                    f32x4 a0 = bk[j][0], a1 = bk[j][1];
#pragma unroll
                    for (int k = 0; k < 4; ++k) { const u32x4 pv = k < 3 ? win[j][k] : cur;
                        a0 += wk[j][k][0] * (f32x4){bflo(pv.x), bfhi(pv.x), bflo(pv.y), bfhi(pv.y)}; a1 += wk[j][k][1] * (f32x4){bflo(pv.z), bfhi(pv.z), bflo(pv.w), bfhi(pv.w)}; }
                    win[j][0] = win[j][1]; win[j][1] = win[j][2]; win[j][2] = cur;
                    u32x4 o; o.x = cvt_pk_bf16(silu_f(a0.x), silu_f(a0.y)); o.y = cvt_pk_bf16(silu_f(a0.z), silu_f(a0.w)); o.z = cvt_pk_bf16(silu_f(a1.x), silu_f(a1.y)); o.w = cvt_pk_bf16(silu_f(a1.z), silu_f(a1.w));
                    *(u32x4*)(xbc + (size_t)row * 1024 + ch) = o; }
                if (lane == 0) { rsq[row] = 0ull; rsq[M + row] = 0ull; }
                if (lane < 8) { const float v = dtr[q] + dtb; dtsp[(size_t)row * 8 + lane] = v > 15.f ? v : __logf(1.f + __expf(v)); }
                { const u32x4 pv = cqv[q];
                  const float f0 = bflo(pv.x), f1 = bfhi(pv.x), f2 = bflo(pv.y), f3 = bfhi(pv.y), f4 = bflo(pv.z), f5 = bfhi(pv.z), f6 = bflo(pv.w), f7 = bfhi(pv.w);
                  const float s = (f0 * f0 + f1 * f1) + (f2 * f2 + f3 * f3) + (f4 * f4 + f5 * f5) + (f6 * f6 + f7 * f7);
                  float sq = lane < 32 ? s : 0.f, sk = (lane >= 32 && lane < 48) ? s : 0.f;
                  sq = wave_sum(sq, lane); sk = wave_sum(sk, lane);
                  if (lane == 0) { rq[row] = __builtin_amdgcn_rsqf(sq * (1.f / 256.f) + EPS); rkv[row] = __builtin_amdgcn_rsqf(sk * (1.f / 128.f) + EPS); } }
                if (lane < 16) { const float x1 = bflo(krv[q]), x2 = bfhi(krv[q]);
                    *(unsigned*)(kr + (size_t)row * 32 + 2 * lane) = cvt_pk_bf16(x1 * rcs[q] - x2 * rsn[q], x1 * rsn[q] + x2 * rcs[q]); }
            }
        }
    }
}
__device__ __forceinline__ void phase_ssd_naive(const Args& a, int l, int G) {
    const int tid = tid_opaque(a.wv), pl = tid >> 5, nq = tid & 31, lane = tid & 63;
    const bf16_t* xbc = (const bf16_t*)(a.ws + WS_H);
    const bf16_t* proj = (const bf16_t*)(a.ws + WS_PROJ);
    const float* dtsp = (const float*)(a.ws + WS_DTSP);
    float* ytmp = (float*)(a.ws + WS_YS);
    for (int unit = blockIdx.x; unit < 256; unit += G) {
        const int b = unit >> 5, h = (unit >> 2) & 7, pq = unit & 3, g = h >> 2, p = pq * 16 + pl;
        const float av = -__expf(a.a_log[l * 8 + h]), dsk = a.ssd_d[l * 8 + h];
        float s0 = 0.f, s1 = 0.f, s2 = 0.f, s3 = 0.f;
        for (int t = 0; t < SEQ; ++t) {
            const size_t row = (size_t)b * SEQ + t;
            const float dt = dtsp[row * 8 + h];
            const float x = bf2f(xbc[row * 1024 + h * 64 + p]);
            const u32x2 bv = *(const u32x2*)(xbc + row * 1024 + 512 + g * 128 + 4 * nq);
            const u32x2 cv = *(const u32x2*)(xbc + row * 1024 + 768 + g * 128 + 4 * nq);
            const float dA = __expf(dt * av), xd = dt * x;
            s0 = s0 * dA + xd * bflo(bv.x); s1 = s1 * dA + xd * bfhi(bv.x); s2 = s2 * dA + xd * bflo(bv.y); s3 = s3 * dA + xd * bfhi(bv.y);
            float y = (s0 * bflo(cv.x) + s1 * bfhi(cv.x)) + (s2 * bflo(cv.y) + s3 * bfhi(cv.y));
            y += shx(y, 16, lane); y += shx(y, 8, lane); y += shx(y, 4, lane); y += shx(y, 2, lane); y += shx(y, 1, lane);
            if (nq == 0) { const float z = bf2f(proj[row * NPROJ + PC_Z + h * 64 + p]); ytmp[row * 512 + h * 64 + p] = (y + dsk * x) * silu_f(z); }
        }
    }
}
__device__ __forceinline__ void phase_ssd_norm(const Args& a, int l, int G) {
    const int tid_ = tid_opaque(a.wv), lane = tid_ & 63, wave = tid_ >> 6;
    const float* ytmp = (const float*)(a.ws + WS_YS); bf16_t* ycat = (bf16_t*)(a.ws + WS_YCAT);
    const float* ng = a.ssd_ng + l * 512;
    for (int row = blockIdx.x * 8 + wave; row < M; row += G * 8) {
        const f32x4 v0 = *(const f32x4*)(ytmp + (size_t)row * 512 + 8 * lane), v1 = *(const f32x4*)(ytmp + (size_t)row * 512 + 8 * lane + 4);
        float s = (v0.x * v0.x + v0.y * v0.y) + (v0.z * v0.z + v0.w * v0.w) + (v1.x * v1.x + v1.y * v1.y) + (v1.z * v1.z + v1.w * v1.w);
        s += shx(s, 16, lane); s += shx(s, 8, lane); s += shx(s, 4, lane); s += shx(s, 2, lane); s += shx(s, 1, lane);
        const float r = 1.f / sqrtf(s * (1.f / 256.f) + EPS);
        const f32x4 g0 = *(const f32x4*)(ng + 8 * lane), g1 = *(const f32x4*)(ng + 8 * lane + 4);
        u32x4 o; o.x = cvt_pk_bf16(v0.x * r * g0.x, v0.y * r * g0.y); o.y = cvt_pk_bf16(v0.z * r * g0.z, v0.w * r * g0.w); o.z = cvt_pk_bf16(v1.x * r * g1.x, v1.y * r * g1.y); o.w = cvt_pk_bf16(v1.z * r * g1.z, v1.w * r * g1.w);
        *(u32x4*)(ycat + (size_t)row * 1024 + 8 * lane) = o;
    }
}

constexpr size_t WS_CDEC = 399 * MiB;
__device__ __forceinline__ void phase_ssd_states(const Args& a, int l, int G) {
    const int tid = tid_opaque(a.wv), p = tid >> 3, no = tid & 7;
    const bf16_t* xbc = (const bf16_t*)(a.ws + WS_H); const float* dtsp = (const float*)(a.ws + WS_DTSP);
    float* states = (float*)(a.ws + WS_YS); float* cdec = (float*)(a.ws + WS_CDEC);
    for (int u = blockIdx.x; u < 2048; u += G) {
        const int b = u >> 8, c = (u >> 3) & 31, h = u & 7, g = h >> 2;
        const float av = -__expf(a.a_log[l * 8 + h]);
        float st[16];
#pragma unroll
        for (int j = 0; j < 16; ++j) st[j] = 0.f;
        float asum = 0.f;
        const size_t row0 = (size_t)b * SEQ + c * 128;
#pragma unroll 2
        for (int s2 = 0; s2 < 128; ++s2) { const size_t row = row0 + s2;
            const float dt = dtsp[row * 8 + h], da = dt * av, dA = __expf(da), xd = dt * bf2f(xbc[row * 1024 + h * 64 + p]);
            const u32x4 b0 = *(const u32x4*)(xbc + row * 1024 + 512 + g * 128 + 16 * no), b1 = *(const u32x4*)(xbc + row * 1024 + 512 + g * 128 + 16 * no + 8);
            asum += da;
            st[0] = st[0] * dA + xd * bflo(b0.x); st[1] = st[1] * dA + xd * bfhi(b0.x); st[2] = st[2] * dA + xd * bflo(b0.y); st[3] = st[3] * dA + xd * bfhi(b0.y);
            st[4] = st[4] * dA + xd * bflo(b0.z); st[5] = st[5] * dA + xd * bfhi(b0.z); st[6] = st[6] * dA + xd * bflo(b0.w); st[7] = st[7] * dA + xd * bfhi(b0.w);
            st[8] = st[8] * dA + xd * bflo(b1.x); st[9] = st[9] * dA + xd * bfhi(b1.x); st[10] = st[10] * dA + xd * bflo(b1.y); st[11] = st[11] * dA + xd * bfhi(b1.y);
            st[12] = st[12] * dA + xd * bflo(b1.z); st[13] = st[13] * dA + xd * bfhi(b1.z); st[14] = st[14] * dA + xd * bflo(b1.w); st[15] = st[15] * dA + xd * bfhi(b1.w); }
        float* sp = states + (size_t)u * 8192 + p * 128 + 16 * no;
#pragma unroll
        for (int j = 0; j < 4; ++j) *(f32x4*)(sp + 4 * j) = (f32x4){st[4 * j], st[4 * j + 1], st[4 * j + 2], st[4 * j + 3]};
        if (tid == 0) cdec[u] = __expf(asum);
    }
}
__device__ __forceinline__ void phase_ssd_scan(const Args& a, int G) {
    bf16_t* states = (bf16_t*)(a.ws + WS_YS); const float* cdec = (const float*)(a.ws + WS_CDEC);
    for (int e = blockIdx.x * 512 + tid_opaque(a.wv); e < 8 * 8 * 2048; e += G * 512) {
        const int b = e >> 14, h = (e >> 11) & 7, pn = e & 2047;
        f32x4 hc = (f32x4){0.f, 0.f, 0.f, 0.f};
#pragma unroll 8
        for (int c = 0; c < 32; ++c) { const int u = (b * 32 + c) * 8 + h; u32x2* sp = (u32x2*)(states + (size_t)u * 8192) + pn;
            const u32x2 v = *sp; u32x2 w; w.x = cvt_pk_bf16(hc.x, hc.y); w.y = cvt_pk_bf16(hc.z, hc.w); *sp = w;
            hc = hc * cdec[u] + (f32x4){bflo(v.x), bfhi(v.x), bflo(v.y), bfhi(v.y)}; }
    }
}
__device__ __forceinline__ void phase_ssd_out(const Args& a, int l, LAS unsigned char* lds, int G) {
    const int tid = tid_opaque(a.wv), p = tid >> 3, no = tid & 7, lane = tid & 63, wave = tid >> 6;
    const bf16_t* xbc = (const bf16_t*)(a.ws + WS_H); const bf16_t* proj = (const bf16_t*)(a.ws + WS_PROJ); const float* dtsp = (const float*)(a.ws + WS_DTSP);
    const float* states = (const float*)(a.ws + WS_YS); bf16_t* ycat = (bf16_t*)(a.ws + WS_YCAT);
    LAS float* yb = (LAS float*)lds;
    for (int u = blockIdx.x; u < 512; u += G) {
        const int b = u >> 6, c = (u >> 1) & 31, g = u & 1;
        const size_t row0 = (size_t)b * SEQ + c * 128;
        for (int hg = 0; hg < 4; ++hg) { const int h = g * 4 + hg;
            const float av = -__expf(a.a_log[l * 8 + h]), dsk = a.ssd_d[l * 8 + h];
            float st[16];
            { const float* sp = states + (size_t)((b * 32 + c) * 8 + h) * 8192 + p * 128 + 16 * no;
#pragma unroll
              for (int j = 0; j < 4; ++j) { const f32x4 v = *(const f32x4*)(sp + 4 * j); st[4 * j] = v.x; st[4 * j + 1] = v.y; st[4 * j + 2] = v.z; st[4 * j + 3] = v.w; } }
#pragma unroll 2
            for (int s2 = 0; s2 < 128; ++s2) { const size_t row = row0 + s2;
                const float dt = dtsp[row * 8 + h], dA = __expf(dt * av), x = bf2f(xbc[row * 1024 + h * 64 + p]), xd = dt * x;
                const bf16_t* bp = xbc + row * 1024 + 512 + g * 128 + 16 * no;
                const u32x4 b0 = *(const u32x4*)bp, b1 = *(const u32x4*)(bp + 8), c0 = *(const u32x4*)(bp + 256), c1 = *(const u32x4*)(bp + 264);
                st[0] = st[0] * dA + xd * bflo(b0.x); st[1] = st[1] * dA + xd * bfhi(b0.x); st[2] = st[2] * dA + xd * bflo(b0.y); st[3] = st[3] * dA + xd * bfhi(b0.y);
                st[4] = st[4] * dA + xd * bflo(b0.z); st[5] = st[5] * dA + xd * bfhi(b0.z); st[6] = st[6] * dA + xd * bflo(b0.w); st[7] = st[7] * dA + xd * bfhi(b0.w);
                st[8] = st[8] * dA + xd * bflo(b1.x); st[9] = st[9] * dA + xd * bfhi(b1.x); st[10] = st[10] * dA + xd * bflo(b1.y); st[11] = st[11] * dA + xd * bfhi(b1.y);
                st[12] = st[12] * dA + xd * bflo(b1.z); st[13] = st[13] * dA + xd * bfhi(b1.z); st[14] = st[14] * dA + xd * bflo(b1.w); st[15] = st[15] * dA + xd * bfhi(b1.w);
                float y = ((st[0] * bflo(c0.x) + st[1] * bfhi(c0.x)) + (st[2] * bflo(c0.y) + st[3] * bfhi(c0.y))) + ((st[4] * bflo(c0.z) + st[5] * bfhi(c0.z)) + (st[6] * bflo(c0.w) + st[7] * bfhi(c0.w)))
                        + ((st[8] * bflo(c1.x) + st[9] * bfhi(c1.x)) + (st[10] * bflo(c1.y) + st[11] * bfhi(c1.y))) + ((st[12] * bflo(c1.z) + st[13] * bfhi(c1.z)) + (st[14] * bflo(c1.w) + st[15] * bfhi(c1.w)));
                y += shx(y, 4, lane); y += shx(y, 2, lane); y += shx(y, 1, lane);
                if (no == 0) { const float z = bf2f(proj[row * NPROJ + PC_Z + h * 64 + p]); yb[s2 * 256 + hg * 64 + p] = (y + dsk * x) * silu_f(z); }
            }
        }
        __syncthreads();
        const float* ng = a.ssd_ng + l * 512 + g * 256;
        const f32x4 gg = *(const f32x4*)(ng + 4 * lane);
        for (int tk = wave; tk < 128; tk += 8) {
            const f32x4 v = *(const LAS f32x4*)(yb + tk * 256 + 4 * lane);
            const float sq = wave_sum((v.x * v.x + v.y * v.y) + (v.z * v.z + v.w * v.w), lane);
            const float r = 1.f / sqrtf(sq * (1.f / 256.f) + EPS);
            u32x2 w; w.x = cvt_pk_bf16(v.x * r * gg.x, v.y * r * gg.y); w.y = cvt_pk_bf16(v.z * r * gg.z, v.w * r * gg.w);
            *(u32x2*)(ycat + (row0 + tk) * 1024 + g * 256 + 4 * lane) = w;
        }
        __syncthreads();
    }
}

__device__ __forceinline__ void phase_mla_naive(const Args& a, int G) {
    const int tid_ = tid_opaque(a.wv), lane = tid_ & 63, wave = tid_ >> 6;
    const bf16_t* qb = (const bf16_t*)(a.ws + WS_Q); const bf16_t* kv = (const bf16_t*)(a.ws + WS_KV); const bf16_t* kr = (const bf16_t*)(a.ws + WS_KR);
    bf16_t* ycat = (bf16_t*)(a.ws + WS_YCAT);
    for (int blk = blockIdx.x; blk < 256; blk += G) {
        const int bh = blk >> 3, s = blk & 7, b = bh >> 2, h = bh & 3;
        const int c = (wave & 1) ? (16 * (wave >> 1) + 15 - s) : (16 * (wave >> 1) + s);
        const int t = c * 64 + lane; const size_t row = (size_t)b * SEQ + t;
        u32x4 qw[12];
#pragma unroll
        for (int i = 0; i < 12; ++i) qw[i] = *(const u32x4*)(qb + row * 384 + h * 96 + 8 * i);
        { const float* rp = (const float*)(a.ws + WS_ROPE) + row * 32;
#pragma unroll
          for (int i = 0; i < 4; ++i) { const f32x4 cs = *(const f32x4*)(rp + 4 * i), sn = *(const f32x4*)(rp + 16 + 4 * i); u32x4 w = qw[8 + i];
              w.x = cvt_pk_bf16(bflo(w.x) * cs.x - bfhi(w.x) * sn.x, bflo(w.x) * sn.x + bfhi(w.x) * cs.x); w.y = cvt_pk_bf16(bflo(w.y) * cs.y - bfhi(w.y) * sn.y, bflo(w.y) * sn.y + bfhi(w.y) * cs.y);
              w.z = cvt_pk_bf16(bflo(w.z) * cs.z - bfhi(w.z) * sn.z, bflo(w.z) * sn.z + bfhi(w.z) * cs.z); w.w = cvt_pk_bf16(bflo(w.w) * cs.w - bfhi(w.w) * sn.w, bflo(w.w) * sn.w + bfhi(w.w) * cs.w);
              qw[8 + i] = w; } }
        float o[64];
#pragma unroll
        for (int i = 0; i < 64; ++i) o[i] = 0.f;
        float mx = -1e30f, ls = 0.f;
        const int jend = c * 64 + 63;
        for (int j = 0; j <= jend; ++j) {
            const size_t rj = (size_t)b * SEQ + j;
            const bf16_t* kp = kv + rj * 512 + h * 128; const bf16_t* krp = kr + rj * 32;
            float sc = 0.f;
#pragma unroll
            for (int i = 0; i < 8; ++i) { const u32x4 w = *(const u32x4*)(kp + 8 * i); const u32x4 qq = qw[i];
                sc += bflo(qq.x) * bflo(w.x) + bfhi(qq.x) * bfhi(w.x) + bflo(qq.y) * bflo(w.y) + bfhi(qq.y) * bfhi(w.y) + bflo(qq.z) * bflo(w.z) + bfhi(qq.z) * bfhi(w.z) + bflo(qq.w) * bflo(w.w) + bfhi(qq.w) * bfhi(w.w); }
#pragma unroll
            for (int i = 0; i < 4; ++i) { const u32x4 w = *(const u32x4*)(krp + 8 * i); const u32x4 qq = qw[8 + i];
                sc += bflo(qq.x) * bflo(w.x) + bfhi(qq.x) * bfhi(w.x) + bflo(qq.y) * bflo(w.y) + bfhi(qq.y) * bfhi(w.y) + bflo(qq.z) * bflo(w.z) + bfhi(qq.z) * bfhi(w.z) + bflo(qq.w) * bflo(w.w) + bfhi(qq.w) * bfhi(w.w); }
            if (j <= t) {
                const float mn = fmaxf(mx, sc), f = exp2f(mx - mn), p = exp2f(sc - mn);
                ls = ls * f + p; mx = mn;
#pragma unroll
                for (int i = 0; i < 8; ++i) { const u32x4 w = *(const u32x4*)(kp + 64 + 8 * i);
                    o[8 * i] = o[8 * i] * f + p * bflo(w.x); o[8 * i + 1] = o[8 * i + 1] * f + p * bfhi(w.x); o[8 * i + 2] = o[8 * i + 2] * f + p * bflo(w.y); o[8 * i + 3] = o[8 * i + 3] * f + p * bfhi(w.y);
                    o[8 * i + 4] = o[8 * i + 4] * f + p * bflo(w.z); o[8 * i + 5] = o[8 * i + 5] * f + p * bfhi(w.z); o[8 * i + 6] = o[8 * i + 6] * f + p * bflo(w.w); o[8 * i + 7] = o[8 * i + 7] * f + p * bfhi(w.w); }
            }
        }
        const float il = 1.f / ls;
#pragma unroll
        for (int i = 0; i < 8; ++i) { u32x4 w; w.x = cvt_pk_bf16(o[8 * i] * il, o[8 * i + 1] * il); w.y = cvt_pk_bf16(o[8 * i + 2] * il, o[8 * i + 3] * il); w.z = cvt_pk_bf16(o[8 * i + 4] * il, o[8 * i + 5] * il); w.w = cvt_pk_bf16(o[8 * i + 6] * il, o[8 * i + 7] * il);
            *(u32x4*)(ycat + row * 1024 + 512 + h * 64 + 8 * i) = w; }
    }
}
__device__ __forceinline__ void phase_swa_naive(const Args& a, int l, int G) {
    const int tid_ = tid_opaque(a.wv), lane = tid_ & 63, wave = tid_ >> 6;
    const bf16_t* proj = (const bf16_t*)(a.ws + WS_PROJ); bf16_t* ycat = (bf16_t*)(a.ws + WS_YCAT);
    for (int blk = blockIdx.x; blk < 256; blk += G) {
        const int bh = blk >> 3, b = bh >> 2, h = bh & 3, c = (blk & 7) * 8 + wave, hk = h >> 1;
        const int t = c * 64 + lane; const size_t row = (size_t)b * SEQ + t;
        u32x4 qw[8];
#pragma unroll
        for (int i = 0; i < 8; ++i) qw[i] = *(const u32x4*)(proj + row * NPROJ + PC_SQ + h * 64 + 8 * i);
        float o[64];
#pragma unroll
        for (int i = 0; i < 64; ++i) o[i] = 0.f;
        float mx = a.sinks[l * 4 + h] * LOG2E, ls = 1.f;
        const int j0 = (c * 64 - 127) > 0 ? (c * 64 - 127) : 0, jend = c * 64 + 63;
        for (int j = j0; j <= jend; ++j) {
            const size_t rj = (size_t)b * SEQ + j;
            const bf16_t* kp = proj + rj * NPROJ + PC_SK + hk * 64; const bf16_t* vp = proj + rj * NPROJ + PC_SV + hk * 64;
            float sc = 0.f;
#pragma unroll
            for (int i = 0; i < 8; ++i) { const u32x4 w = *(const u32x4*)(kp + 8 * i); const u32x4 qq = qw[i];
                sc += bflo(qq.x) * bflo(w.x) + bfhi(qq.x) * bfhi(w.x) + bflo(qq.y) * bflo(w.y) + bfhi(qq.y) * bfhi(w.y) + bflo(qq.z) * bflo(w.z) + bfhi(qq.z) * bfhi(w.z) + bflo(qq.w) * bflo(w.w) + bfhi(qq.w) * bfhi(w.w); }
            sc *= SWA_QSCALE;
            if (j <= t && t - j < 128) {
                const float mn = fmaxf(mx, sc), f = exp2f(mx - mn), p = exp2f(sc - mn);
                ls = ls * f + p; mx = mn;
#pragma unroll
                for (int i = 0; i < 8; ++i) { const u32x4 w = *(const u32x4*)(vp + 8 * i);
                    o[8 * i] = o[8 * i] * f + p * bflo(w.x); o[8 * i + 1] = o[8 * i + 1] * f + p * bfhi(w.x); o[8 * i + 2] = o[8 * i + 2] * f + p * bflo(w.y); o[8 * i + 3] = o[8 * i + 3] * f + p * bfhi(w.y);
                    o[8 * i + 4] = o[8 * i + 4] * f + p * bflo(w.z); o[8 * i + 5] = o[8 * i + 5] * f + p * bfhi(w.z); o[8 * i + 6] = o[8 * i + 6] * f + p * bflo(w.w); o[8 * i + 7] = o[8 * i + 7] * f + p * bfhi(w.w); }
            }
        }
        const float il = 1.f / ls;
#pragma unroll
        for (int i = 0; i < 8; ++i) { u32x4 w; w.x = cvt_pk_bf16(o[8 * i] * il, o[8 * i + 1] * il); w.y = cvt_pk_bf16(o[8 * i + 2] * il, o[8 * i + 3] * il); w.z = cvt_pk_bf16(o[8 * i + 4] * il, o[8 * i + 5] * il); w.w = cvt_pk_bf16(o[8 * i + 6] * il, o[8 * i + 7] * il);
            *(u32x4*)(ycat + row * 1024 + 768 + h * 64 + 8 * i) = w; }
    }
}


typedef float f32x16 __attribute__((ext_vector_type(16)));
typedef short s16x4 __attribute__((ext_vector_type(4)));
__device__ __forceinline__ s16x4 lds_tr16(LAS unsigned char* p) { return __builtin_bit_cast(s16x4, __builtin_amdgcn_ds_read_tr16_b64_v4i16((LAS s16x4*)p)); }
template <bool MLA>
__device__ __forceinline__ void attn_unit(const Args& a, int l, LAS unsigned char* lds, int b, int hd, int qb) {
    constexpr int KS = MLA ? 6 : 4, KROW = MLA ? 208 : 144, KBUF = 128 * KROW, VBUF = 16384, VOFF = 2 * KBUF;
    const int tid = tid_opaque(a.wv), lane = tid & 63, wave = __builtin_amdgcn_readfirstlane(tid >> 6), r = lane & 31, h = lane >> 5;
    const bf16_t* proj = (const bf16_t*)(a.ws + WS_PROJ);
    const bf16_t* Kp; const bf16_t* Vp; int ldk;
    if (MLA) { Kp = (const bf16_t*)(a.ws + WS_KV) + (size_t)b * SEQ * 512 + hd * 128; Vp = Kp + 64; ldk = 512; }
    else { Kp = proj + (size_t)b * SEQ * NPROJ + PC_SK + (hd >> 1) * 64; Vp = proj + (size_t)b * SEQ * NPROJ + PC_SV + (hd >> 1) * 64; ldk = NPROJ; }
    const bf16_t* Krp = (const bf16_t*)(a.ws + WS_KR) + (size_t)b * SEQ * 32;
    const int q0 = qb * 256, Q0 = q0 + wave * 32, qpos = Q0 + r;
    const size_t qrow = (size_t)b * SEQ + qpos;
    bf16x8 qr[KS];
    {
        u32x4 qw[KS]; f32x4 rcs[2], rsn[2];
        const bf16_t* qp = MLA ? (const bf16_t*)(a.ws + WS_Q) + qrow * 384 + hd * 96 + 8 * h : proj + qrow * NPROJ + PC_SQ + hd * 64 + 8 * h;
#pragma unroll
        for (int ks = 0; ks < KS; ++ks) qw[ks] = *(const u32x4*)(qp + 16 * ks);
        if (MLA) {
#pragma unroll
            for (int k2 = 0; k2 < 2; ++k2) { const float* rp = (const float*)(a.ws + WS_ROPE) + qrow * 32 + 8 * k2 + 4 * h; rcs[k2] = *(const f32x4*)rp; rsn[k2] = *(const f32x4*)(rp + 16); }
        }
#pragma unroll
        for (int ks = 0; ks < KS; ++ks) { u32x4 w = qw[ks];
            if (MLA) { if (ks >= 4) { const f32x4 cs = rcs[ks - 4 < 0 ? 0 : ks - 4], sn = rsn[ks - 4 < 0 ? 0 : ks - 4];
                w.x = cvt_pk_bf16(bflo(w.x) * cs.x - bfhi(w.x) * sn.x, bflo(w.x) * sn.x + bfhi(w.x) * cs.x); w.y = cvt_pk_bf16(bflo(w.y) * cs.y - bfhi(w.y) * sn.y, bflo(w.y) * sn.y + bfhi(w.y) * cs.y);
                w.z = cvt_pk_bf16(bflo(w.z) * cs.z - bfhi(w.z) * sn.z, bflo(w.z) * sn.z + bfhi(w.z) * cs.z); w.w = cvt_pk_bf16(bflo(w.w) * cs.w - bfhi(w.w) * sn.w, bflo(w.w) * sn.w + bfhi(w.w) * cs.w); } }
            else {
                w.x = cvt_pk_bf16(bflo(w.x) * SWA_QSCALE, bfhi(w.x) * SWA_QSCALE); w.y = cvt_pk_bf16(bflo(w.y) * SWA_QSCALE, bfhi(w.y) * SWA_QSCALE);
                w.z = cvt_pk_bf16(bflo(w.z) * SWA_QSCALE, bfhi(w.z) * SWA_QSCALE); w.w = cvt_pk_bf16(bflo(w.w) * SWA_QSCALE, bfhi(w.w) * SWA_QSCALE); }
            qr[ks] = __builtin_bit_cast(bf16x8, w); }
    }
    const int T_lo = MLA ? 0 : (qb == 0 ? 0 : 2 * qb - 1), T_hi = 2 * qb + 1;
    const int skey = tid >> 3, sch = tid & 7, rkey = tid >> 2, rch = tid & 3;
    u32x4 kreg[2], vreg[2], k2reg[2];
    auto gload = [&](int T) {
#pragma unroll
        for (int sub = 0; sub < 2; ++sub) { const int t = 2 * T + sub;
            kreg[sub] = *(const u32x4*)(Kp + (size_t)(64 * t + skey) * ldk + 8 * sch);
            vreg[sub] = *(const u32x4*)(Vp + (size_t)(64 * t + skey) * ldk + 8 * sch);
            if (MLA && tid < 256) k2reg[sub] = *(const u32x4*)(Krp + (size_t)(64 * t + rkey) * 32 + 8 * rch); }
    };
    auto lstore = [&](int buf) {
#pragma unroll
        for (int sub = 0; sub < 2; ++sub) {
            *(LAS u32x4*)(lds + buf * KBUF + (64 * sub + skey) * KROW + 16 * sch) = kreg[sub];
            *(LAS u32x4*)(lds + VOFF + buf * VBUF + sub * 8192 + (sch >> 2) * 4096 + skey * 64 + (sch & 3) * 16) = vreg[sub];
            if (MLA && tid < 256) *(LAS u32x4*)(lds + buf * KBUF + (64 * sub + rkey) * KROW + 128 + 16 * rch) = k2reg[sub]; }
    };
    f32x16 o0, o1;
#pragma unroll
    for (int i = 0; i < 16; ++i) { o0[i] = 0.f; o1[i] = 0.f; }
    float mx = MLA ? 0.f : a.sinks[l * 4 + hd] * LOG2E, ls = (MLA || h == 1) ? 0.f : 1.f;
    f32x16 negm;
#pragma unroll
    for (int i = 0; i < 16; ++i) negm[i] = -mx;
    gload(T_lo); lstore(0);
    __syncthreads();
    const int trb = (4 * h + ((lane & 15) >> 2)) * 64 + ((lane >> 4) & 1) * 32 + (lane & 3) * 8;
    for (int T = T_lo; T <= T_hi; ++T) {
        const int buf = (T - T_lo) & 1;
        if (T < T_hi) gload(T + 1);
#pragma unroll
        for (int sub = 0; sub < 2; ++sub) {
        const int t = 2 * T + sub;
        const bool active = (64 * t <= Q0 + 31) && (MLA || 64 * t + 63 >= Q0 - 127);
        if (active) {
            LAS unsigned char* Kb = lds + buf * KBUF + (64 * sub + r) * KROW + 16 * h;
            f32x16 p0 = negm, p1 = negm;
#pragma unroll
            for (int ks = 0; ks < KS; ++ks) {
                const bf16x8 k0 = *(const LAS bf16x8*)(Kb + 32 * ks), k1 = *(const LAS bf16x8*)(Kb + 32 * KROW + 32 * ks);
                p0 = __builtin_amdgcn_mfma_f32_32x32x16_bf16(k0, qr[ks], p0, 0, 0, 0);
                p1 = __builtin_amdgcn_mfma_f32_32x32x16_bf16(k1, qr[ks], p1, 0, 0, 0);
            }
            const bool need_mask = (64 * t + 63 > Q0) || (!MLA && 64 * t < Q0 + 31 - 127);
            if (need_mask) {
#pragma unroll
                for (int i = 0; i < 16; ++i) { const int kp = 64 * t + (i & 3) + 8 * (i >> 2) + 4 * h;
                    if (kp > qpos || (!MLA && qpos - kp >= 128)) p0[i] = -1e30f;
                    if (kp + 32 > qpos || (!MLA && qpos - kp - 32 >= 128)) p1[i] = -1e30f; } }
            float mt = fmaxf(p0[0], p1[0]);
#pragma unroll
            for (int i = 1; i < 16; ++i) mt = fmaxf(mt, fmaxf(p0[i], p1[i]));
            const bool first = MLA && (t == 0);
            if (first || __builtin_amdgcn_ballot_w64(mt > 8.f) != 0ull) {
                mt = fmaxf(mt, shx(mt, 32, lane));
                const float dl = first ? mt : fmaxf(mt, 0.f), f = first ? 1.f : __builtin_amdgcn_exp2f(-dl);
                mx += dl; ls *= f;
#pragma unroll
                for (int i = 0; i < 16; ++i) { p0[i] -= dl; p1[i] -= dl; o0[i] *= f; o1[i] *= f; negm[i] = -mx; }
            }
            float sum = 0.f;
#pragma unroll
            for (int i = 0; i < 16; ++i) { p0[i] = __builtin_amdgcn_exp2f(p0[i]); p1[i] = __builtin_amdgcn_exp2f(p1[i]); sum += p0[i] + p1[i]; }
            ls += sum;
            bf16x8 pw[2][2];
#pragma unroll
            for (int s2 = 0; s2 < 2; ++s2) {
                u32x4 w0, w1;
                w0.x = cvt_pk_bf16(p0[8 * s2], p0[8 * s2 + 1]); w0.y = cvt_pk_bf16(p0[8 * s2 + 2], p0[8 * s2 + 3]); w0.z = cvt_pk_bf16(p0[8 * s2 + 4], p0[8 * s2 + 5]); w0.w = cvt_pk_bf16(p0[8 * s2 + 6], p0[8 * s2 + 7]);
                w1.x = cvt_pk_bf16(p1[8 * s2], p1[8 * s2 + 1]); w1.y = cvt_pk_bf16(p1[8 * s2 + 2], p1[8 * s2 + 3]); w1.z = cvt_pk_bf16(p1[8 * s2 + 4], p1[8 * s2 + 5]); w1.w = cvt_pk_bf16(p1[8 * s2 + 6], p1[8 * s2 + 7]);
                pw[0][s2] = __builtin_bit_cast(bf16x8, w0); pw[1][s2] = __builtin_bit_cast(bf16x8, w1);
            }
            LAS unsigned char* Vb = lds + VOFF + buf * VBUF + sub * 8192 + trb;
#pragma unroll
            for (int kb = 0; kb < 2; ++kb)
#pragma unroll
                for (int s2 = 0; s2 < 2; ++s2) {
                    const int ko = (32 * kb + 16 * s2) * 64;
                    const s16x4 a0l = lds_tr16(Vb + ko), a0h = lds_tr16(Vb + ko + 512), a1l = lds_tr16(Vb + 4096 + ko), a1h = lds_tr16(Vb + 4096 + ko + 512);
                    const bf16x8 A0 = {a0l[0], a0l[1], a0l[2], a0l[3], a0h[0], a0h[1], a0h[2], a0h[3]}, A1 = {a1l[0], a1l[1], a1l[2], a1l[3], a1h[0], a1h[1], a1h[2], a1h[3]};
                    o0 = __builtin_amdgcn_mfma_f32_32x32x16_bf16(A0, pw[kb][s2], o0, 0, 0, 0);
                    o1 = __builtin_amdgcn_mfma_f32_32x32x16_bf16(A1, pw[kb][s2], o1, 0, 0, 0);
                }
        }
        }
        if (T < T_hi) lstore(buf ^ 1);
        __syncthreads();
    }
    ls += shx(ls, 32, lane);
    const float il = 1.f / ls;
    bf16_t* op = (bf16_t*)(a.ws + WS_YCAT) + qrow * 1024 + (MLA ? 512 : 768) + hd * 64 + 4 * h;
#pragma unroll
    for (int g4 = 0; g4 < 4; ++g4) {
        u32x2 w; w.x = cvt_pk_bf16(o0[4 * g4] * il, o0[4 * g4 + 1] * il); w.y = cvt_pk_bf16(o0[4 * g4 + 2] * il, o0[4 * g4 + 3] * il); *(u32x2*)(op + 8 * g4) = w;
        w.x = cvt_pk_bf16(o1[4 * g4] * il, o1[4 * g4 + 1] * il); w.y = cvt_pk_bf16(o1[4 * g4 + 2] * il, o1[4 * g4 + 3] * il); *(u32x2*)(op + 32 + 8 * g4) = w;
    }
}
__device__ __forceinline__ int xcd_vid(int blk, int G) { return (G % 8 == 0) ? (blk % 8) * (G / 8) + blk / 8 : blk; }
__device__ __forceinline__ void phase_mla(const Args& a, int l, LAS unsigned char* lds, int G) {
    for (int v0 = blockIdx.x; v0 < 256; v0 += G) { const int v = (G == 256) ? xcd_vid(v0, G) : v0; const int bh = v >> 3, s = v & 7;
        attn_unit<true>(a, l, lds, bh >> 2, bh & 3, s); attn_unit<true>(a, l, lds, bh >> 2, bh & 3, 15 - s); }
}
__device__ __forceinline__ void phase_swa(const Args& a, int l, LAS unsigned char* lds, int G) {
    for (int v0 = blockIdx.x; v0 < 512; v0 += G) { const int v = (G == 256) ? 2 * xcd_vid(v0 & 255, G) + (v0 >> 8) : v0; const int bh = v >> 4; attn_unit<false>(a, l, lds, bh >> 2, bh & 3, v & 15); }
}
__device__ __forceinline__ int crow16(int i, int h2) { return (i & 3) + 8 * (i >> 2) + 4 * h2; }
__device__ __forceinline__ void ssd_tables(const Args& a, int l, LAS float* dts, LAS float* acs, size_t row0, int g, int tid) {
    const int hg = tid >> 7, s = tid & 127, h = 4 * g + hg;
    const float av = -__expf(a.a_log[l * 8 + h]);
    const float dt = ((const float*)(a.ws + WS_DTSP))[(row0 + s) * 8 + h];
    dts[hg * 128 + s] = dt;
    const int lane = tid & 63;
    float v = dt * av;
#pragma unroll
    for (int d = 1; d < 64; d <<= 1) { const float o = __builtin_bit_cast(float, __builtin_amdgcn_ds_bpermute(((lane - d) & 63) << 2, __builtin_bit_cast(int, v))); v += (lane >= d) ? o : 0.f; }
    if ((tid & 127) == 63) acs[hg * 128] = v;
    __syncthreads();
    const float add = (tid & 64) ? acs[hg * 128] : 0.f;
    __syncthreads();
    acs[hg * 128 + s] = v + add;
    __syncthreads();
}
template <bool SCALED>
__device__ __forceinline__ void ssd_stage_x(const bf16_t* xbc, size_t row0, int g, LAS unsigned char* Xi, const LAS float* dts, const LAS float* acs, int tid) {
    u32x4 vv[8];
#pragma unroll
    for (int i = 0; i < 8; ++i) { const int ch = tid + 512 * i, hg = ch >> 10, s = (ch >> 3) & 127, c8 = ch & 7;
        vv[i] = *(const u32x4*)(xbc + (row0 + s) * 1024 + (4 * g + hg) * 64 + 8 * c8); }
#pragma unroll
    for (int i = 0; i < 8; ++i) { const int ch = tid + 512 * i, hg = ch >> 10, s = (ch >> 3) & 127, c8 = ch & 7;
        u32x4 v = vv[i];
        if (SCALED) { const float w = dts[hg * 128 + s] * __expf(acs[hg * 128 + 127] - acs[hg * 128 + s]);
            v.x = cvt_pk_bf16(bflo(v.x) * w, bfhi(v.x) * w); v.y = cvt_pk_bf16(bflo(v.y) * w, bfhi(v.y) * w); v.z = cvt_pk_bf16(bflo(v.z) * w, bfhi(v.z) * w); v.w = cvt_pk_bf16(bflo(v.w) * w, bfhi(v.w) * w); }
        *(LAS u32x4*)(Xi + hg * 16384 + (c8 >> 2) * 8192 + s * 64 + (c8 & 3) * 16) = v; }
}
__device__ __forceinline__ bf16x8 tr_frag(LAS unsigned char* p, int hi_off) {
    const s16x4 lo = lds_tr16(p), hi = lds_tr16(p + hi_off);
    return (bf16x8){lo[0], lo[1], lo[2], lo[3], hi[0], hi[1], hi[2], hi[3]};
}
__device__ __forceinline__ void phase_ssd_states_mfma(const Args& a, int l, LAS unsigned char* lds, int G) {
    const int tid = tid_opaque(a.wv), lane = tid & 63, wave = __builtin_amdgcn_readfirstlane(tid >> 6), r = lane & 31, h2 = lane >> 5;
    const bf16_t* xbc = (const bf16_t*)(a.ws + WS_H);
    bf16_t* states = (bf16_t*)(a.ws + WS_YS); float* cdec = (float*)(a.ws + WS_CDEC);
    LAS unsigned char* Bi = lds; LAS unsigned char* Xi = lds + 32768; LAS float* dts = (LAS float*)(lds + 98304); LAS float* acs = dts + 512;
    const int trb2 = (8 * h2 + ((lane & 15) >> 2)) * 64 + ((lane >> 4) & 1) * 32 + (lane & 3) * 8;
    for (int u = blockIdx.x; u < 512; u += G) {
        const int b = u >> 6, c = (u >> 1) & 31, g = u & 1; const size_t row0 = (size_t)b * SEQ + c * 128;
        ssd_tables(a, l, dts, acs, row0, g, tid);
#pragma unroll
        for (int i = 0; i < 4; ++i) { const int ch = tid + 512 * i, s = ch >> 4, c16 = ch & 15;
            *(LAS u32x4*)(Bi + (c16 >> 2) * 8192 + s * 64 + (c16 & 3) * 16) = *(const u32x4*)(xbc + (row0 + s) * 1024 + 512 + g * 128 + 8 * c16); }
        ssd_stage_x<true>(xbc, row0, g, Xi, dts, acs, tid);
        __syncthreads();
        const int hg = wave >> 1, nbh = wave & 1;
        f32x16 d00, d01, d10, d11;
#pragma unroll
        for (int i = 0; i < 16; ++i) { d00[i] = 0.f; d01[i] = 0.f; d10[i] = 0.f; d11[i] = 0.f; }
        LAS unsigned char* xa = Xi + hg * 16384 + trb2; LAS unsigned char* ba = Bi + (2 * nbh) * 8192 + trb2;
#pragma unroll
        for (int ks = 0; ks < 8; ++ks) {
            const bf16x8 A0 = tr_frag(xa + ks * 1024, 256), A1 = tr_frag(xa + 8192 + ks * 1024, 256), B0 = tr_frag(ba + ks * 1024, 256), B1 = tr_frag(ba + 8192 + ks * 1024, 256);
            d00 = __builtin_amdgcn_mfma_f32_32x32x16_bf16(B0, A0, d00, 0, 0, 0); d01 = __builtin_amdgcn_mfma_f32_32x32x16_bf16(B0, A1, d01, 0, 0, 0);
            d10 = __builtin_amdgcn_mfma_f32_32x32x16_bf16(B1, A0, d10, 0, 0, 0); d11 = __builtin_amdgcn_mfma_f32_32x32x16_bf16(B1, A1, d11, 0, 0, 0);
        }
        asm volatile("s_nop 15\n\ts_nop 7" : "+v"(d00), "+v"(d01), "+v"(d10), "+v"(d11));
        bf16_t* sp = states + (size_t)((b * 32 + c) * 8 + 4 * g + hg) * 8192 + (size_t)r * 128 + 64 * nbh + 4 * h2;
#pragma unroll
        for (int g4 = 0; g4 < 4; ++g4) { u32x2 w;
            w.x = cvt_pk_bf16(d00[4 * g4], d00[4 * g4 + 1]); w.y = cvt_pk_bf16(d00[4 * g4 + 2], d00[4 * g4 + 3]); *(u32x2*)(sp + 8 * g4) = w;
            w.x = cvt_pk_bf16(d01[4 * g4], d01[4 * g4 + 1]); w.y = cvt_pk_bf16(d01[4 * g4 + 2], d01[4 * g4 + 3]); *(u32x2*)(sp + 32 * 128 + 8 * g4) = w;
            w.x = cvt_pk_bf16(d10[4 * g4], d10[4 * g4 + 1]); w.y = cvt_pk_bf16(d10[4 * g4 + 2], d10[4 * g4 + 3]); *(u32x2*)(sp + 32 + 8 * g4) = w;
            w.x = cvt_pk_bf16(d11[4 * g4], d11[4 * g4 + 1]); w.y = cvt_pk_bf16(d11[4 * g4 + 2], d11[4 * g4 + 3]); *(u32x2*)(sp + 32 * 128 + 32 + 8 * g4) = w; }
        if (tid < 4) cdec[(b * 32 + c) * 8 + 4 * g + tid] = __expf(acs[tid * 128 + 127]);
        __syncthreads();
    }
}
__device__ __forceinline__ void phase_ssd_out_mfma(const Args& a, int l, LAS unsigned char* lds, int G) {
    constexpr int RW = 272;
    const int tid = tid_opaque(a.wv), lane = tid & 63, wave = __builtin_amdgcn_readfirstlane(tid >> 6), r = lane & 31, h2 = lane >> 5;
    const bf16_t* xbc = (const bf16_t*)(a.ws + WS_H); const bf16_t* proj = (const bf16_t*)(a.ws + WS_PROJ);
    const bf16_t* states = (const bf16_t*)(a.ws + WS_YS); bf16_t* ycat = (bf16_t*)(a.ws + WS_YCAT);
    LAS unsigned char* Cr = lds; LAS unsigned char* Br = lds + 34816; LAS unsigned char* Xi = lds + 69632;
    LAS float* dts = (LAS float*)(lds + 135168); LAS float* acs = dts + 512; LAS float* sq = dts + 1024;
    const int trb = (4 * h2 + ((lane & 15) >> 2)) * 64 + ((lane >> 4) & 1) * 32 + (lane & 3) * 8;
    for (int u = blockIdx.x; u < 512; u += G) {
        const int b = u >> 6, c = (u >> 1) & 31, g = u & 1; const size_t row0 = (size_t)b * SEQ + c * 128;
        const int hg = wave >> 1, lh = wave & 1, h = 4 * g + hg;
        const float dsk = a.ssd_d[l * 8 + h];
        bf16x8 hf[2][8];
        { const bf16_t* hp = states + (size_t)((b * 32 + c) * 8 + h) * 8192 + (size_t)r * 128 + 8 * h2;
#pragma unroll
          for (int pb = 0; pb < 2; ++pb)
#pragma unroll
              for (int ks = 0; ks < 8; ++ks) hf[pb][ks] = *(const bf16x8*)(hp + pb * 4096 + 16 * ks); }
        ssd_tables(a, l, dts, acs, row0, g, tid);
#pragma unroll
        for (int i = 0; i < 4; ++i) { const int ch = tid + 512 * i, s = ch >> 4, c16 = ch & 15; const bf16_t* src = xbc + (row0 + s) * 1024 + 512 + g * 128 + 8 * c16;
            *(LAS u32x4*)(Br + s * RW + 16 * c16) = *(const u32x4*)src; *(LAS u32x4*)(Cr + s * RW + 16 * c16) = *(const u32x4*)(src + 256); }
        ssd_stage_x<false>(xbc, row0, g, Xi, dts, acs, tid);
        __syncthreads();
        f32x16 yv[2][2];
#pragma unroll
        for (int lb = 0; lb < 2; ++lb) {
            const int Lb = lb == 0 ? lh : 3 - lh, L0 = 32 * Lb, lq = L0 + r;
            bf16x8 cf[8];
#pragma unroll
            for (int ks = 0; ks < 8; ++ks) cf[ks] = *(const LAS bf16x8*)(Cr + lq * RW + 32 * ks + 16 * h2);
            f32x16 o0, o1;
#pragma unroll
            for (int i = 0; i < 16; ++i) { o0[i] = 0.f; o1[i] = 0.f; }
#pragma unroll
            for (int ks = 0; ks < 8; ++ks) {
                o0 = __builtin_amdgcn_mfma_f32_32x32x16_bf16(hf[0][ks], cf[ks], o0, 0, 0, 0);
                o1 = __builtin_amdgcn_mfma_f32_32x32x16_bf16(hf[1][ks], cf[ks], o1, 0, 0, 0);
            }
            const float Al = acs[hg * 128 + lq], eAl = __expf(Al);
#pragma unroll
            for (int i = 0; i < 16; ++i) { o0[i] *= eAl; o1[i] *= eAl; }
            for (int sb = 0; sb <= Lb; ++sb) {
                f32x16 X;
#pragma unroll
                for (int i = 0; i < 16; ++i) X[i] = 0.f;
#pragma unroll
                for (int ks = 0; ks < 8; ++ks) X = __builtin_amdgcn_mfma_f32_32x32x16_bf16(*(const LAS bf16x8*)(Br + (32 * sb + r) * RW + 32 * ks + 16 * h2), cf[ks], X, 0, 0, 0);
#pragma unroll
                for (int i = 0; i < 16; ++i) { const int s = 32 * sb + crow16(i, h2); X[i] = (s <= lq) ? X[i] * __expf(Al - acs[hg * 128 + s]) * dts[hg * 128 + s] : 0.f; }
                u32x4 w0, w1;
                w0.x = cvt_pk_bf16(X[0], X[1]); w0.y = cvt_pk_bf16(X[2], X[3]); w0.z = cvt_pk_bf16(X[4], X[5]); w0.w = cvt_pk_bf16(X[6], X[7]);
                w1.x = cvt_pk_bf16(X[8], X[9]); w1.y = cvt_pk_bf16(X[10], X[11]); w1.z = cvt_pk_bf16(X[12], X[13]); w1.w = cvt_pk_bf16(X[14], X[15]);
                LAS unsigned char* xa = Xi + hg * 16384 + trb + (32 * sb) * 64;
                o0 = __builtin_amdgcn_mfma_f32_32x32x16_bf16(tr_frag(xa, 512), __builtin_bit_cast(bf16x8, w0), o0, 0, 0, 0);
                o1 = __builtin_amdgcn_mfma_f32_32x32x16_bf16(tr_frag(xa + 8192, 512), __builtin_bit_cast(bf16x8, w0), o1, 0, 0, 0);
                o0 = __builtin_amdgcn_mfma_f32_32x32x16_bf16(tr_frag(xa + 1024, 512), __builtin_bit_cast(bf16x8, w1), o0, 0, 0, 0);
                o1 = __builtin_amdgcn_mfma_f32_32x32x16_bf16(tr_frag(xa + 8192 + 1024, 512), __builtin_bit_cast(bf16x8, w1), o1, 0, 0, 0);
            }
            float ssq = 0.f;
            const bf16_t* zp = proj + (row0 + lq) * NPROJ + PC_Z + h * 64 + 4 * h2;
#pragma unroll
            for (int g4 = 0; g4 < 4; ++g4) {
                const u32x2 x0 = *(const LAS u32x2*)(Xi + hg * 16384 + lq * 64 + (8 * g4 + 4 * h2) * 2), x1 = *(const LAS u32x2*)(Xi + hg * 16384 + 8192 + lq * 64 + (8 * g4 + 4 * h2) * 2);
                const u32x2 z0 = *(const u32x2*)(zp + 8 * g4), z1 = *(const u32x2*)(zp + 32 + 8 * g4);
                float v;
                v = (o0[4 * g4] + dsk * bflo(x0.x)) * silu_f(bflo(z0.x)); o0[4 * g4] = v; ssq += v * v;
                v = (o0[4 * g4 + 1] + dsk * bfhi(x0.x)) * silu_f(bfhi(z0.x)); o0[4 * g4 + 1] = v; ssq += v * v;
                v = (o0[4 * g4 + 2] + dsk * bflo(x0.y)) * silu_f(bflo(z0.y)); o0[4 * g4 + 2] = v; ssq += v * v;
                v = (o0[4 * g4 + 3] + dsk * bfhi(x0.y)) * silu_f(bfhi(z0.y)); o0[4 * g4 + 3] = v; ssq += v * v;
                v = (o1[4 * g4] + dsk * bflo(x1.x)) * silu_f(bflo(z1.x)); o1[4 * g4] = v; ssq += v * v;
                v = (o1[4 * g4 + 1] + dsk * bfhi(x1.x)) * silu_f(bfhi(z1.x)); o1[4 * g4 + 1] = v; ssq += v * v;
                v = (o1[4 * g4 + 2] + dsk * bflo(x1.y)) * silu_f(bflo(z1.y)); o1[4 * g4 + 2] = v; ssq += v * v;
                v = (o1[4 * g4 + 3] + dsk * bfhi(x1.y)) * silu_f(bfhi(z1.y)); o1[4 * g4 + 3] = v; ssq += v * v;
            }
            ssq += shx(ssq, 32, lane);
            if (h2 == 0) sq[lq * 4 + hg] = ssq;
            yv[lb][0] = o0; yv[lb][1] = o1;
        }
        f32x4 ngv[4][2];
        { const float* ngp = a.ssd_ng + l * 512 + g * 256 + hg * 64 + 4 * h2;
#pragma unroll
          for (int g4 = 0; g4 < 4; ++g4)
#pragma unroll
              for (int pb = 0; pb < 2; ++pb) ngv[g4][pb] = *(const f32x4*)(ngp + 32 * pb + 8 * g4); }
        __syncthreads();
#pragma unroll
        for (int lb = 0; lb < 2; ++lb) {
            const int Lb = lb == 0 ? lh : 3 - lh, lq = 32 * Lb + r;
            const f32x4 t4 = *(const LAS f32x4*)(sq + lq * 4);
            const float rinv = __builtin_amdgcn_rsqf(((t4.x + t4.y) + (t4.z + t4.w)) * (1.f / 256.f) + EPS);
            bf16_t* op = ycat + (row0 + lq) * 1024 + g * 256 + hg * 64 + 4 * h2;
#pragma unroll
            for (int g4 = 0; g4 < 4; ++g4)
#pragma unroll
                for (int pb = 0; pb < 2; ++pb) { const f32x4 gg = ngv[g4][pb];
                    u32x2 w; w.x = cvt_pk_bf16(yv[lb][pb][4 * g4] * rinv * gg.x, yv[lb][pb][4 * g4 + 1] * rinv * gg.y); w.y = cvt_pk_bf16(yv[lb][pb][4 * g4 + 2] * rinv * gg.z, yv[lb][pb][4 * g4 + 3] * rinv * gg.w);
                    *(u32x2*)(op + 32 * pb + 8 * g4) = w; }
        }
        __syncthreads();
    }
}


#define XB_TMO      128
#define XB_XCNT(j)  (256  + 64 * (j))
#define XB_XSUB(j)  (1280 + 64 * (j))
#define XB_XGEN(j)  (2304 + 64 * (j))
#define XB_TOP      3328
#define XB_TOPGEN   3392
#define XCD_BAR_WORDS 3456
#define XB_SPIN_CAP (1u << 18)
__device__ __forceinline__ unsigned xb_ld(unsigned* p)              { return __hip_atomic_load(p, __ATOMIC_RELAXED, __HIP_MEMORY_SCOPE_AGENT); }
__device__ __forceinline__ unsigned xb_add(unsigned* p, unsigned v) { return __hip_atomic_fetch_add(p, v, __ATOMIC_RELAXED, __HIP_MEMORY_SCOPE_AGENT); }
__device__ __forceinline__ unsigned xb_xcc_id() { return (unsigned)__builtin_amdgcn_s_getreg((3 << 11) | 20) & 0xFu; }
#define XB_SPIN(cond, bar) do { unsigned _sp = 0; while (cond) { __builtin_amdgcn_s_sleep(1); \
    if ((++_sp & 255u) == 0u) { if (xb_ld(&(bar)[XB_TMO])) break; if (_sp > XB_SPIN_CAP) { atomicAdd(&(bar)[XB_TMO], 1u); break; } } } } while (0)
struct XcdBarrier { unsigned* bar; unsigned x; volatile LAS unsigned* st; };
__device__ __forceinline__ XcdBarrier xcd_barrier_post(unsigned* bar, volatile LAS unsigned* st) {
    XcdBarrier b; b.bar = bar; b.x = xb_xcc_id(); b.st = st;
    if (threadIdx.x == 0) (void)xb_add(&bar[XB_XCNT(b.x)], 1u);
    return b;
}
__device__ __forceinline__ void xcd_barrier_complete(unsigned* bar, unsigned x, unsigned& nloc, unsigned& nx) {
    const unsigned G = gridDim.x * gridDim.y * gridDim.z;
    unsigned sum, cnt, mine, sp = 0u;
    for (;;) {
        sum = 0u; cnt = 0u; mine = 0u;
#pragma unroll
        for (unsigned j = 0; j < 16; ++j) { const unsigned c = xb_ld(&bar[XB_XCNT(j)]); sum += c; cnt += (c > 0u) ? 1u : 0u; mine = (j == x) ? c : mine; }
        if (sum == G) break;
        __builtin_amdgcn_s_sleep(1);
        if ((++sp & 255u) == 0u) { if (xb_ld(&bar[XB_TMO])) break; if (sp > XB_SPIN_CAP) { atomicAdd(&bar[XB_TMO], 1u); break; } }
    }
    nloc = mine > 0u ? mine : 1u; nx = cnt > 0u ? cnt : 1u;
}
__device__ __forceinline__ void xcd_barrier(const XcdBarrier& b) {
    asm volatile("s_waitcnt vmcnt(0)" ::: "memory");
    __syncthreads();
    if (threadIdx.x == 0) {
        unsigned* bar = b.bar;
        __builtin_amdgcn_s_waitcnt(0);
        unsigned nloc = b.st[0], nx = b.st[1];
        if (nloc == 0u) { xcd_barrier_complete(bar, b.x, nloc, nx); b.st[0] = nloc; b.st[1] = nx; }
        const unsigned old = xb_add(&bar[XB_XSUB(b.x)], 1u);
        const unsigned gen = old / nloc;
        if (old + 1u == (gen + 1u) * nloc) {
            __builtin_amdgcn_fence(__ATOMIC_RELEASE, "agent");
            asm volatile("s_waitcnt vmcnt(0)" ::: "memory");
            const unsigned og = xb_add(&bar[XB_TOP], 1u);
            const unsigned tg = og / nx;
            if (og + 1u == (tg + 1u) * nx) xb_add(&bar[XB_TOPGEN], 1u);
            else XB_SPIN(xb_ld(&bar[XB_TOPGEN]) == tg, bar);
            __builtin_amdgcn_fence(__ATOMIC_ACQUIRE, "agent");
            xb_add(&bar[XB_XGEN(b.x)], 1u);
            asm volatile("s_waitcnt vmcnt(0)" ::: "memory");
        } else {
            XB_SPIN(xb_ld(&bar[XB_XGEN(b.x)]) == gen, bar);
            __builtin_amdgcn_fence(__ATOMIC_ACQUIRE, "agent");
            asm volatile("s_waitcnt vmcnt(0)" ::: "memory");
        }
    }
    __syncthreads();
}

constexpr int PH_PER_LAYER = 8, N_PHASES = 2 + DEPTH * PH_PER_LAYER + 1;
__global__ void __launch_bounds__(512, 2) fwd_kernel(Args a0) {
    extern __shared__ __attribute__((aligned(16))) unsigned char lds_raw[];
    LAS unsigned char* lds = (LAS unsigned char*)lds_raw;
    const int G = gridDim.x;
    const int wave_s = __builtin_amdgcn_readfirstlane((int)threadIdx.x >> 6);
#if MK_PER_PHASE
#define SEAM() do {} while (0)
#else
    cg::grid_group grid = cg::this_grid();
    volatile LAS unsigned* bst = (volatile LAS unsigned*)(lds + LDS_BYTES - 64);
    if (threadIdx.x < 2) bst[threadIdx.x] = 0u;
    __syncthreads();
    if (blockIdx.x == 0 && a0.ph_lo == 0) { for (int i = threadIdx.x; i < XCD_BAR_WORDS; i += 512) ((unsigned*)a0.ws)[i] = 0u; }
    XcdBarrier xbar; xbar.bar = (unsigned*)a0.ws; xbar.x = 0u; xbar.st = bst;
#define SEAM() do { if (ph + 1 < a.ph_hi) { if (ph == 0) { grid.sync(); xbar = xcd_barrier_post((unsigned*)a0.ws, bst); } else xcd_barrier(xbar); if ((PROBE_MASK & 256) && ph > 0) xcd_barrier(xbar); } } while (0)
#endif
    for (int ph = a0.ph_lo; ph < a0.ph_hi; ++ph) {
        unsigned long long wsi_ = (unsigned long long)a0.ws, oi_ = (unsigned long long)a0.out; asm volatile("" : "+s"(wsi_), "+s"(oi_));
        unsigned char* ws = (unsigned char*)(__attribute__((address_space(1))) unsigned char*)wsi_;
        Args a = a0; a.ws = ws; a.wv = wave_s;
        a.out = (float*)(__attribute__((address_space(1))) float*)oi_;
        const float* mod = (const float*)(ws + WS_MOD);
        bf16_t* hbuf = (bf16_t*)(ws + WS_H);
        unsigned long long* rowsq1 = (unsigned long long*)(ws + WS_RSQ); unsigned long long* rowsq2 = rowsq1 + M;
        if (ph == 0) { RUN(16, phase_mod(a, lds, G)); phase_rope(a, G); __syncthreads(); phase_weights(a, 0, ws + WS_W, lds, G); SEAM(); continue; }
        if (ph == 1) { phase_norm0(a.x, a.n1g, mod + 1024, hbuf, rowsq1, G, a.wv); phase_bias(a, 0, (float*)(ws + WS_BIAS), lds, G); SEAM(); continue; }
        if (ph == N_PHASES - 1) { phase_final(a.out, a.fng, G, a.wv); continue; }
        const int l = (ph - 2) / PH_PER_LAYER, sp = (ph - 2) % PH_PER_LAYER;
        const float* ml = mod + (size_t)l * 8 * 6144;
        const float* xcur = (l == 0) ? a.x : a.out;
        const unsigned char* Wb = ws + ((l & 1) ? WS_W2 : WS_W);
        const float* biasb = (const float*)(ws + WS_BIAS + (size_t)(l & 1) * 262144);
        if (sp == 0) {
            pg8::Gemm g{hbuf, (const bf16_t*)(Wb + WO_IN), D, D, a.wv}; pg8::Order S; S.init(M / 256, NPROJ / 256, G, (int)blockIdx.x, 0);
            pg8::EpiProj E{(bf16_t*)(ws + WS_PROJ), (float*)(ws + WS_DTRAW), rowsq1, biasb};
            RUN(32, pg8::gemm_phase(lds, g, S, E));
        } else if (sp == 1) {
            RUN(8, phase_prep(a, l, G));
        } else if (sp == 2) {
            { pg8::Gemm g{(const bf16_t*)(ws + WS_PROJ) + PC_CQ, (const bf16_t*)(Wb + WO_UQ), 256, NPROJ, a.wv}; pg8::Order S; S.init(M / 256, 2, G, (int)blockIdx.x, 0);
              pg8::EpiMla E{(bf16_t*)(ws + WS_Q), (bf16_t*)(ws + WS_KV), (const float*)(ws + WS_RS), 1};
              pg8::gemm_phase(lds, g, S, E); }
            { pg8::Gemm g{(const bf16_t*)(ws + WS_PROJ) + PC_CKV, (const bf16_t*)(Wb + WO_UKV), 128, NPROJ, a.wv}; pg8::Order S; S.init(M / 256, 2, G, (int)blockIdx.x, 0);
              pg8::EpiMla E{(bf16_t*)(ws + WS_Q), (bf16_t*)(ws + WS_KV), (const float*)(ws + WS_RS), 0};
              pg8::gemm_phase(lds, g, S, E); }
            RUN(4, phase_ssd_states_mfma(a, l, lds, G));
            RUN(2, phase_swa(a, l, lds, G));
        } else if (sp == 3) {
            phase_ssd_scan(a, G);
            RUN(2, phase_mla(a, l, lds, G));
            if (l + 1 < DEPTH) { __syncthreads(); RUN(1024, phase_weights(a, l + 1, ws + (((l + 1) & 1) ? WS_W2 : WS_W), lds, G)); RUN(512, phase_bias(a, l + 1, (float*)(ws + WS_BIAS + (size_t)((l + 1) & 1) * 262144), lds, G)); }
        } else if (sp == 4) {
            RUN(2048, phase_ssd_out_mfma(a, l, lds, G));
        } else if (sp == 5) {
            pg8::Gemm g{(const bf16_t*)(ws + WS_YCAT), (const bf16_t*)(Wb + WO_OUT), D, D, a.wv}; pg8::Order S; S.init(M / 256, D / 256, G, (int)blockIdx.x, 0);
            pg8::EpiRes E{xcur, a.out, ml + 2048, hbuf, a.n2g + l * D, ml + 4096, rowsq2};
            pg8::gemm_phase(lds, g, S, E);
        } else if (sp == 6) {
            pg8::Gemm g{hbuf, (const bf16_t*)(Wb + WO_UP), D, D, a.wv}; pg8::Order S; S.init(NB * 17, DFF / 128, G, (int)blockIdx.x, 1);
            pg8::EpiUp E{(bf16_t*)(ws + WS_PROJ), a.fconv_w + (size_t)l * 3 * 2 * DFF, a.fconv_b + (size_t)l * 2 * DFF, rowsq2, biasb + 8 * NPROJ};
            RUN(128, pg8::gemm_phase(lds, g, S, E));
        } else {
            pg8::Gemm g{(const bf16_t*)(ws + WS_PROJ), (const bf16_t*)(Wb + WO_DN), DFF, DFF, a.wv}; pg8::Order S; S.init(M / 256, D / 256, G, (int)blockIdx.x, 0);
            const bool nxt = l + 1 < DEPTH;
            pg8::EpiRes E{a.out, a.out, ml + 5120, nxt ? hbuf : nullptr, a.n1g + (nxt ? l + 1 : l) * D, ml + (nxt ? 8 * 6144 : 0) + 1024, rowsq1};
            pg8::gemm_phase(lds, g, S, E);
        }
        SEAM();
    }
}

extern "C" void kernel_launch(void* const* d_in, const int* in_sizes, int n_in, void* d_out, int out_size, void* d_ws, size_t ws_size, hipStream_t stream) {
    static int grid = 0;
    if (grid == 0) {
        if (n_in != 25 || ws_size < WS_END) { fprintf(stderr, "kernel_launch: unexpected n_in %d / ws %zu\n", n_in, ws_size); grid = -1; return; }
        int dev = 0, cus = 0, per_cu = 0;
        hipGetDevice(&dev); hipDeviceGetAttribute(&cus, hipDeviceAttributeMultiprocessorCount, dev);
        if (hipFuncSetAttribute((const void*)fwd_kernel, hipFuncAttributeMaxDynamicSharedMemorySize, LDS_BYTES) != hipSuccess) { fprintf(stderr, "hipFuncSetAttribute failed\n"); }
        hipOccupancyMaxActiveBlocksPerMultiprocessor(&per_cu, (const void*)fwd_kernel, 512, LDS_BYTES);
        (void)hipGetLastError();
        if (per_cu < 1) { fprintf(stderr, "occupancy query says %d blocks/CU\n", per_cu); per_cu = 1; }
        grid = cus;
    }
    if (grid < 0) return;
    Args a{};
    a.x = (const float*)d_in[0]; a.c = (const float*)d_in[1]; a.pos = (const int*)d_in[2];
    a.ada_w = (const float*)d_in[3]; a.ada_b = (const float*)d_in[4]; a.n1g = (const float*)d_in[5]; a.n2g = (const float*)d_in[6]; a.w_in = (const float*)d_in[7];
    a.sconv_w = (const float*)d_in[8]; a.sconv_b = (const float*)d_in[9]; a.dt_bias = (const float*)d_in[10]; a.a_log = (const float*)d_in[11]; a.ssd_d = (const float*)d_in[12]; a.ssd_ng = (const float*)d_in[13];
    a.qng = (const float*)d_in[14]; a.w_uq = (const float*)d_in[15]; a.kvng = (const float*)d_in[16]; a.w_ukv = (const float*)d_in[17]; a.sinks = (const float*)d_in[18]; a.w_out = (const float*)d_in[19];
    a.w_up = (const float*)d_in[20]; a.fconv_w = (const float*)d_in[21]; a.fconv_b = (const float*)d_in[22]; a.w_dn = (const float*)d_in[23]; a.fng = (const float*)d_in[24];
    a.out = (float*)d_out; a.ws = (unsigned char*)d_ws;
#if MK_PER_PHASE
    for (int ph = 0; ph < N_PHASES; ++ph) { a.ph_lo = ph; a.ph_hi = ph + 1; hipLaunchKernelGGL(fwd_kernel, dim3(grid), dim3(512), LDS_BYTES, stream, a); }
#else
    a.ph_lo = 0; a.ph_hi = N_PHASES;
    void* args[] = {&a};
    hipError_t e = hipLaunchCooperativeKernel((const void*)fwd_kernel, dim3(grid), dim3(512), args, LDS_BYTES, stream);
    if (e != hipSuccess) fprintf(stderr, "cooperative launch failed: %s (grid %d)\n", hipGetErrorString(e), grid);
#endif
}
```
